# Optimizing an MI355X kernel written in HIP

```python
import jax, jax.numpy as jnp
from jax import lax
import numpy as np

D_MODEL = 2048
BATCH = 2
SEQ = 8192
DEPTH = 1

CHUNK = 64
HEAD_DIM = 64
D_SSD = D_MODEL
D_RWKV = D_MODEL
D_MIX = D_SSD + D_RWKV
SSD_HEADS = D_SSD // HEAD_DIM
SSD_GROUPS = 4
SSD_HPG = SSD_HEADS // SSD_GROUPS
SSD_STATE = 128
CONV_WIDTH = 4
D_XBC = D_SSD + 2 * SSD_GROUPS * SSD_STATE
RWKV_HEADS = D_RWKV // HEAD_DIM
DECAY_LORA = 96
AAA_LORA = 96
GATE_LORA = 256
D_RWKV_IN = 3 * D_RWKV + DECAY_LORA + AAA_LORA + GATE_LORA
D_IN = D_SSD + D_XBC + SSD_HEADS + D_RWKV_IN
D_FF = -(-8 * D_MODEL // (3 * 256)) * 256
RMS_EPS = 1e-6
GATED_NORM_EPS = 1e-5
GN_EPS = 64e-5

kernel_name = "hymba_style_ssd_rwkv7_hybrid_block"


def rms_norm(x, g, eps=RMS_EPS):
    xf = x.astype(jnp.float32)
    y = xf * lax.rsqrt(jnp.mean(xf * xf, axis=-1, keepdims=True) + eps)
    return (y * g.astype(jnp.float32)).astype(x.dtype)


def causal_depthwise_conv(u, w, b):
    c = u.shape[-1]
    y = lax.conv_general_dilated(u, w[:, None, :].astype(u.dtype), window_strides=(1,),
                                 padding=((w.shape[0] - 1, 0),),
                                 dimension_numbers=('NWC', 'WIO', 'NWC'),
                                 feature_group_count=c)
    return y + b.astype(u.dtype)


def segsum(a):
    t = a.shape[-1]
    rep = jnp.broadcast_to(a[..., None], a.shape + (t,))
    rep = jnp.where(jnp.tril(jnp.ones((t, t), bool), -1), rep, 0.0)
    cs = jnp.cumsum(rep, axis=-2)
    return jnp.where(jnp.tril(jnp.ones((t, t), bool)), cs, -jnp.inf)


def ssd_chunked(xh, dt, A, Bm, Cm):
    b, s, g, e, p = xh.shape
    n = Bm.shape[-1]
    c = s // CHUNK
    X = (xh * dt[..., None]).reshape(b, c, CHUNK, g, e, p)
    Adt = (dt * A).reshape(b, c, CHUNK, g, e).transpose(0, 3, 4, 1, 2)
    Bc = Bm.reshape(b, c, CHUNK, g, n)
    Cc = Cm.reshape(b, c, CHUNK, g, n)
    A_cs = jnp.cumsum(Adt, axis=-1)
    L = jnp.exp(segsum(Adt))
    CB = jnp.einsum('bclgn,bcsgn->bcgls', Cc, Bc)
    y_diag = jnp.einsum('bcgls,bgecls,bcsgep->bclgep', CB, L, X)
    decay_states = jnp.exp(A_cs[..., -1:] - A_cs)
    states = jnp.einsum('bclgn,bgecl,bclgep->bcgepn', Bc, decay_states, X)
    chunk_decay = jnp.exp(A_cs[..., -1])

    def step(h, inp):
        st, dec = inp
        return h * dec[..., None, None] + st, h

    h0 = jnp.zeros((b, g, e, p, n), X.dtype)
    _, h_in = lax.scan(step, h0, (states.transpose(1, 0, 2, 3, 4, 5), chunk_decay.transpose(3, 0, 1, 2)))
    h_in = h_in.transpose(1, 0, 2, 3, 4, 5)
    y_off = jnp.einsum('bclgn,bcgepn,bgecl->bclgep', Cc, h_in, jnp.exp(A_cs))
    return (y_diag + y_off).reshape(b, s, g, e, p)


def ssd_mixer(z, xbc, dt_raw, conv_w, conv_b, dt_bias, A_log, D_skip, norm_g):
    b, s, _ = z.shape
    f32 = jnp.float32
    xbc = jax.nn.silu(causal_depthwise_conv(xbc, conv_w, conv_b)).astype(f32)
    xs = xbc[..., :D_SSD]
    Bm = xbc[..., D_SSD:D_SSD + SSD_GROUPS * SSD_STATE].reshape(b, s, SSD_GROUPS, SSD_STATE)
    Cm = xbc[..., D_SSD + SSD_GROUPS * SSD_STATE:].reshape(b, s, SSD_GROUPS, SSD_STATE)
    xh = xs.reshape(b, s, SSD_GROUPS, SSD_HPG, HEAD_DIM)
    dt = jax.nn.softplus(dt_raw.astype(f32) + dt_bias.astype(f32)).reshape(b, s, SSD_GROUPS, SSD_HPG)
    A = -jnp.exp(A_log.astype(f32)).reshape(SSD_GROUPS, SSD_HPG)
    y = ssd_chunked(xh, dt, A, Bm, Cm)
    y = y + D_skip.astype(f32).reshape(SSD_GROUPS, SSD_HPG)[..., None] * xh
    y = y.reshape(b, s, D_SSD) * jax.nn.silu(z.astype(f32))
    yg = y.reshape(b, s, SSD_GROUPS, D_SSD // SSD_GROUPS)
    yg = yg * lax.rsqrt(jnp.mean(yg * yg, axis=-1, keepdims=True) + GATED_NORM_EPS)
    return (yg.reshape(b, s, D_SSD) * norm_g.astype(f32)).astype(z.dtype)


def wkv7_scan(r, w, k, v, a, bb):
    bsz, _, h, n = r.shape

    def step(S, inp):
        r_t, w_t, k_t, v_t, a_t, b_t = inp
        sa = jnp.einsum('bhvk,bhk->bhv', S, a_t)
        S = S * w_t[:, :, None, :] + sa[..., None] * b_t[:, :, None, :] + v_t[..., None] * k_t[:, :, None, :]
        return S, jnp.einsum('bhvk,bhk->bhv', S, r_t)

    seq = (r.swapaxes(0, 1), w.swapaxes(0, 1), k.swapaxes(0, 1), v.swapaxes(0, 1),
           a.swapaxes(0, 1), bb.swapaxes(0, 1))
    S0 = jnp.zeros((bsz, h, n, n), jnp.float32)
    _, y = lax.scan(step, S0, seq)
    return y.swapaxes(0, 1)


def rwkv7_mixer(r, k, v, wd, ad, gd, w0, w2, a0, a2, g2, k_k, k_a, r_k, gn_w, gn_b):
    f32 = jnp.float32
    b, s, _ = r.shape
    H, N = RWKV_HEADS, HEAD_DIM
    r, k, v, wd, ad, gd = (t.astype(f32) for t in (r, k, v, wd, ad, gd))
    logw = -jax.nn.softplus(-(w0.astype(f32) + jnp.tanh(wd) @ w2.astype(f32))) - 0.5
    decay = jnp.exp(-jnp.exp(logw))
    a = jax.nn.sigmoid(a0.astype(f32) + ad @ a2.astype(f32))
    g = jax.nn.sigmoid(gd) @ g2.astype(f32)
    kk = (k * k_k.astype(f32)).reshape(b, s, H, N)
    kk = kk / jnp.maximum(jnp.sqrt(jnp.sum(kk * kk, axis=-1, keepdims=True)), 1e-12)
    k = k * (1.0 + (a - 1.0) * k_a.astype(f32))
    rh = r.reshape(b, s, H, N)
    kh = k.reshape(b, s, H, N)
    vh = v.reshape(b, s, H, N)
    ah = a.reshape(b, s, H, N)
    y = wkv7_scan(rh, decay.reshape(b, s, H, N), kh, vh, -kk, kk * ah)
    mu = jnp.mean(y, axis=-1, keepdims=True)
    var = jnp.mean(jnp.square(y - mu), axis=-1, keepdims=True)
    y = ((y - mu) * lax.rsqrt(var + GN_EPS)).reshape(b, s, D_RWKV) * gn_w.astype(f32) + gn_b.astype(f32)
    bonus = jnp.sum(rh * kh * r_k.astype(f32).reshape(H, N), axis=-1, keepdims=True) * vh
    y = y + bonus.reshape(b, s, D_RWKV)
    return y * g


def setup_inputs(seed: int = 0) -> dict:
    key = jax.random.key(seed)
    ks = jax.random.split(key, 32)
    f32 = jnp.float32
    L = DEPTH

    def nrm(k, shape, scale):
        return jax.random.normal(k, shape, f32) * scale

    dt0 = jnp.exp(jax.random.uniform(ks[5], (L, SSD_HEADS), f32, np.log(1e-3), np.log(1e-1)))
    w0_base = jnp.linspace(-6.0, -1.0, D_RWKV, dtype=f32) + 0.5
    return {
        "x": jax.random.normal(ks[0], (BATCH, SEQ, D_MODEL), f32),
        "norm1_g": 1.0 + nrm(ks[1], (L, D_MODEL), 0.02),
        "w_in": nrm(ks[2], (L, D_MODEL, D_IN), D_MODEL ** -0.5),
        "ssd_conv_w": nrm(ks[3], (L, CONV_WIDTH, D_XBC), CONV_WIDTH ** -0.5),
        "ssd_conv_b": nrm(ks[4], (L, D_XBC), 0.02),
        "ssd_dt_bias": dt0 + jnp.log(-jnp.expm1(-dt0)),
        "ssd_A_log": jnp.log(jax.random.uniform(ks[6], (L, SSD_HEADS), f32, 1.0, 16.0)),
        "ssd_D": 1.0 + nrm(ks[7], (L, SSD_HEADS), 0.1),
        "ssd_norm_g": 1.0 + nrm(ks[8], (L, D_SSD), 0.02),
        "rwkv_mu": jax.random.uniform(ks[9], (L, D_RWKV_IN), f32),
        "rwkv_w0": w0_base + nrm(ks[10], (L, D_RWKV), 0.1),
        "rwkv_w2": nrm(ks[11], (L, DECAY_LORA, D_RWKV), 0.1 * DECAY_LORA ** -0.5),
        "rwkv_a0": nrm(ks[12], (L, D_RWKV), 0.1),
        "rwkv_a2": nrm(ks[13], (L, AAA_LORA, D_RWKV), 0.1 * AAA_LORA ** -0.5),
        "rwkv_g2": nrm(ks[14], (L, GATE_LORA, D_RWKV), GATE_LORA ** -0.5),
        "rwkv_k_k": 0.85 + nrm(ks[15], (L, D_RWKV), 0.05),
        "rwkv_k_a": 1.0 + nrm(ks[16], (L, D_RWKV), 0.05),
        "rwkv_r_k": nrm(ks[17], (L, D_RWKV), 0.1),
        "rwkv_gn_w": 1.0 + nrm(ks[18], (L, D_RWKV), 0.02),
        "rwkv_gn_b": nrm(ks[19], (L, D_RWKV), 0.02),
        "w_out": nrm(ks[20], (L, D_MIX, D_MODEL), D_MIX ** -0.5),
        "norm2_g": 1.0 + nrm(ks[21], (L, D_MODEL), 0.02),
        "w_gate": nrm(ks[22], (L, D_MODEL, D_FF), D_MODEL ** -0.5),
        "w_up": nrm(ks[23], (L, D_MODEL, D_FF), D_MODEL ** -0.5),
        "w_down": nrm(ks[24], (L, D_FF, D_MODEL), D_FF ** -0.5),
        "norm_f_g": 1.0 + nrm(ks[25], (D_MODEL,), 0.02),
    }


def reference(x, norm1_g, w_in, ssd_conv_w, ssd_conv_b, ssd_dt_bias, ssd_A_log, ssd_D, ssd_norm_g,
              rwkv_mu, rwkv_w0, rwkv_w2, rwkv_a0, rwkv_a2, rwkv_g2, rwkv_k_k, rwkv_k_a, rwkv_r_k,
              rwkv_gn_w, rwkv_gn_b, w_out, norm2_g, w_gate, w_up, w_down, norm_f_g):
    h = x
    for l in range(DEPTH):
        u = rms_norm(h, norm1_g[l])
        P = u @ w_in[l]
        o1 = D_SSD
        o2 = o1 + D_XBC
        o3 = o2 + SSD_HEADS
        z = P[..., :o1]
        xbc = P[..., o1:o2]
        dt_raw = P[..., o2:o3]
        pr = P[..., o3:]
        prev = jnp.pad(pr, ((0, 0), (1, 0), (0, 0)))[:, :-1]
        pr = pr + (prev - pr) * rwkv_mu[l]
        c1 = D_RWKV
        c2 = 2 * D_RWKV
        c3 = 3 * D_RWKV
        c4 = c3 + DECAY_LORA
        c5 = c4 + AAA_LORA
        y_ssd = ssd_mixer(z, xbc, dt_raw, ssd_conv_w[l], ssd_conv_b[l], ssd_dt_bias[l],
                          ssd_A_log[l], ssd_D[l], ssd_norm_g[l])
        y_rwkv = rwkv7_mixer(pr[..., :c1], pr[..., c1:c2], pr[..., c2:c3], pr[..., c3:c4],
                             pr[..., c4:c5], pr[..., c5:], rwkv_w0[l], rwkv_w2[l], rwkv_a0[l],
                             rwkv_a2[l], rwkv_g2[l], rwkv_k_k[l], rwkv_k_a[l], rwkv_r_k[l],
                             rwkv_gn_w[l], rwkv_gn_b[l]).astype(h.dtype)
        h = h + jnp.concatenate([y_ssd, y_rwkv], axis=-1) @ w_out[l]
        v = rms_norm(h, norm2_g[l])
        h = h + (jax.nn.silu(v @ w_gate[l]) * (v @ w_up[l])) @ w_down[l]
    return rms_norm(h, norm_f_g)
```

```cpp
#include <hip/hip_runtime.h>
#include <cstdio>
#include <cstdint>

#define LAS __attribute__((address_space(3)))
typedef unsigned short bf16_t;
typedef short bf16x8 __attribute__((ext_vector_type(8)));
typedef float f32x4 __attribute__((ext_vector_type(4)));
typedef unsigned u32x4 __attribute__((ext_vector_type(4)));
typedef unsigned u32x2 __attribute__((ext_vector_type(2)));

constexpr int BATCH = 2, SEQ = 8192, DM = 2048, M = BATCH * SEQ;
constexpr int D_SSD = 2048, D_RWKV = 2048, D_MIX = 4096, NHEAD = 32, HD = 64, NGRP = 4, NSTATE = 128;
constexpr int D_XBC = 3072, D_IN = 11744, NP = 11776  , D_FF = 5632, NGU = 11264;
constexpr int LW = 96, LG = 256;
constexpr float RMS_EPS = 1e-6f, GATED_EPS = 1e-5f, GN_EPS = 64e-5f;
constexpr int O_Z = 0, O_XBC = 2048, O_DT = 5120, O_R = 5152, O_K = 7200, O_V = 9248, O_WD = 11296, O_AD = 11392, O_GD = 11488;
constexpr int MU_R = 0, MU_K = 2048, MU_V = 4096, MU_WD = 6144, MU_AD = 6240, MU_GD = 6336;

constexpr size_t MiB = 1u << 20;
constexpr size_t WS_CTL = 0, CTL_BYTES = 1 * MiB;
constexpr size_t WS_WIN = 1 * MiB;
constexpr size_t WS_WOUT = 47 * MiB;
constexpr size_t WS_G2 = 63 * MiB;
constexpr size_t WS_Z = 64 * MiB;
constexpr size_t WS_XBC = 128 * MiB;
constexpr size_t WS_V = 224 * MiB;
constexpr size_t WS_SM = 288 * MiB;
constexpr size_t WS_GD = 304 * MiB;
constexpr size_t WS_R = 312 * MiB;
constexpr size_t WS_K = 376 * MiB;
constexpr size_t WS_FREE = 440 * MiB;
constexpr size_t WS_H1 = 64 * MiB;
constexpr size_t WS_H1B = 192 * MiB;
constexpr size_t WS_ACT = 256 * MiB;
constexpr size_t WS_WGU = 440 * MiB;
constexpr size_t WS_WDN = 484 * MiB;
constexpr size_t WS_END = 512 * MiB;
static_assert(WS_WDN + (size_t)2048 * 5632 * 2 <= WS_END, "ws map");

struct Params {
    const float* in[26];
    float* out;
    unsigned char* ws;
};
enum { I_X = 0, I_N1G, I_WIN, I_CONVW, I_CONVB, I_DTB, I_ALOG, I_SSDD, I_SSDNG, I_MU, I_W0, I_W2, I_A0, I_A2, I_G2, I_KK, I_KA, I_RK, I_GNW, I_GNB, I_WOUT, I_N2G, I_WGATE, I_WUP, I_WDOWN, I_NFG };

__device__ __forceinline__ unsigned f2bf(float f) { unsigned u = __builtin_bit_cast(unsigned, f); return (u + 0x7fffu + ((u >> 16) & 1u)) >> 16; }
__device__ __forceinline__ unsigned pk2(float lo, float hi) { return f2bf(lo) | (f2bf(hi) << 16); }
__device__ __forceinline__ float bf2f(bf16_t v) { return __builtin_bit_cast(float, (unsigned)v << 16); }
__device__ __forceinline__ float wave_sum(float v) {
#pragma unroll
    for (int o = 1; o < 64; o <<= 1) v += __shfl_xor(v, o);
    return v;
}
__device__ __forceinline__ float sigmoidf_(float x) { return 1.f / (1.f + __expf(-x)); }
__device__ __forceinline__ float siluf_(float x) { return x / (1.f + __expf(-x)); }
__device__ __forceinline__ float softplusf_(float x) { return fmaxf(x, 0.f) + log1pf(__expf(-fabsf(x))); }

__device__ __forceinline__ void transpose_item(const float* W, int ldw, int K, bf16_t* WT, int n_dst0, int src_col0, const float* kscale, LAS float* scr, int kb, int nb, int lane) {
    const int k0 = 64 * kb, n0 = 32 * nb;
#pragma unroll 8
    for (int i = 0; i < 32; ++i) { const int kk = 2 * i + (lane >> 5); float v = W[(size_t)(k0 + kk) * ldw + src_col0 + n0 + (lane & 31)]; if (kscale) v *= kscale[k0 + kk]; scr[kk * 33 + (lane & 31)] = v; }
    asm volatile("s_waitcnt lgkmcnt(0)" ::: "memory");
    const int c = lane & 7;
#pragma unroll
    for (int j = 0; j < 4; ++j) { const int n = (lane >> 3) + 8 * j; const LAS float* s = scr + (8 * c) * 33 + n;
        u32x4 o; o.x = pk2(s[0 * 33], s[1 * 33]); o.y = pk2(s[2 * 33], s[3 * 33]); o.z = pk2(s[4 * 33], s[5 * 33]); o.w = pk2(s[6 * 33], s[7 * 33]);
        *(u32x4*)(WT + (size_t)(n_dst0 + n0 + n) * K + k0 + 8 * c) = o; }
    asm volatile("s_waitcnt lgkmcnt(0)" ::: "memory");
}
__device__ __forceinline__ void convert_seg(const float* W, int ldw, int K, bf16_t* WT, int n_dst0, int count, int src_col0, const float* kscale, LAS float* scr, int gw, int ngw, int lane) {
    const int nblk = count / 32, nit = (K / 64) * nblk;
    for (int it = gw; it < nit; it += ngw) transpose_item(W, ldw, K, WT, n_dst0, src_col0, kscale, scr, it / nblk, it % nblk, lane);
}
__device__ __forceinline__ void zero_rows(bf16_t* WT, int K, int n0, int count, int gw, int ngw, int lane) {
    const int chunks = count * K / 8;
    u32x4 z = {0u, 0u, 0u, 0u};
    for (int i = gw * 64 + lane; i < chunks; i += ngw * 64) *(u32x4*)(WT + (size_t)n0 * K + (size_t)i * 8) = z;
}

__device__ void phase_p0a(const Params& p, LAS unsigned char* lds, int wg, int nwg) {
    const int tid = threadIdx.x, lane = tid & 63, wave = tid >> 6;
    LAS float* scr = (LAS float*)(lds + wave * 16384);
    const int gw = wg * 8 + wave, ngw = nwg * 8;
    bf16_t* WIN = (bf16_t*)(p.ws + WS_WIN); bf16_t* WOUT = (bf16_t*)(p.ws + WS_WOUT);
    const float* w_in = p.in[I_WIN];
    convert_seg(w_in, D_IN, DM, WIN, 0, 2048, O_Z, nullptr, scr, gw, ngw, lane);
    convert_seg(w_in, D_IN, DM, WIN, 2048, 3072, O_XBC, nullptr, scr, gw, ngw, lane);
    convert_seg(w_in, D_IN, DM, WIN, 5120, 2048, O_R, nullptr, scr, gw, ngw, lane);
    convert_seg(w_in, D_IN, DM, WIN, 7168, 2048, O_K, nullptr, scr, gw, ngw, lane);
    convert_seg(w_in, D_IN, DM, WIN, 9216, 2048, O_V, nullptr, scr, gw, ngw, lane);
    convert_seg(w_in, D_IN, DM, WIN, 11264, 32, O_DT, nullptr, scr, gw, ngw, lane);
    convert_seg(w_in, D_IN, DM, WIN, 11296, 96, O_WD, nullptr, scr, gw, ngw, lane);
    convert_seg(w_in, D_IN, DM, WIN, 11392, 96, O_AD, nullptr, scr, gw, ngw, lane);
    zero_rows(WIN, DM, 11488, 32, gw, ngw, lane);
    convert_seg(w_in, D_IN, DM, WIN, 11520, 256, O_GD, nullptr, scr, gw, ngw, lane);
    convert_seg(p.in[I_WOUT], DM, D_MIX, WOUT, 0, 2048, 0, nullptr, scr, gw, ngw, lane);
    bf16_t* U = (bf16_t*)p.out; const float* x = p.in[I_X]; const float* g1 = p.in[I_N1G];
    for (int m = gw; m < M; m += ngw) {
        const f32x4* xr = (const f32x4*)(x + (size_t)m * DM) + lane; f32x4 v[8]; float s = 0.f;
#pragma unroll
        for (int j = 0; j < 8; ++j) { v[j] = xr[64 * j]; s += (v[j].x * v[j].x + v[j].y * v[j].y) + (v[j].z * v[j].z + v[j].w * v[j].w); }
        const float rstd = 1.f / sqrtf(wave_sum(s) * (1.f / DM) + RMS_EPS);
        u32x2* o = (u32x2*)(U + (size_t)m * DM) + lane;
#pragma unroll
        for (int j = 0; j < 8; ++j) { const f32x4 g = ((const f32x4*)g1)[64 * j + lane]; u32x2 w; w.x = pk2(v[j].x * rstd * g.x, v[j].y * rstd * g.y); w.y = pk2(v[j].z * rstd * g.z, v[j].w * rstd * g.w); o[64 * j] = w; }
    }
}
__device__ void phase_p0b(const Params& p, LAS unsigned char* lds, int wg, int nwg) {
    const int tid = threadIdx.x, lane = tid & 63, wave = tid >> 6;
    LAS float* scr = (LAS float*)(lds + wave * 16384);
    const int gw = wg * 8 + wave, ngw = nwg * 8;
    bf16_t* WGU = (bf16_t*)(p.ws + WS_WGU); bf16_t* WDN = (bf16_t*)(p.ws + WS_WDN);
    const int nblk = 4, per_half = (DM / 64) * nblk, nit = (D_FF / 128) * 2 * per_half;
    for (int it = gw; it < nit; it += ngw) {
        const int th = it / per_half, r = it % per_half, tile = th >> 1, half = th & 1;
        transpose_item(half ? p.in[I_WUP] : p.in[I_WGATE], D_FF, DM, WGU, 256 * tile + 128 * half, 128 * tile, p.in[I_N2G], scr, r / nblk, r % nblk, lane);
    }
    convert_seg(p.in[I_WDOWN], DM, D_FF, WDN, 0, 2048, 0, nullptr, scr, gw, ngw, lane);
}

template <class Epi>
__device__ void gemm_simple(const bf16_t* A, const bf16_t* Bt, int Mr, int N, int K, Epi& E, int wg, int nwg) {
    const int tid = threadIdx.x, lane = tid & 63, wave = tid >> 6, fr = lane & 15, fq = lane >> 4;
    const int gw = wg * 8 + wave, ngw = nwg * 8;
    const int nrb = Mr / 32, nit = (N / 256) * nrb;
    for (int it = gw; it < nit; it += ngw) {
        const int pn = it / nrb, rb = it % nrb, r0 = rb * 32;
        f32x4 acc[2][16];
#pragma unroll
        for (int a = 0; a < 2; ++a)
#pragma unroll
            for (int j = 0; j < 16; ++j) acc[a][j] = (f32x4){0.f, 0.f, 0.f, 0.f};
        const bf16_t* ap = A + (size_t)(r0 + fr) * K + 8 * fq;
        const bf16_t* bp = Bt + (size_t)(256 * pn + fr) * K + 8 * fq;
        for (int k0 = 0; k0 < K; k0 += 32) {
            const bf16x8 a0 = *(const bf16x8*)(ap + k0), a1 = *(const bf16x8*)(ap + (size_t)16 * K + k0);
#pragma unroll
            for (int j = 0; j < 16; ++j) {
                const bf16x8 b = *(const bf16x8*)(bp + (size_t)(16 * j) * K + k0);
                acc[0][j] = __builtin_amdgcn_mfma_f32_16x16x32_bf16(b, a0, acc[0][j], 0, 0, 0);
                acc[1][j] = __builtin_amdgcn_mfma_f32_16x16x32_bf16(b, a1, acc[1][j], 0, 0, 0);
            }
        }
#pragma unroll
        for (int a = 0; a < 2; ++a) {
            const int row = r0 + 16 * a + fr;
            E.begin();
            if constexpr (Epi::PAIR) {
#pragma unroll
                for (int j = 0; j < 8; ++j) E.pair(row, pn, 16 * j + 4 * fq, acc[a][j], acc[a][j + 8]);
            } else {
#pragma unroll
                for (int j = 0; j < 16; ++j) E.quad(row, pn, 16 * j + 4 * fq, acc[a][j]);
            }
            E.end(row);
        }
    }
}

struct EpiP {
    static constexpr bool PAIR = false;
    unsigned char* ws;
    __device__ __forceinline__ void begin() {}
    __device__ __forceinline__ void end(int) {}
    __device__ __forceinline__ void quad(int row, int pn, int c, f32x4 v) {
        if (pn == 44) { *(f32x4*)((float*)(ws + WS_SM) + (size_t)row * 256 + c) = v; return; }
        bf16_t* base; int ld, col;
        if (pn < 8) { base = (bf16_t*)(ws + WS_Z); ld = 2048; col = pn * 256 + c; }
        else if (pn < 20) { base = (bf16_t*)(ws + WS_XBC); ld = 3072; col = (pn - 8) * 256 + c; }
        else if (pn < 28) { base = (bf16_t*)(ws + WS_R); ld = 2048; col = (pn - 20) * 256 + c; }
        else if (pn < 36) { base = (bf16_t*)(ws + WS_K); ld = 2048; col = (pn - 28) * 256 + c; }
        else if (pn < 44) { base = (bf16_t*)(ws + WS_V); ld = 2048; col = (pn - 36) * 256 + c; }
        else { base = (bf16_t*)(ws + WS_GD); ld = 256; col = c; }
        u32x2 w; w.x = pk2(v.x, v.y); w.y = pk2(v.z, v.w);
        *(u32x2*)(base + (size_t)row * ld + col) = w;
    }
};
struct EpiOut {
    static constexpr bool PAIR = false;
    const float* x; float* h1; bf16_t* h1b; float* rowss; float s;
    __device__ __forceinline__ void begin() { s = 0.f; }
    __device__ __forceinline__ void quad(int row, int pn, int c, f32x4 v) {
        const size_t off = (size_t)row * DM + pn * 256 + c;
        const f32x4 h = *(const f32x4*)(x + off) + v;
        *(f32x4*)(h1 + off) = h;
        u32x2 w; w.x = pk2(h.x, h.y); w.y = pk2(h.z, h.w); *(u32x2*)(h1b + off) = w;
        s += (h.x * h.x + h.y * h.y) + (h.z * h.z + h.w * h.w);
    }
    __device__ __forceinline__ void end(int row) { float t = s; t += __shfl_xor(t, 16); t += __shfl_xor(t, 32); if ((threadIdx.x & 63) < 16) atomicAdd(rowss + row, t); }
};
struct EpiGU {
    static constexpr bool PAIR = true;
    const float* rowss; bf16_t* act; float rstd;
    __device__ __forceinline__ void begin() {}
    __device__ __forceinline__ void end(int) {}
    __device__ __forceinline__ void pair(int row, int pn, int c, f32x4 g, f32x4 u) {
        const float rs = 1.f / sqrtf(rowss[row] * (1.f / DM) + RMS_EPS);
        g = g * rs; u = u * rs;
        u32x2 w; w.x = pk2(siluf_(g.x) * u.x, siluf_(g.y) * u.y); w.y = pk2(siluf_(g.z) * u.z, siluf_(g.w) * u.w);
        *(u32x2*)(act + (size_t)row * D_FF + pn * 128 + c) = w;
    }
};
struct EpiDown {
    static constexpr bool PAIR = false;
    const float* h1; float* out; float* rowss; float s;
    __device__ __forceinline__ void begin() { s = 0.f; }
    __device__ __forceinline__ void quad(int row, int pn, int c, f32x4 v) {
        const size_t off = (size_t)row * DM + pn * 256 + c;
        const f32x4 h = *(const f32x4*)(h1 + off) + v;
        *(f32x4*)(out + off) = h;
        s += (h.x * h.x + h.y * h.y) + (h.z * h.z + h.w * h.w);
    }
    __device__ __forceinline__ void end(int row) { float t = s; t += __shfl_xor(t, 16); t += __shfl_xor(t, 32); if ((threadIdx.x & 63) < 16) atomicAdd(rowss + row, t); }
};

__device__ void phase_ssd_seq(const Params& p, LAS unsigned char* lds, int wg, int nwg) {
    const int tid = threadIdx.x;
    LAS float* xs = (LAS float*)lds; LAS float* Bs = xs + 64 * 64; LAS float* Cs = Bs + 64 * 128; LAS float* ys = Cs + 64 * 128; LAS float* dts = ys + 64 * 64; LAS float* dAs = dts + 64;
    const bf16_t* XBC = (const bf16_t*)(p.ws + WS_XBC); const bf16_t* Z = (const bf16_t*)(p.ws + WS_Z); const float* SM = (const float*)(p.ws + WS_SM);
    bf16_t* YG = (bf16_t*)(p.ws + WS_FREE);
    const float* cw = p.in[I_CONVW]; const float* cb = p.in[I_CONVB];
    for (int unit = wg; unit < BATCH * NHEAD; unit += nwg) {
        const int b = unit / NHEAD, e = unit % NHEAD, g = e / 8;
        const float Aneg = -__expf(p.in[I_ALOG][e]), dtb = p.in[I_DTB][e], Dsk = p.in[I_SSDD][e];
        const int pp = tid >> 3, nq = tid & 7;
        float h[16];
#pragma unroll
        for (int i = 0; i < 16; ++i) h[i] = 0.f;
        int ccol = -1; if (tid < 64) ccol = e * 64 + tid; else if (tid < 192) ccol = 2048 + g * 128 + (tid - 64); else if (tid < 320) ccol = 2560 + g * 128 + (tid - 192);
        float cw0 = 0, cw1 = 0, cw2 = 0, cw3 = 0, cbias = 0;
        if (ccol >= 0) { cw0 = cw[0 * D_XBC + ccol]; cw1 = cw[1 * D_XBC + ccol]; cw2 = cw[2 * D_XBC + ccol]; cw3 = cw[3 * D_XBC + ccol]; cbias = cb[ccol]; }
        float u1 = 0.f, u2 = 0.f, u3 = 0.f;
        for (int t0 = 0; t0 < SEQ; t0 += 64) {
            const size_t m0 = (size_t)b * SEQ + t0;
            if (ccol >= 0) {
                for (int t = 0; t < 64; ++t) {
                    const float u0 = bf2f(XBC[(m0 + t) * D_XBC + ccol]);
                    const float y = siluf_(cw0 * u3 + cw1 * u2 + cw2 * u1 + cw3 * u0 + cbias);
                    u3 = u2; u2 = u1; u1 = u0;
                    if (tid < 64) xs[t * 64 + tid] = y; else if (tid < 192) Bs[t * 128 + (tid - 64)] = y; else Cs[t * 128 + (tid - 192)] = y;
                }
            } else if (tid >= 448) {
                const int t = tid - 448;
                const float dt = softplusf_(SM[(m0 + t) * 256 + e] + dtb);
                dts[t] = dt; dAs[t] = __expf(dt * Aneg);
            }
            __syncthreads();
            for (int t = 0; t < 64; ++t) {
                const float xv = xs[t * 64 + pp], dtx = dts[t] * xv, dA = dAs[t];
                float part = 0.f;
#pragma unroll
                for (int i = 0; i < 16; ++i) { h[i] = h[i] * dA + dtx * Bs[t * 128 + 16 * nq + i]; part += h[i] * Cs[t * 128 + 16 * nq + i]; }
                part += __shfl_xor(part, 1); part += __shfl_xor(part, 2); part += __shfl_xor(part, 4);
                if (nq == 0) ys[t * 64 + pp] = part + Dsk * xv;
            }
            __syncthreads();
            for (int i = tid; i < 64 * 64; i += 512) {
                const int t = i >> 6, c = i & 63;
                const float z = bf2f(Z[(m0 + t) * D_SSD + e * 64 + c]);
                YG[(m0 + t) * D_SSD + e * 64 + c] = (bf16_t)f2bf(ys[i] * siluf_(z));
            }
            __syncthreads();
        }
    }
}
__device__ void phase_ssd_norm(const Params& p, bf16_t* ymix, int wg, int nwg) {
    const int tid = threadIdx.x, lane = tid & 63, wave = tid >> 6;
    const bf16_t* YG = (const bf16_t*)(p.ws + WS_FREE); const float* ng = p.in[I_SSDNG];
    for (int it = wg * 8 + wave; it < M * NGRP; it += nwg * 8) {
        const int m = it >> 2, g = it & 3;
        const u32x4 raw = *(const u32x4*)(YG + (size_t)m * D_SSD + g * 512 + lane * 8);
        float v[8]; v[0] = __builtin_bit_cast(float, raw.x << 16); v[1] = __builtin_bit_cast(float, raw.x & 0xffff0000u); v[2] = __builtin_bit_cast(float, raw.y << 16); v[3] = __builtin_bit_cast(float, raw.y & 0xffff0000u);
        v[4] = __builtin_bit_cast(float, raw.z << 16); v[5] = __builtin_bit_cast(float, raw.z & 0xffff0000u); v[6] = __builtin_bit_cast(float, raw.w << 16); v[7] = __builtin_bit_cast(float, raw.w & 0xffff0000u);
        float s = 0.f;
#pragma unroll
        for (int i = 0; i < 8; ++i) s += v[i] * v[i];
        const float rstd = 1.f / sqrtf(wave_sum(s) * (1.f / 512.f) + GATED_EPS);
        const float* gp = ng + g * 512 + lane * 8;
        u32x4 o; o.x = pk2(v[0] * rstd * gp[0], v[1] * rstd * gp[1]); o.y = pk2(v[2] * rstd * gp[2], v[3] * rstd * gp[3]); o.z = pk2(v[4] * rstd * gp[4], v[5] * rstd * gp[5]); o.w = pk2(v[6] * rstd * gp[6], v[7] * rstd * gp[7]);
        *(u32x4*)(ymix + (size_t)m * D_MIX + g * 512 + lane * 8) = o;
    }
}

__device__ void phase_rwkv_seq(const Params& p, bf16_t* ymix, LAS unsigned char* lds, int wg, int nwg) {
    const int tid = threadIdx.x, lane = tid & 63, wave = tid >> 6;
    constexpr int T = 32;
    LAS float* tw = (LAS float*)lds;
    LAS float* ad = tw + T * 96;
    LAS float* sg = ad + T * 96;
    LAS float* rr = sg + T * 256;
    LAS float* ww = rr + T * 64; LAS float* kp = ww + T * 64; LAS float* vv = kp + T * 64; LAS float* an = vv + T * 64; LAS float* bb = an + T * 64; LAS float* gg = bb + T * 64; LAS float* yy = gg + T * 64;
    LAS float* bon = yy + T * 64;
    const float* SM = (const float*)(p.ws + WS_SM); const bf16_t* GD = (const bf16_t*)(p.ws + WS_GD);
    const bf16_t* R = (const bf16_t*)(p.ws + WS_R); const bf16_t* Kb = (const bf16_t*)(p.ws + WS_K); const bf16_t* V = (const bf16_t*)(p.ws + WS_V);
    const float* mu = p.in[I_MU];
    for (int unit = wg; unit < BATCH * NHEAD; unit += nwg) {
        const int b = unit / NHEAD, hh = unit % NHEAD;
        const int row = tid >> 3, l8 = tid & 7;
        float S[8];
#pragma unroll
        for (int i = 0; i < 8; ++i) S[i] = 0.f;
        for (int t0 = 0; t0 < SEQ; t0 += T) {
            const size_t m0 = (size_t)b * SEQ + t0;
            for (int i = tid; i < T * 96; i += 512) {
                const int t = i / 96, j = i % 96; const size_t m = m0 + t; const bool hp = (t0 + t) > 0;
                { const float cur = SM[m * 256 + 32 + j], prev = hp ? SM[(m - 1) * 256 + 32 + j] : 0.f; tw[i] = tanhf(cur + (prev - cur) * mu[MU_WD + j]); }
                { const float cur = SM[m * 256 + 128 + j], prev = hp ? SM[(m - 1) * 256 + 128 + j] : 0.f; ad[i] = cur + (prev - cur) * mu[MU_AD + j]; }
            }
            for (int i = tid; i < T * 256; i += 512) {
                const int t = i >> 8, j = i & 255; const size_t m = m0 + t; const bool hp = (t0 + t) > 0;
                const float cur = bf2f(GD[m * 256 + j]), prev = hp ? bf2f(GD[(m - 1) * 256 + j]) : 0.f;
                sg[i] = sigmoidf_(cur + (prev - cur) * mu[MU_GD + j]);
            }
            __syncthreads();
            for (int t = wave; t < T; t += 8) {
                const int c = hh * 64 + lane; const size_t m = m0 + t; const bool hp = (t0 + t) > 0;
                float lw = 0.f, la = 0.f, lg = 0.f;
                for (int j = 0; j < 96; ++j) { lw += tw[t * 96 + j] * p.in[I_W2][(size_t)j * D_RWKV + c]; la += ad[t * 96 + j] * p.in[I_A2][(size_t)j * D_RWKV + c]; }
                for (int j = 0; j < 256; ++j) lg += sg[t * 256 + j] * p.in[I_G2][(size_t)j * D_RWKV + c];
                const float logw = -softplusf_(-(p.in[I_W0][c] + lw)) - 0.5f;
                const float decay = __expf(-__expf(logw));
                const float a = sigmoidf_(p.in[I_A0][c] + la);
                float r, k, v;
                { const float cur = bf2f(R[m * 2048 + c]), prev = hp ? bf2f(R[(m - 1) * 2048 + c]) : 0.f; r = cur + (prev - cur) * mu[MU_R + c]; }
                { const float cur = bf2f(Kb[m * 2048 + c]), prev = hp ? bf2f(Kb[(m - 1) * 2048 + c]) : 0.f; k = cur + (prev - cur) * mu[MU_K + c]; }
                { const float cur = bf2f(V[m * 2048 + c]), prev = hp ? bf2f(V[(m - 1) * 2048 + c]) : 0.f; v = cur + (prev - cur) * mu[MU_V + c]; }
                const float kk = k * p.in[I_KK][c];
                const float nrm = fmaxf(sqrtf(wave_sum(kk * kk)), 1e-12f);
                const float kkn = kk / nrm;
                const float kpr = k * (1.f + (a - 1.f) * p.in[I_KA][c]);
                const float bo = wave_sum(r * kpr * p.in[I_RK][c]);
                rr[t * 64 + lane] = r; ww[t * 64 + lane] = decay; kp[t * 64 + lane] = kpr; vv[t * 64 + lane] = v; an[t * 64 + lane] = -kkn; bb[t * 64 + lane] = kkn * a; gg[t * 64 + lane] = lg;
                if (lane == 0) bon[t] = bo;
            }
            __syncthreads();
            for (int t = 0; t < T; ++t) {
                float sa = 0.f;
#pragma unroll
                for (int i = 0; i < 8; ++i) sa += S[i] * an[t * 64 + 8 * l8 + i];
                sa += __shfl_xor(sa, 1); sa += __shfl_xor(sa, 2); sa += __shfl_xor(sa, 4);
                const float vr = vv[t * 64 + row]; float yp = 0.f;
#pragma unroll
                for (int i = 0; i < 8; ++i) { const int kx = t * 64 + 8 * l8 + i; S[i] = S[i] * ww[kx] + sa * bb[kx] + vr * kp[kx]; yp += S[i] * rr[kx]; }
                yp += __shfl_xor(yp, 1); yp += __shfl_xor(yp, 2); yp += __shfl_xor(yp, 4);
                if (l8 == 0) yy[t * 64 + row] = yp;
            }
            __syncthreads();
            for (int t = wave; t < T; t += 8) {
                const int c = hh * 64 + lane; const size_t m = m0 + t;
                const float yv = yy[t * 64 + lane];
                const float mean = wave_sum(yv) * (1.f / 64.f); const float d = yv - mean;
                const float var = wave_sum(d * d) * (1.f / 64.f);
                float o = d * (1.f / sqrtf(var + GN_EPS)) * p.in[I_GNW][c] + p.in[I_GNB][c];
                o += bon[t] * vv[t * 64 + lane];
                o *= gg[t * 64 + lane];
                ymix[m * D_MIX + 2048 + c] = (bf16_t)f2bf(o);
            }
            __syncthreads();
        }
    }
}

__device__ void phase_final(const Params& p, int wg, int nwg) {
    const int tid = threadIdx.x, lane = tid & 63, wave = tid >> 6;
    const float* rowss2 = (const float*)(p.ws + WS_CTL) + M; const float* gf = p.in[I_NFG];
    for (int m = wg * 8 + wave; m < M; m += nwg * 8) {
        const float rstd = 1.f / sqrtf(rowss2[m] * (1.f / DM) + RMS_EPS);
        f32x4* o = (f32x4*)(p.out + (size_t)m * DM) + lane;
#pragma unroll
        for (int j = 0; j < 8; ++j) { const f32x4 g = ((const f32x4*)gf)[64 * j + lane]; f32x4 v = o[64 * j]; v = v * rstd * g; o[64 * j] = v; }
    }
}

template <int PH>
__global__ void __launch_bounds__(512, 2) k_phase(Params p) {
    extern __shared__ __attribute__((aligned(16))) unsigned char lds_raw[];
    LAS unsigned char* lds = (LAS unsigned char*)lds_raw;
    const int wg = blockIdx.x, nwg = gridDim.x;
    bf16_t* ymix = (bf16_t*)p.out;
    float* rowss1 = (float*)(p.ws + WS_CTL); float* rowss2 = rowss1 + M;
    if constexpr (PH == 0) phase_p0a(p, lds, wg, nwg);
    if constexpr (PH == 1) { EpiP E{p.ws}; gemm_simple((const bf16_t*)p.out, (const bf16_t*)(p.ws + WS_WIN), M, NP, DM, E, wg, nwg); }
    if constexpr (PH == 2) phase_ssd_seq(p, lds, wg, nwg);
    if constexpr (PH == 3) phase_ssd_norm(p, ymix, wg, nwg);
    if constexpr (PH == 4) phase_rwkv_seq(p, ymix, lds, wg, nwg);
    if constexpr (PH == 5) { phase_p0b(p, lds, wg, nwg); }
    if constexpr (PH == 6) { EpiOut E{p.in[I_X], (float*)(p.ws + WS_H1), (bf16_t*)(p.ws + WS_H1B), rowss1, 0.f}; gemm_simple(ymix, (const bf16_t*)(p.ws + WS_WOUT), M, DM, D_MIX, E, wg, nwg); }
    if constexpr (PH == 7) { EpiGU E{rowss1, (bf16_t*)(p.ws + WS_ACT), 0.f}; gemm_simple((const bf16_t*)(p.ws + WS_H1B), (const bf16_t*)(p.ws + WS_WGU), M, NGU, DM, E, wg, nwg); }
    if constexpr (PH == 8) { EpiDown E{(const float*)(p.ws + WS_H1), p.out, rowss2, 0.f}; gemm_simple((const bf16_t*)(p.ws + WS_ACT), (const bf16_t*)(p.ws + WS_WDN), M, DM, D_FF, E, wg, nwg); }
    if constexpr (PH == 9) phase_final(p, wg, nwg);
}

constexpr int LDS_BYTES = 131072;
template <int PH> static void launch_phase(const Params& p, int grid, hipStream_t stream) {
    static bool attr = false;
    if (!attr) { (void)hipFuncSetAttribute((const void*)k_phase<PH>, hipFuncAttributeMaxDynamicSharedMemorySize, LDS_BYTES); attr = true; }
    hipLaunchKernelGGL(k_phase<PH>, dim3(grid), dim3(512), LDS_BYTES, stream, p);
}

extern "C" void kernel_launch(void* const* d_in, const int* in_sizes, int n_in, void* d_out, int out_size, void* d_ws, size_t ws_size, hipStream_t stream) {
    if (n_in != 26 || ws_size < WS_END) { fprintf(stderr, "kernel_launch: unexpected n_in %d / ws_size %zu\n", n_in, ws_size); return; }
    Params p{};
    for (int i = 0; i < 26; ++i) p.in[i] = (const float*)d_in[i];
    p.out = (float*)d_out; p.ws = (unsigned char*)d_ws;
    (void)hipMemsetAsync((char*)d_ws + WS_CTL, 0, CTL_BYTES, stream);
    const int grid = 256;
    launch_phase<0>(p, grid, stream);
    launch_phase<1>(p, grid, stream);
    launch_phase<2>(p, grid, stream);
    launch_phase<3>(p, grid, stream);
    launch_phase<4>(p, grid, stream);
    launch_phase<5>(p, grid, stream);
    launch_phase<6>(p, grid, stream);
    launch_phase<7>(p, grid, stream);
    launch_phase<8>(p, grid, stream);
    launch_phase<9>(p, grid, stream);
}
```

```cpp
#include <hip/hip_runtime.h>
#include <hip/hip_cooperative_groups.h>
#include <cstdio>
#include <cstdint>

#define LAS __attribute__((address_space(3)))
namespace cg = cooperative_groups;
typedef unsigned short bf16_t;
typedef short bf16x8 __attribute__((ext_vector_type(8)));
typedef float f32x4 __attribute__((ext_vector_type(4)));
typedef unsigned u32x4 __attribute__((ext_vector_type(4)));
typedef unsigned u32x2 __attribute__((ext_vector_type(2)));

constexpr int BATCH = 2, SEQ = 8192, DM = 2048, M = BATCH * SEQ;
constexpr int D_SSD = 2048, D_RWKV = 2048, D_MIX = 4096, NHEAD = 32, HD = 64, NGRP = 4, NSTATE = 128;
constexpr int D_XBC = 3072, D_IN = 11744, NP = 11776  , D_FF = 5632, NGU = 11264;
constexpr int LW = 96, LG = 256;
constexpr float RMS_EPS = 1e-6f, GATED_EPS = 1e-5f, GN_EPS = 64e-5f;
constexpr int O_Z = 0, O_XBC = 2048, O_DT = 5120, O_R = 5152, O_K = 7200, O_V = 9248, O_WD = 11296, O_AD = 11392, O_GD = 11488;
constexpr int MU_R = 0, MU_K = 2048, MU_V = 4096, MU_WD = 6144, MU_AD = 6240, MU_GD = 6336;

constexpr size_t MiB = 1u << 20;
constexpr size_t WS_CTL = 0, CTL_BYTES = 1 * MiB;
constexpr size_t WS_WIN = 1 * MiB;
constexpr size_t WS_WOUT = 47 * MiB;
constexpr size_t WS_G2 = 63 * MiB;
constexpr size_t WS_Z = 64 * MiB;
constexpr size_t WS_XBC = 128 * MiB;
constexpr size_t WS_V = 224 * MiB;
constexpr size_t WS_SM = 288 * MiB;
constexpr size_t WS_GD = 304 * MiB;
constexpr size_t WS_R = 312 * MiB;
constexpr size_t WS_K = 376 * MiB;
constexpr size_t WS_FREE = 440 * MiB;
constexpr size_t WS_H1 = 64 * MiB;
constexpr size_t WS_H1B = 192 * MiB;
constexpr size_t WS_ACT = 256 * MiB;
constexpr size_t WS_WGU = 440 * MiB;
constexpr size_t WS_WDN = 484 * MiB;
constexpr size_t WS_END = 512 * MiB;
static_assert(WS_WDN + (size_t)2048 * 5632 * 2 <= WS_END, "ws map");

struct Params {
    const float* in[26];
    float* out;
    unsigned char* ws;
};
enum { I_X = 0, I_N1G, I_WIN, I_CONVW, I_CONVB, I_DTB, I_ALOG, I_SSDD, I_SSDNG, I_MU, I_W0, I_W2, I_A0, I_A2, I_G2, I_KK, I_KA, I_RK, I_GNW, I_GNB, I_WOUT, I_N2G, I_WGATE, I_WUP, I_WDOWN, I_NFG };

__device__ __forceinline__ unsigned f2bf(float f) { unsigned u = __builtin_bit_cast(unsigned, f); return (u + 0x7fffu + ((u >> 16) & 1u)) >> 16; }
__device__ __forceinline__ unsigned pk2(float lo, float hi) { return f2bf(lo) | (f2bf(hi) << 16); }
__device__ __forceinline__ float bf2f(bf16_t v) { return __builtin_bit_cast(float, (unsigned)v << 16); }
__device__ __forceinline__ float wave_sum(float v) {
#pragma unroll
    for (int o = 1; o < 64; o <<= 1) v += __shfl_xor(v, o);
    return v;
}
__device__ __forceinline__ int otid() { int t = threadIdx.x; asm volatile("" : "+v"(t)); return t; }
__device__ __forceinline__ float sigmoidf_(float x) { return 1.f / (1.f + __expf(-x)); }
__device__ __forceinline__ float siluf_(float x) { return x / (1.f + __expf(-x)); }
__device__ __forceinline__ float softplusf_(float x) { return fmaxf(x, 0.f) + log1pf(__expf(-fabsf(x))); }

__device__ __forceinline__ void transpose_item(const float* W, int ldw, int K, bf16_t* WT, int n_dst0, int src_col0, const float* kscale, LAS float* scr, int kb, int nb, int lane) {
    const int k0 = 64 * kb, n0 = 32 * nb;
#pragma unroll 8
    for (int i = 0; i < 32; ++i) { const int kk = 2 * i + (lane >> 5); float v = W[(size_t)(k0 + kk) * ldw + src_col0 + n0 + (lane & 31)]; if (kscale) v *= kscale[k0 + kk]; scr[kk * 33 + (lane & 31)] = v; }
    asm volatile("s_waitcnt lgkmcnt(0)" ::: "memory");
    const int c = lane & 7;
#pragma unroll
    for (int j = 0; j < 4; ++j) { const int n = (lane >> 3) + 8 * j; const LAS float* s = scr + (8 * c) * 33 + n;
        u32x4 o; o.x = pk2(s[0 * 33], s[1 * 33]); o.y = pk2(s[2 * 33], s[3 * 33]); o.z = pk2(s[4 * 33], s[5 * 33]); o.w = pk2(s[6 * 33], s[7 * 33]);
        *(u32x4*)(WT + (size_t)(n_dst0 + n0 + n) * K + k0 + 8 * c) = o; }
    asm volatile("s_waitcnt lgkmcnt(0)" ::: "memory");
}
__device__ __forceinline__ void convert_seg(const float* W, int ldw, int K, bf16_t* WT, int n_dst0, int count, int src_col0, const float* kscale, LAS float* scr, int gw, int ngw, int lane) {
    const int nblk = count / 32, nit = (K / 64) * nblk;
    for (int it = gw; it < nit; it += ngw) transpose_item(W, ldw, K, WT, n_dst0, src_col0, kscale, scr, it / nblk, it % nblk, lane);
}
__device__ __forceinline__ void zero_rows(bf16_t* WT, int K, int n0, int count, int gw, int ngw, int lane) {
    const int chunks = count * K / 8;
    u32x4 z = {0u, 0u, 0u, 0u};
    for (int i = gw * 64 + lane; i < chunks; i += ngw * 64) *(u32x4*)(WT + (size_t)n0 * K + (size_t)i * 8) = z;
}

__device__ void phase_p0a(const Params& p, LAS unsigned char* lds, int wg, int nwg) {
    const int tid = otid(), lane = tid & 63, wave = tid >> 6;
    LAS float* scr = (LAS float*)(lds + wave * 16384);
    const int gw = wg * 8 + wave, ngw = nwg * 8;
    bf16_t* WIN = (bf16_t*)(p.ws + WS_WIN); bf16_t* WOUT = (bf16_t*)(p.ws + WS_WOUT);
    const float* w_in = p.in[I_WIN];
    convert_seg(w_in, D_IN, DM, WIN, 0, 2048, O_Z, nullptr, scr, gw, ngw, lane);
    convert_seg(w_in, D_IN, DM, WIN, 2048, 3072, O_XBC, nullptr, scr, gw, ngw, lane);
    convert_seg(w_in, D_IN, DM, WIN, 5120, 2048, O_R, nullptr, scr, gw, ngw, lane);
    convert_seg(w_in, D_IN, DM, WIN, 7168, 2048, O_K, nullptr, scr, gw, ngw, lane);
    convert_seg(w_in, D_IN, DM, WIN, 9216, 2048, O_V, nullptr, scr, gw, ngw, lane);
    convert_seg(w_in, D_IN, DM, WIN, 11264, 32, O_DT, nullptr, scr, gw, ngw, lane);
    convert_seg(w_in, D_IN, DM, WIN, 11296, 96, O_WD, nullptr, scr, gw, ngw, lane);
    convert_seg(w_in, D_IN, DM, WIN, 11392, 96, O_AD, nullptr, scr, gw, ngw, lane);
    zero_rows(WIN, DM, 11488, 32, gw, ngw, lane);
    convert_seg(w_in, D_IN, DM, WIN, 11520, 256, O_GD, nullptr, scr, gw, ngw, lane);
    convert_seg(p.in[I_WOUT], DM, D_MIX, WOUT, 0, 2048, 0, nullptr, scr, gw, ngw, lane);
    convert_seg(p.in[I_G2], D_RWKV, LG, (bf16_t*)(p.ws + WS_G2), 0, 2048, 0, nullptr, scr, gw, ngw, lane);
    bf16_t* U = (bf16_t*)p.out; const float* x = p.in[I_X]; const float* g1 = p.in[I_N1G];
    for (int m = gw; m < M; m += ngw) {
        const f32x4* xr = (const f32x4*)(x + (size_t)m * DM) + lane; f32x4 v[8]; float s = 0.f;
#pragma unroll
        for (int j = 0; j < 8; ++j) { v[j] = xr[64 * j]; s += (v[j].x * v[j].x + v[j].y * v[j].y) + (v[j].z * v[j].z + v[j].w * v[j].w); }
        const float rstd = 1.f / sqrtf(wave_sum(s) * (1.f / DM) + RMS_EPS);
        u32x2* o = (u32x2*)(U + (size_t)m * DM) + lane;
#pragma unroll
        for (int j = 0; j < 8; ++j) { const f32x4 g = ((const f32x4*)g1)[64 * j + lane]; u32x2 w; w.x = pk2(v[j].x * rstd * g.x, v[j].y * rstd * g.y); w.y = pk2(v[j].z * rstd * g.z, v[j].w * rstd * g.w); o[64 * j] = w; }
    }
}
__device__ void phase_p0b(const Params& p, LAS unsigned char* lds, int wg, int nwg) {
    const int tid = otid(), lane = tid & 63, wave = tid >> 6;
    LAS float* scr = (LAS float*)(lds + wave * 16384);
    const int gw = wg * 8 + wave, ngw = nwg * 8;
    bf16_t* WGU = (bf16_t*)(p.ws + WS_WGU); bf16_t* WDN = (bf16_t*)(p.ws + WS_WDN);
    const int nblk = 4, per_half = (DM / 64) * nblk, nit = (D_FF / 128) * 2 * per_half;
    for (int it = gw; it < nit; it += ngw) {
        const int th = it / per_half, r = it % per_half, tile = th >> 1, half = th & 1;
        transpose_item(half ? p.in[I_WUP] : p.in[I_WGATE], D_FF, DM, WGU, 256 * tile + 128 * half, 128 * tile, p.in[I_N2G], scr, r / nblk, r % nblk, lane);
    }
    convert_seg(p.in[I_WDOWN], DM, D_FF, WDN, 0, 2048, 0, nullptr, scr, gw, ngw, lane);
}

namespace pg8 {
#define PG8_LAS __attribute__((address_space(3)))
typedef unsigned short bf16_t;
typedef short bf16x8 __attribute__((ext_vector_type(8)));
typedef float f32x4 __attribute__((ext_vector_type(4)));
typedef unsigned u32x4 __attribute__((ext_vector_type(4)));
constexpr int BM = 256, BK = 64, HALF = 128, HTB = HALF * BK * 2  , STAGE_BYTES = 8 * HTB, NXCD = 8, WGM = 8;

__host__ __device__ __forceinline__ int lds_byte(int r, int c) { const int st = (r >> 4) * 2 + (c >> 5), rr = r & 15, cc = c & 31, ob = rr * 64 + cc * 2; return st * 1024 + (ob ^ (((ob >> 9) & 1) << 5)); }
__host__ __device__ __forceinline__ void stage_rc(int b, int& R, int& C) { const int st = b / 1024, sb = b % 1024, swz = sb ^ (((sb >> 9) & 1) << 5); R = (st >> 1) * 16 + swz / 64; C = (st & 1) * 32 + (swz % 64) / 2; }
__host__ __device__ __forceinline__ int perm32(int rho) { const int n = rho >> 4, i = rho & 15; return 8 * (i >> 2) + 4 * n + (i & 3); }

struct Unit { int pm, pn; };
struct Gemm { const bf16_t* A; const bf16_t* Bt; int M, N, K; };

struct StaticOrder {
    int nM, nN, nwg, G, c;
    __host__ __device__ void init(int M, int N, int G_, int c_) { nM = M / BM; nN = N / BM; nwg = nM * nN; G = G_; c = c_; }
    __host__ __device__ bool next(int i, Unit& u) const {
        const long L = (long)i * G + c; if (L >= nwg) return false;
        int wgid = (int)L; { const int q = nwg / NXCD, r = nwg % NXCD, xcd = wgid % NXCD, off = wgid / NXCD; wgid = (xcd < r ? xcd * (q + 1) : r * (q + 1) + (xcd - r) * q) + off; }
        const int nig = WGM * nN, gid = wgid / nig, fm = gid * WGM, gsz = (nM - fm) < WGM ? (nM - fm) : WGM;
        u.pm = fm + ((wgid % nig) % gsz); u.pn = (wgid % nig) / gsz; return true;
    }
    __device__ __forceinline__ void a_ready(const Unit&) const {}
    __device__ __forceinline__ void done(const Unit&) const {}
};

__device__ __forceinline__ unsigned cvt_pk_bf16(float lo, float hi) { unsigned r; asm volatile("v_cvt_pk_bf16_f32 %0, %1, %2" : "=v"(r) : "v"(lo), "v"(hi)); return r; }

template <class F> struct EpiAdapt {
    static constexpr bool PERM = true, AFTER_DRAIN = false;
    F f;
    __device__ __forceinline__ void operator()(const f32x4 (&acc)[2][2][4][2], const Unit& u, int wr, int wc, int fr, int fq) const {
        F g = f;
#pragma unroll
        for (int ai = 0; ai < 2; ++ai)
#pragma unroll
            for (int m = 0; m < 4; ++m) {
                const int row = u.pm * BM + ai * HALF + wr * 64 + m * 16 + fr;
                g.begin();
                if constexpr (F::PAIR) g.pair8(row, u.pn, wc * 32 + 8 * fq, acc[ai][0][m][0], acc[ai][0][m][1], acc[ai][1][m][0], acc[ai][1][m][1]);
                else {
#pragma unroll
                    for (int bj = 0; bj < 2; ++bj) g.oct(row, u.pn, bj * HALF + wc * 32 + 8 * fq, acc[ai][bj][m][0], acc[ai][bj][m][1]);
                }
                g.end(row);
            }
    }
};
template <class Epi, class Sched, bool ALIGN_EPI = false, bool SP2 = false>
__device__ __forceinline__ void gemm_phase(PG8_LAS unsigned char* lds, const Gemm g, const Sched& S, const Epi& E) {
    int tid_ = threadIdx.x; asm volatile("" : "+v"(tid_));
    const int tid = tid_, wid = __builtin_amdgcn_readfirstlane(tid >> 6), lane = tid & 63, wr = wid >> 2, wc = wid & 3, fr = lane & 15, fq = lane >> 4;
    const int K = g.K, nt = K / BK;
    unsigned voffA[2], voffB[2];
#pragma unroll
    for (int i = 0; i < 2; ++i) { int R, C; stage_rc(tid * 16 + i * 8192, R, C); const int Rb = Epi::PERM ? ((R & ~31) + perm32(R & 31)) : R;
        voffA[i] = (unsigned)(R * K + C) * 2u; voffB[i] = (unsigned)(Rb * K + C) * 2u; }
    const size_t kstep = (size_t)(BK * 2);
    const size_t hstep = (size_t)HALF * K * 2;
    const size_t tstep = 2 * hstep;
    const unsigned ldsw = (unsigned)wid * 1024u;
    const int aoff = lds_byte(wr * 64 + fr, fq * 8), boff = lds_byte(wc * 32 + fr, fq * 8);
#define PG8_SA(b, h) (((b) * 2 + (h)) * HTB)
#define PG8_SB(b, h) ((4 + (b) * 2 + (h)) * HTB)
#define PG8_STAGE(bufoff, gbase, voff) do { _Pragma("unroll") for (int _i = 0; _i < 2; ++_i) \
        __builtin_amdgcn_global_load_lds((const unsigned*)((const char*)(gbase) + (voff)[_i]), (PG8_LAS unsigned*)(lds + (bufoff) + ldsw + _i * 8192), 16, 0, 0); } while (0)
#define PG8_LDA(dst, b, h) do { _Pragma("unroll") for (int m = 0; m < 4; ++m) _Pragma("unroll") for (int k = 0; k < 2; ++k) dst[m][k] = *(const PG8_LAS bf16x8*)(lds + PG8_SA(b, h) + aoff + m * 2048 + k * 1024); } while (0)
#define PG8_LDB(dst, b, h) do { _Pragma("unroll") for (int n = 0; n < 2; ++n) _Pragma("unroll") for (int k = 0; k < 2; ++k) dst[n][k] = *(const PG8_LAS bf16x8*)(lds + PG8_SB(b, h) + boff + n * 2048 + k * 1024); } while (0)
#define PG8_MMA(ai, bj, At, Bt) do { __builtin_amdgcn_s_setprio(1); _Pragma("unroll") for (int m = 0; m < 4; ++m) _Pragma("unroll") for (int n = 0; n < 2; ++n) _Pragma("unroll") for (int k = 0; k < 2; ++k) \
        acc[ai][bj][m][n] = __builtin_amdgcn_mfma_f32_16x16x32_bf16(Bt[n][k], At[m][k], acc[ai][bj][m][n], 0, 0, 0); __builtin_amdgcn_s_setprio(0); } while (0)
#define PG8_WAIT_V(n) asm volatile("s_waitcnt vmcnt(" #n ")" ::: "memory")
#define PG8_WAIT_L(n) asm volatile("s_waitcnt lgkmcnt(" #n ")" ::: "memory")
#define PG8_BAR __builtin_amdgcn_s_barrier()
#define PG8_SCHED __builtin_amdgcn_sched_barrier(0)
    Unit cur, nxt; int ui = 0;
    if (!S.next(0, cur)) return;
    f32x4 acc[2][2][4][2];
#pragma unroll
    for (int a = 0; a < 2; ++a)
#pragma unroll
        for (int b = 0; b < 2; ++b)
#pragma unroll
            for (int m = 0; m < 4; ++m)
#pragma unroll
                for (int n = 0; n < 2; ++n) acc[a][b][m][n] = (f32x4){0.f, 0.f, 0.f, 0.f};
    bf16x8 At[4][2], B0[2][2], B1[2][2];
    const char* cA = (const char*)g.A + (size_t)cur.pm * tstep; const char* cB = (const char*)g.Bt + (size_t)cur.pn * tstep;
    S.a_ready(cur);
    if constexpr (SP2) {
        PG8_STAGE(PG8_SB(0, 0), cB, voffB); PG8_STAGE(PG8_SB(0, 1), cB + hstep, voffB); PG8_STAGE(PG8_SA(0, 0), cA, voffA); PG8_STAGE(PG8_SA(0, 1), cA + hstep, voffA);
        if (wr == 1) PG8_BAR;
        PG8_WAIT_V(2); PG8_BAR;
        PG8_STAGE(PG8_SB(1, 0), cB + kstep, voffB); PG8_STAGE(PG8_SA(1, 0), cA + kstep, voffA); PG8_STAGE(PG8_SB(1, 1), cB + hstep + kstep, voffB);
        PG8_WAIT_V(6); PG8_BAR;
    } else {
        PG8_STAGE(PG8_SB(0, 0), cB, voffB); PG8_STAGE(PG8_SA(0, 0), cA, voffA); PG8_STAGE(PG8_SB(0, 1), cB + hstep, voffB); PG8_STAGE(PG8_SA(0, 1), cA + hstep, voffA);
        if (wr == 1) PG8_BAR;
        PG8_WAIT_V(4); PG8_BAR;
        PG8_STAGE(PG8_SB(1, 0), cB + kstep, voffB); PG8_STAGE(PG8_SA(1, 0), cA + kstep, voffA); PG8_STAGE(PG8_SB(1, 1), cB + hstep + kstep, voffB);
        PG8_WAIT_V(6); PG8_BAR;
    }
    for (;;) {
        const bool has_next = S.next(ui + 1, nxt);
        const char* nA = has_next ? (const char*)g.A + (size_t)nxt.pm * tstep : cA; const char* nB = has_next ? (const char*)g.Bt + (size_t)nxt.pn * tstep : cB;
        for (int t = 0; t < nt; t += 2) {
            const bool last = (t == nt - 2);
            const char* a1 = cA + (size_t)(t + 1) * kstep;
            const char* a2 = last ? nA : cA + (size_t)(t + 2) * kstep; const char* b2 = last ? nB : cB + (size_t)(t + 2) * kstep;
            const char* a3 = a2 + kstep; const char* b3 = b2 + kstep;
            if (last && has_next) S.a_ready(nxt);
            if constexpr (SP2) {
            PG8_LDB(B0, 0, 0); PG8_LDB(B1, 0, 1); PG8_SCHED; PG8_LDA(At, 0, 0); PG8_STAGE(PG8_SA(1, 1), a1 + hstep, voffA);
            PG8_WAIT_V(8); PG8_WAIT_L(0); PG8_BAR; PG8_MMA(0, 0, At, B0); PG8_MMA(0, 1, At, B1); PG8_BAR; PG8_SCHED;
            PG8_LDA(At, 0, 1); PG8_STAGE(PG8_SB(0, 0), b2, voffB); PG8_STAGE(PG8_SB(0, 1), b2 + hstep, voffB); PG8_STAGE(PG8_SA(0, 0), a2, voffA);
            PG8_WAIT_V(8); PG8_WAIT_L(0); PG8_BAR; PG8_MMA(1, 0, At, B0); PG8_MMA(1, 1, At, B1); PG8_BAR; PG8_SCHED;
            PG8_LDB(B0, 1, 0); PG8_LDB(B1, 1, 1); PG8_SCHED; PG8_LDA(At, 1, 0); PG8_STAGE(PG8_SA(0, 1), a2 + hstep, voffA);
            PG8_WAIT_V(8); PG8_WAIT_L(0); PG8_BAR; PG8_MMA(0, 0, At, B0); PG8_MMA(0, 1, At, B1); PG8_BAR; PG8_SCHED;
            PG8_LDA(At, 1, 1); PG8_STAGE(PG8_SB(1, 0), b3, voffB); PG8_STAGE(PG8_SB(1, 1), b3 + hstep, voffB); PG8_STAGE(PG8_SA(1, 0), a3, voffA);
            PG8_WAIT_V(8); PG8_WAIT_L(0); PG8_BAR; PG8_MMA(1, 0, At, B0); PG8_MMA(1, 1, At, B1); PG8_BAR; PG8_SCHED;
            } else {
            PG8_LDB(B0, 0, 0); PG8_SCHED; PG8_LDA(At, 0, 0); PG8_STAGE(PG8_SA(1, 1), a1 + hstep, voffA);
            PG8_WAIT_L(8); PG8_BAR; PG8_WAIT_L(0); PG8_MMA(0, 0, At, B0); PG8_BAR; PG8_SCHED;
            PG8_LDB(B1, 0, 1); PG8_STAGE(PG8_SB(0, 0), b2, voffB);
            PG8_BAR; PG8_WAIT_L(0); PG8_MMA(0, 1, At, B1); PG8_BAR;
            PG8_LDA(At, 0, 1); PG8_STAGE(PG8_SA(0, 0), a2, voffA);
            PG8_BAR; PG8_WAIT_L(0); PG8_MMA(1, 0, At, B0); PG8_BAR; PG8_SCHED;
            PG8_STAGE(PG8_SB(0, 1), b2 + hstep, voffB);
            PG8_WAIT_V(6); PG8_BAR; PG8_MMA(1, 1, At, B1); PG8_BAR;
            PG8_LDB(B0, 1, 0); PG8_SCHED; PG8_LDA(At, 1, 0); PG8_STAGE(PG8_SA(0, 1), a2 + hstep, voffA);
            PG8_WAIT_L(8); PG8_BAR; PG8_WAIT_L(0); PG8_MMA(0, 0, At, B0); PG8_BAR; PG8_SCHED;
            PG8_LDB(B1, 1, 1); PG8_STAGE(PG8_SB(1, 0), b3, voffB);
            PG8_BAR; PG8_WAIT_L(0); PG8_MMA(0, 1, At, B1); PG8_BAR;
            PG8_LDA(At, 1, 1); PG8_STAGE(PG8_SA(1, 0), a3, voffA);
            PG8_BAR; PG8_WAIT_L(0); PG8_MMA(1, 0, At, B0); PG8_BAR; PG8_SCHED;
            PG8_STAGE(PG8_SB(1, 1), b3 + hstep, voffB);
            PG8_WAIT_V(6); PG8_BAR; PG8_MMA(1, 1, At, B1); PG8_BAR;
            }
        }
        if constexpr (ALIGN_EPI) { if (wr == 0) PG8_BAR; }
        if constexpr (!Epi::AFTER_DRAIN) { E(acc, cur, wr, wc, fr, fq); S.done(cur); }
        if (!has_next) break;
#pragma unroll
        for (int a = 0; a < 2; ++a)
#pragma unroll
            for (int b = 0; b < 2; ++b)
#pragma unroll
                for (int m = 0; m < 4; ++m)
#pragma unroll
                    for (int n = 0; n < 2; ++n) acc[a][b][m][n] = (f32x4){0.f, 0.f, 0.f, 0.f};
        cur = nxt; cA = nA; cB = nB; ++ui;
        if constexpr (ALIGN_EPI) { if (wr == 1) PG8_BAR; }
    }
    PG8_WAIT_V(0);
    if constexpr (!ALIGN_EPI) { if (wr == 0) PG8_BAR; }
    PG8_BAR;
    if constexpr (Epi::AFTER_DRAIN) { E.fused(acc, cur, wr, wc, fr, fq, lds, wid, lane); S.done(cur); }
#undef PG8_SA
#undef PG8_SB
#undef PG8_STAGE
#undef PG8_LDA
#undef PG8_LDB
#undef PG8_MMA
#undef PG8_WAIT_V
#undef PG8_WAIT_L
#undef PG8_BAR
#undef PG8_SCHED
}
}

__device__ __forceinline__ u32x4 pack8(f32x4 a, f32x4 b) { u32x4 w; w.x = pg8::cvt_pk_bf16(a.x, a.y); w.y = pg8::cvt_pk_bf16(a.z, a.w); w.z = pg8::cvt_pk_bf16(b.x, b.y); w.w = pg8::cvt_pk_bf16(b.z, b.w); return w; }
__device__ __forceinline__ f32x4 ld4bf(const bf16_t* p) { const u32x2 w = *(const u32x2*)p; f32x4 r; r.x = __builtin_bit_cast(float, w.x << 16); r.y = __builtin_bit_cast(float, w.x & 0xffff0000u); r.z = __builtin_bit_cast(float, w.y << 16); r.w = __builtin_bit_cast(float, w.y & 0xffff0000u); return r; }
__device__ __forceinline__ float sumsq4(f32x4 h) { return (h.x * h.x + h.y * h.y) + (h.z * h.z + h.w * h.w); }
struct EpiP {
    static constexpr bool PAIR = false;
    unsigned char* ws;
    __device__ __forceinline__ void begin() {}
    __device__ __forceinline__ void end(int) {}
    __device__ __forceinline__ void oct(int row, int pn, int c, f32x4 v0, f32x4 v1) {
        if (pn == 44) { float* d = (float*)(ws + WS_SM) + (size_t)row * 256 + c; *(f32x4*)d = v0; *(f32x4*)(d + 4) = v1; return; }
        bf16_t* base; int ld, col;
        if (pn < 8) { base = (bf16_t*)(ws + WS_Z); ld = 2048; col = pn * 256 + c; }
        else if (pn < 20) { base = (bf16_t*)(ws + WS_XBC); ld = 3072; col = (pn - 8) * 256 + c; }
        else if (pn < 28) { base = (bf16_t*)(ws + WS_R); ld = 2048; col = (pn - 20) * 256 + c; }
        else if (pn < 36) { base = (bf16_t*)(ws + WS_K); ld = 2048; col = (pn - 28) * 256 + c; }
        else if (pn < 44) { base = (bf16_t*)(ws + WS_V); ld = 2048; col = (pn - 36) * 256 + c; }
        else { base = (bf16_t*)(ws + WS_GD); ld = 256; col = c; }
        *(u32x4*)(base + (size_t)row * ld + col) = pack8(v0, v1);
    }
};
struct EpiOut {
    static constexpr bool PAIR = false;
    const float* x; float* h1; bf16_t* h1b; float* rowss; float s;
    __device__ __forceinline__ void begin() { s = 0.f; }
    __device__ __forceinline__ void oct(int row, int pn, int c, f32x4 v0, f32x4 v1) {
        const size_t off = (size_t)row * DM + pn * 256 + c;
        const f32x4 a = *(const f32x4*)(x + off) + v0, b = *(const f32x4*)(x + off + 4) + v1;
        *(f32x4*)(h1 + off) = a; *(f32x4*)(h1 + off + 4) = b;
        *(u32x4*)(h1b + off) = pack8(a, b);
        s += sumsq4(a) + sumsq4(b);
    }
    __device__ __forceinline__ void end(int row) { float t = s; t += __shfl_xor(t, 16); t += __shfl_xor(t, 32); if ((otid() & 63) < 16) atomicAdd(rowss + row, t); }
};
struct EpiGU {
    static constexpr bool PAIR = true;
    const float* rowss; bf16_t* act;
    __device__ __forceinline__ void begin() {}
    __device__ __forceinline__ void end(int) {}
    __device__ __forceinline__ void pair8(int row, int pn, int c, f32x4 g0, f32x4 g1, f32x4 u0, f32x4 u1) {
        const float rs = 1.f / sqrtf(rowss[row] * (1.f / DM) + RMS_EPS);
        g0 = g0 * rs; g1 = g1 * rs; u0 = u0 * rs; u1 = u1 * rs;
        f32x4 a, b;
        a.x = siluf_(g0.x) * u0.x; a.y = siluf_(g0.y) * u0.y; a.z = siluf_(g0.z) * u0.z; a.w = siluf_(g0.w) * u0.w;
        b.x = siluf_(g1.x) * u1.x; b.y = siluf_(g1.y) * u1.y; b.z = siluf_(g1.z) * u1.z; b.w = siluf_(g1.w) * u1.w;
        *(u32x4*)(act + (size_t)row * D_FF + pn * 128 + c) = pack8(a, b);
    }
};
struct EpiDown {
    static constexpr bool PAIR = false;
    const float* h1; float* out; float* rowss; float s;
    __device__ __forceinline__ void begin() { s = 0.f; }
    __device__ __forceinline__ void oct(int row, int pn, int c, f32x4 v0, f32x4 v1) {
        const size_t off = (size_t)row * DM + pn * 256 + c;
        const f32x4 a = *(const f32x4*)(h1 + off) + v0, b = *(const f32x4*)(h1 + off + 4) + v1;
        *(f32x4*)(out + off) = a; *(f32x4*)(out + off + 4) = b;
        s += sumsq4(a) + sumsq4(b);
    }
    __device__ __forceinline__ void end(int row) { float t = s; t += __shfl_xor(t, 16); t += __shfl_xor(t, 32); if ((otid() & 63) < 16) atomicAdd(rowss + row, t); }
};
template <class F> __device__ __forceinline__ void run_gemm(LAS unsigned char* lds, const bf16_t* A, const bf16_t* Bt, int Mr, int N, int K, const F& f) {
    pg8::Gemm g{A, Bt, Mr, N, K}; pg8::StaticOrder S; S.init(Mr, N, (int)gridDim.x, (int)blockIdx.x);
    pg8::EpiAdapt<F> E{f};
    pg8::gemm_phase<pg8::EpiAdapt<F>, pg8::StaticOrder, true, true>(lds, g, S, E);
}

constexpr int SSD_XT = 0;
constexpr int SSD_B = 73728;
constexpr int SSD_C = SSD_B + 18432;
constexpr int SSD_CB = SSD_C + 17408;
constexpr int SSD_ACS = SSD_CB + 17408;
constexpr int SSD_DT = SSD_ACS + 2048;
constexpr int SSD_PART = SSD_DT + 2048;
constexpr size_t WS_CD = 128 * 1024;
__device__ __forceinline__ void unpack8(u32x4 w, float (&f)[8]) {
    f[0] = __builtin_bit_cast(float, w.x << 16); f[1] = __builtin_bit_cast(float, w.x & 0xffff0000u); f[2] = __builtin_bit_cast(float, w.y << 16); f[3] = __builtin_bit_cast(float, w.y & 0xffff0000u);
    f[4] = __builtin_bit_cast(float, w.z << 16); f[5] = __builtin_bit_cast(float, w.z & 0xffff0000u); f[6] = __builtin_bit_cast(float, w.w << 16); f[7] = __builtin_bit_cast(float, w.w & 0xffff0000u);
}
template <bool WITH_C, bool B_TR>
__device__ __forceinline__ void ssd_stage(const Params& p, LAS unsigned char* lds, int b, int c, int g) {
    const int tid = otid(); constexpr int NCG = WITH_C ? 96 : 80;
    if (tid < NCG * 4) {
        const int cg = tid >> 2, seg = tid & 3;
        const int kind = cg < 64 ? 0 : (cg < 80 ? 1 : 2);
        const int col0 = kind == 0 ? 512 * g + 8 * cg : (kind == 1 ? 2048 + 128 * g + 8 * (cg - 64) : 2560 + 128 * g + 8 * (cg - 80));
        const float* cw = p.in[I_CONVW] + col0; const float* cb = p.in[I_CONVB] + col0;
        float w0[8], w1[8], w2[8], w3[8], bs[8];
#pragma unroll
        for (int i = 0; i < 8; ++i) { w0[i] = cw[i]; w1[i] = cw[D_XBC + i]; w2[i] = cw[2 * D_XBC + i]; w3[i] = cw[3 * D_XBC + i]; bs[i] = cb[i]; }
        const int tb = 64 * c + 16 * seg;
        const bf16_t* src = (const bf16_t*)(p.ws + WS_XBC) + ((size_t)b * SEQ + tb) * D_XBC + col0;
        float u1[8], u2[8], u3[8];
        const u32x4 zz = {0u, 0u, 0u, 0u};
        unpack8(tb >= 3 ? *(const u32x4*)(src - 3 * D_XBC) : zz, u3); unpack8(tb >= 2 ? *(const u32x4*)(src - 2 * D_XBC) : zz, u2); unpack8(tb >= 1 ? *(const u32x4*)(src - 1 * D_XBC) : zz, u1);
#pragma unroll
        for (int hb = 0; hb < 2; ++hb) {
            float y[8][8];
#pragma unroll
            for (int tt = 0; tt < 8; ++tt) {
                float u0[8]; unpack8(*(const u32x4*)(src + (size_t)(8 * hb + tt) * D_XBC), u0);
#pragma unroll
                for (int i = 0; i < 8; ++i) { const float a = w0[i] * u3[i] + w1[i] * u2[i] + w2[i] * u1[i] + w3[i] * u0[i] + bs[i]; y[tt][i] = a / (1.f + __expf(-a)); u3[i] = u2[i]; u2[i] = u1[i]; u1[i] = u0[i]; }
            }
            const bool tr = (kind == 0) || (kind == 1 && B_TR);
            if (tr) {
                LAS unsigned char* img = lds + (kind == 0 ? SSD_XT : SSD_B);
                const int r0 = kind == 0 ? 8 * cg : 8 * (cg - 64);
#pragma unroll
                for (int i = 0; i < 8; ++i) { u32x4 w; w.x = pg8::cvt_pk_bf16(y[0][i], y[1][i]); w.y = pg8::cvt_pk_bf16(y[2][i], y[3][i]); w.z = pg8::cvt_pk_bf16(y[4][i], y[5][i]); w.w = pg8::cvt_pk_bf16(y[6][i], y[7][i]);
                    *(LAS u32x4*)(img + ((r0 + i) * 72 + 16 * seg + 8 * hb) * 2) = w; }
            } else {
                LAS unsigned char* img = lds + (kind == 1 ? SSD_B : SSD_C);
                const int c0 = kind == 1 ? 8 * (cg - 64) : 8 * (cg - 80);
#pragma unroll
                for (int tt = 0; tt < 8; ++tt) { u32x4 w; w.x = pg8::cvt_pk_bf16(y[tt][0], y[tt][1]); w.y = pg8::cvt_pk_bf16(y[tt][2], y[tt][3]); w.z = pg8::cvt_pk_bf16(y[tt][4], y[tt][5]); w.w = pg8::cvt_pk_bf16(y[tt][6], y[tt][7]);
                    *(LAS u32x4*)(img + ((16 * seg + 8 * hb + tt) * 136 + c0) * 2) = w; }
            }
        }
    }
}
__device__ __forceinline__ void ssd_dt(const Params& p, LAS unsigned char* lds, int b, int c, int g) {
    const int lane = otid() & 63, e = otid() >> 6, eg = 8 * g + e;
    const float* SM = (const float*)(p.ws + WS_SM);
    const float dt = softplusf_(SM[((size_t)b * SEQ + 64 * c + lane) * 256 + eg] + p.in[I_DTB][eg]);
    float a = dt * -__expf(p.in[I_ALOG][eg]);
#pragma unroll
    for (int o = 1; o < 64; o <<= 1) { const float t = __shfl_up(a, o); if (lane >= o) a += t; }
    ((LAS float*)(lds + SSD_ACS))[lane * 8 + e] = a; ((LAS float*)(lds + SSD_DT))[lane * 8 + e] = dt;
}
__device__ void phase_ssd1(const Params& p, LAS unsigned char* lds, int wg, int nwg) {
    const int tid = otid(), lane = tid & 63, e = tid >> 6, fr = lane & 15, fq = lane >> 4;
    bf16_t* S = (bf16_t*)p.out; float* CD = (float*)(p.ws + WS_CTL + WS_CD);
    for (int unit = wg; unit < BATCH * 128 * NGRP; unit += nwg) {
        const int g = unit & 3, c = (unit >> 2) & 127, b = unit >> 9, eg = 8 * g + e;
        __syncthreads();
        ssd_stage<false, true>(p, lds, b, c, g);
        ssd_dt(p, lds, b, c, g);
        __syncthreads();
        LAS const float* ACS = (LAS const float*)(lds + SSD_ACS); LAS const float* DT = (LAS const float*)(lds + SSD_DT);
        const float alast = ACS[63 * 8 + e];
        f32x4 acc[8][4];
#pragma unroll
        for (int nt = 0; nt < 8; ++nt)
#pragma unroll
            for (int pt = 0; pt < 4; ++pt) acc[nt][pt] = (f32x4){0.f, 0.f, 0.f, 0.f};
#pragma unroll
        for (int ks = 0; ks < 2; ++ks) {
            float wl[8];
#pragma unroll
            for (int j = 0; j < 8; ++j) { const int s = 32 * ks + 8 * fq + j; wl[j] = DT[s * 8 + e] * __expf(alast - ACS[s * 8 + e]); }
            bf16x8 xb[4];
#pragma unroll
            for (int pt = 0; pt < 4; ++pt) {
                float f[8]; unpack8(*(LAS const u32x4*)(lds + SSD_XT + ((64 * e + 16 * pt + fr) * 72 + 32 * ks + 8 * fq) * 2), f);
                u32x4 w; w.x = pg8::cvt_pk_bf16(f[0] * wl[0], f[1] * wl[1]); w.y = pg8::cvt_pk_bf16(f[2] * wl[2], f[3] * wl[3]); w.z = pg8::cvt_pk_bf16(f[4] * wl[4], f[5] * wl[5]); w.w = pg8::cvt_pk_bf16(f[6] * wl[6], f[7] * wl[7]);
                xb[pt] = __builtin_bit_cast(bf16x8, w);
            }
#pragma unroll
            for (int nt = 0; nt < 8; ++nt) {
                const bf16x8 bt = *(LAS const bf16x8*)(lds + SSD_B + ((16 * nt + fr) * 72 + 32 * ks + 8 * fq) * 2);
#pragma unroll
                for (int pt = 0; pt < 4; ++pt) acc[nt][pt] = __builtin_amdgcn_mfma_f32_16x16x32_bf16(bt, xb[pt], acc[nt][pt], 0, 0, 0);
            }
        }
        bf16_t* sb = S + ((((size_t)b * 128 + c) * 32 + eg) * 64) * 128;
#pragma unroll
        for (int pt = 0; pt < 4; ++pt)
#pragma unroll
            for (int nt = 0; nt < 8; ++nt) { u32x2 w; w.x = pg8::cvt_pk_bf16(acc[nt][pt].x, acc[nt][pt].y); w.y = pg8::cvt_pk_bf16(acc[nt][pt].z, acc[nt][pt].w); *(u32x2*)(sb + (size_t)(16 * pt + fr) * 128 + 16 * nt + 4 * fq) = w; }
        if (lane == 0) CD[(b * 128 + c) * 32 + eg] = __expf(alast);
    }
}
__device__ void phase_ssd2(const Params& p, int wg, int nwg) {
    bf16_t* S = (bf16_t*)p.out; const float* CD = (const float*)(p.ws + WS_CTL + WS_CD);
    for (int idx = wg * 512 + otid(); idx < BATCH * 32 * 64 * 32; idx += nwg * 512) {
        const int n4 = idx & 31, pp = (idx >> 5) & 63, eg = (idx >> 11) & 31, b = idx >> 16;
        bf16_t* base = S + ((((size_t)b * 128) * 32 + eg) * 64 + pp) * 128 + 4 * n4;
        const float* cd = CD + (b * 128) * 32 + eg;
        f32x4 h = {0.f, 0.f, 0.f, 0.f};
#pragma unroll 8
        for (int c = 0; c < 128; ++c) {
            bf16_t* q = base + (size_t)c * (32 * 64 * 128);
            const f32x4 s = ld4bf(q); const float d = cd[c * 32];
            u32x2 w; w.x = pg8::cvt_pk_bf16(h.x, h.y); w.y = pg8::cvt_pk_bf16(h.z, h.w); *(u32x2*)q = w;
            h = h * d + s;
        }
    }
}
__device__ void phase_ssd3(const Params& p, bf16_t* ymix, LAS unsigned char* lds, int wg, int nwg) {
    const int tid = otid(), lane = tid & 63, e = tid >> 6, fr = lane & 15, fq = lane >> 4;
    const bf16_t* S = (const bf16_t*)p.out; const bf16_t* Z = (const bf16_t*)(p.ws + WS_Z);
    for (int unit = wg; unit < BATCH * 128 * NGRP; unit += nwg) {
        const int g = unit & 3, c = (unit >> 2) & 127, b = unit >> 9, eg = 8 * g + e;
        const size_t m0 = (size_t)b * SEQ + 64 * c;
        __syncthreads();
        ssd_stage<true, false>(p, lds, b, c, g);
        ssd_dt(p, lds, b, c, g);
        __syncthreads();
        {
            const int st = e >> 1;
            f32x4 cbacc[2] = {(f32x4){0.f, 0.f, 0.f, 0.f}, (f32x4){0.f, 0.f, 0.f, 0.f}};
#pragma unroll
            for (int ks = 0; ks < 4; ++ks) {
                const bf16x8 bfr = *(LAS const bf16x8*)(lds + SSD_B + ((16 * st + fr) * 136 + 32 * ks + 8 * fq) * 2);
#pragma unroll
                for (int j = 0; j < 2; ++j) { const int lt = 2 * (e & 1) + j; const bf16x8 cfr = *(LAS const bf16x8*)(lds + SSD_C + ((16 * lt + fr) * 136 + 32 * ks + 8 * fq) * 2); cbacc[j] = __builtin_amdgcn_mfma_f32_16x16x32_bf16(bfr, cfr, cbacc[j], 0, 0, 0); }
            }
#pragma unroll
            for (int j = 0; j < 2; ++j) { const int lt = 2 * (e & 1) + j; *(LAS f32x4*)(lds + SSD_CB + ((16 * lt + fr) * 68 + 16 * st + 4 * fq) * 4) = cbacc[j]; }
        }
        __syncthreads();
        LAS const float* ACS = (LAS const float*)(lds + SSD_ACS); LAS const float* DT = (LAS const float*)(lds + SSD_DT);
        const float Dsk = p.in[I_SSDD][eg];
        f32x4 acc[4][4];
#pragma unroll
        for (int pt = 0; pt < 4; ++pt)
#pragma unroll
            for (int lt = 0; lt < 4; ++lt) acc[pt][lt] = (f32x4){0.f, 0.f, 0.f, 0.f};
        const bf16_t* hb = S + ((((size_t)b * 128 + c) * 32 + eg) * 64) * 128;
#pragma unroll
        for (int ks = 0; ks < 4; ++ks) {
            bf16x8 hf[4], cf[4];
#pragma unroll
            for (int pt = 0; pt < 4; ++pt) hf[pt] = *(const bf16x8*)(hb + (size_t)(16 * pt + fr) * 128 + 32 * ks + 8 * fq);
#pragma unroll
            for (int lt = 0; lt < 4; ++lt) cf[lt] = *(LAS const bf16x8*)(lds + SSD_C + ((16 * lt + fr) * 136 + 32 * ks + 8 * fq) * 2);
#pragma unroll
            for (int pt = 0; pt < 4; ++pt)
#pragma unroll
                for (int lt = 0; lt < 4; ++lt) acc[pt][lt] = __builtin_amdgcn_mfma_f32_16x16x32_bf16(hf[pt], cf[lt], acc[pt][lt], 0, 0, 0);
        }
        float acl[4];
#pragma unroll
        for (int lt = 0; lt < 4; ++lt) { acl[lt] = ACS[(16 * lt + fr) * 8 + e]; const float sc = __expf(acl[lt]);
#pragma unroll
            for (int pt = 0; pt < 4; ++pt) acc[pt][lt] = acc[pt][lt] * sc; }
#pragma unroll
        for (int ks = 0; ks < 2; ++ks) {
            float as_[8], ds_[8];
#pragma unroll
            for (int j = 0; j < 8; ++j) { const int s = 32 * ks + 8 * fq + j; as_[j] = ACS[s * 8 + e]; ds_[j] = DT[s * 8 + e]; }
            bf16x8 xa[4];
#pragma unroll
            for (int pt = 0; pt < 4; ++pt) xa[pt] = *(LAS const bf16x8*)(lds + SSD_XT + ((64 * e + 16 * pt + fr) * 72 + 32 * ks + 8 * fq) * 2);
#pragma unroll
            for (int lt = 0; lt < 4; ++lt) {
                if (32 * ks > 16 * lt + 15) continue;
                const int l = 16 * lt + fr;
                const f32x4 c0 = *(LAS const f32x4*)(lds + SSD_CB + (l * 68 + 32 * ks + 8 * fq) * 4), c1 = *(LAS const f32x4*)(lds + SSD_CB + (l * 68 + 32 * ks + 8 * fq + 4) * 4);
                float mv[8];
#pragma unroll
                for (int j = 0; j < 8; ++j) { const int s = 32 * ks + 8 * fq + j; const float cbv = j < 4 ? c0[j] : c1[j - 4];
                    float v = cbv * __expf(fminf(acl[lt] - as_[j], 0.f)) * ds_[j]; v = (s <= l) ? v : 0.f; mv[j] = (s == l) ? v + Dsk : v; }
                u32x4 w; w.x = pg8::cvt_pk_bf16(mv[0], mv[1]); w.y = pg8::cvt_pk_bf16(mv[2], mv[3]); w.z = pg8::cvt_pk_bf16(mv[4], mv[5]); w.w = pg8::cvt_pk_bf16(mv[6], mv[7]);
                const bf16x8 mf = __builtin_bit_cast(bf16x8, w);
#pragma unroll
                for (int pt = 0; pt < 4; ++pt) acc[pt][lt] = __builtin_amdgcn_mfma_f32_16x16x32_bf16(xa[pt], mf, acc[pt][lt], 0, 0, 0);
            }
        }
        float ssq[4];
#pragma unroll
        for (int lt = 0; lt < 4; ++lt) {
            float s = 0.f;
#pragma unroll
            for (int pt = 0; pt < 4; ++pt) {
                const f32x4 z = ld4bf(Z + (m0 + 16 * lt + fr) * D_SSD + 64 * eg + 16 * pt + 4 * fq);
                f32x4 y = acc[pt][lt];
                y.x *= siluf_(z.x); y.y *= siluf_(z.y); y.z *= siluf_(z.z); y.w *= siluf_(z.w);
                acc[pt][lt] = y; s += (y.x * y.x + y.y * y.y) + (y.z * y.z + y.w * y.w);
            }
            s += __shfl_xor(s, 16); s += __shfl_xor(s, 32); ssq[lt] = s;
            if (fq == 0) ((LAS float*)(lds + SSD_PART))[e * 64 + 16 * lt + fr] = s;
        }
        __syncthreads();
#pragma unroll
        for (int lt = 0; lt < 4; ++lt) {
            float tot = 0.f;
#pragma unroll
            for (int w = 0; w < 8; ++w) tot += ((LAS const float*)(lds + SSD_PART))[w * 64 + 16 * lt + fr];
            const float rstd = 1.f / sqrtf(tot * (1.f / 512.f) + GATED_EPS);
#pragma unroll
            for (int pt = 0; pt < 4; ++pt) {
                const int col = 64 * eg + 16 * pt + 4 * fq;
                const f32x4 ng = *(const f32x4*)(p.in[I_SSDNG] + col);
                const f32x4 o = acc[pt][lt] * rstd * ng;
                u32x2 w; w.x = pg8::cvt_pk_bf16(o.x, o.y); w.y = pg8::cvt_pk_bf16(o.z, o.w);
                *(u32x2*)(ymix + (m0 + 16 * lt + fr) * D_MIX + col) = w;
            }
        }
    }
}

constexpr size_t WS_AW = 1 * MiB;
constexpr size_t WS_AA = 5 * MiB;
constexpr size_t WS_AG = 504 * MiB;
constexpr size_t WS_BON = WS_GD;
constexpr size_t WS_YRAW = WS_FREE;
__device__ void phase_rwkv_pre(const Params& p, int wg, int nwg) {
    const int tid = otid(), lane = tid & 63, wave = tid >> 6;
    const float* SM = (const float*)(p.ws + WS_SM); const bf16_t* GD = (const bf16_t*)(p.ws + WS_GD); const float* mu = p.in[I_MU];
    bf16_t* AW = (bf16_t*)(p.ws + WS_AW); bf16_t* AA = (bf16_t*)(p.ws + WS_AA); bf16_t* AG = (bf16_t*)(p.ws + WS_AG);
    for (int m = wg * 8 + wave; m < M; m += nwg * 8) {
        const bool hp = (m % SEQ) > 0;
#pragma unroll
        for (int i = 0; i < 2; ++i) {
            const int j = lane + 64 * i;
            float vw = 0.f, va = 0.f;
            if (j < 96) {
                { const float cur = SM[(size_t)m * 256 + 32 + j], prev = hp ? SM[(size_t)(m - 1) * 256 + 32 + j] : 0.f; vw = tanhf(cur + (prev - cur) * mu[MU_WD + j]); }
                { const float cur = SM[(size_t)m * 256 + 128 + j], prev = hp ? SM[(size_t)(m - 1) * 256 + 128 + j] : 0.f; va = cur + (prev - cur) * mu[MU_AD + j]; }
            }
            AW[(size_t)m * 128 + j] = (bf16_t)f2bf(vw); AA[(size_t)m * 128 + j] = (bf16_t)f2bf(va);
        }
#pragma unroll
        for (int i = 0; i < 4; ++i) {
            const int j = lane + 64 * i;
            const float cur = bf2f(GD[(size_t)m * 256 + j]), prev = hp ? bf2f(GD[(size_t)(m - 1) * 256 + j]) : 0.f;
            AG[(size_t)m * 256 + j] = (bf16_t)f2bf(sigmoidf_(cur + (prev - cur) * mu[MU_GD + j]));
        }
    }
}

template <int CTRL> __device__ __forceinline__ float dpp_f(float x) { return __builtin_bit_cast(float, __builtin_amdgcn_update_dpp(0, __builtin_bit_cast(int, x), CTRL, 0xf, 0xf, true)); }
__device__ __forceinline__ float red16(float x) { x += dpp_f<0xB1>(x); x += dpp_f<0x4E>(x); x += dpp_f<0x124>(x); x += dpp_f<0x128>(x); return x; }

constexpr int R2_T = 32, R2_RING = 5 * 8192 + 2048 + 256;
__device__ void phase_rwkv_scan(const Params& p, LAS unsigned char* lds, int wg, int nwg) {
    constexpr int T = R2_T, NCH = SEQ / T;
    const int tid = otid(), lane = tid & 63, wave = __builtin_amdgcn_readfirstlane(tid >> 6);
    LAS float* cst = (LAS float*)(lds + 2 * R2_RING + 4096);
    const bf16_t* R = (const bf16_t*)(p.ws + WS_R); const bf16_t* Kb = (const bf16_t*)(p.ws + WS_K); const bf16_t* V = (const bf16_t*)(p.ws + WS_V);
    const bf16_t* AW = (const bf16_t*)(p.ws + WS_AW); const bf16_t* AA = (const bf16_t*)(p.ws + WS_AA);
    float* BON = (float*)(p.ws + WS_BON); bf16_t* YRAW = (bf16_t*)(p.ws + WS_YRAW);
    for (int unit = wg; unit < 256; unit += nwg) {
        const int xcd = unit & 7, idx = unit >> 3, q = idx & 3, bh = xcd * 8 + (idx >> 2), b = bh >> 5, h = bh & 31;
        __syncthreads();
        { const int arr = tid >> 6, ch = tid & 63; const float* srcs[8] = {p.in[I_W0], p.in[I_A0], p.in[I_KK], p.in[I_KA], p.in[I_RK], p.in[I_MU] + MU_R, p.in[I_MU] + MU_K, p.in[I_MU] + MU_V};
          float v = 0.f;
#pragma unroll
          for (int a = 0; a < 8; ++a) if (arr == a) v = srcs[a][h * 64 + ch];
          cst[arr * 64 + ch] = v; }
        __syncthreads();
        if (wave >= 4) {
            const int pw = wave - 4, mt = pw & 1, half = pw >> 1, fr = lane & 15, fq = lane >> 4;
            bf16x8 bw[2][4], ba[2][4];
#pragma unroll
            for (int nt = 0; nt < 2; ++nt)
#pragma unroll
                for (int ks = 0; ks < 4; ++ks) {
                    const int ch = h * 64 + 32 * half + 16 * nt + fr;
#pragma unroll
                    for (int j = 0; j < 8; ++j) { const int k = 32 * ks + 8 * fq + j; float w2v = 0.f, a2v = 0.f; if (k < 96) { w2v = p.in[I_W2][(size_t)k * D_RWKV + ch]; a2v = p.in[I_A2][(size_t)k * D_RWKV + ch]; }
                        bw[nt][ks][j] = (short)f2bf(w2v); ba[nt][ks][j] = (short)f2bf(a2v); }
                }
            for (int c = 0; c <= NCH + 1; ++c) {
                if (c >= 2 && pw == 0) {
                    LAS const float* yo = (LAS const float*)(lds + 2 * R2_RING + ((c - 2) & 1) * 2048);
                    const int tok = lane >> 1, hf = lane & 1;
                    const f32x4 y0 = *(LAS const f32x4*)(yo + tok * 16 + 8 * hf), y1 = *(LAS const f32x4*)(yo + tok * 16 + 8 * hf + 4);
                    *(u32x4*)(YRAW + ((size_t)b * SEQ + (size_t)T * (c - 2) + tok) * D_RWKV + h * 64 + 16 * q + 8 * hf) = pack8(y0, y1);
                }
                if (c < NCH) {
                    LAS float* rg = (LAS float*)(lds + (c & 1) * R2_RING);
                    LAS float* r_an = rg; LAS float* r_ww = rg + 2048; LAS float* r_bb = rg + 4096; LAS float* r_kp = rg + 6144; LAS float* r_rr = rg + 8192; LAS float* r_vv = rg + 10240; LAS float* r_ss = rg + 10240 + 512;
                    const int tok = 16 * mt + fr, tg = T * c + tok; const size_t m = (size_t)b * SEQ + tg; const bool hp = tg > 0;
                    f32x4 accw[2], acca[2];
#pragma unroll
                    for (int nt = 0; nt < 2; ++nt) { accw[nt] = (f32x4){0.f, 0.f, 0.f, 0.f}; acca[nt] = (f32x4){0.f, 0.f, 0.f, 0.f}; }
#pragma unroll
                    for (int ks = 0; ks < 4; ++ks) {
                        const bf16x8 afw = *(const bf16x8*)(AW + m * 128 + 32 * ks + 8 * fq), afa = *(const bf16x8*)(AA + m * 128 + 32 * ks + 8 * fq);
#pragma unroll
                        for (int nt = 0; nt < 2; ++nt) { accw[nt] = __builtin_amdgcn_mfma_f32_16x16x32_bf16(bw[nt][ks], afw, accw[nt], 0, 0, 0); acca[nt] = __builtin_amdgcn_mfma_f32_16x16x32_bf16(ba[nt][ks], afa, acca[nt], 0, 0, 0); }
                    }
                    float ssp = 0.f, bop = 0.f;
#pragma unroll
                    for (int nt = 0; nt < 2; ++nt) {
                        const int ch0 = 32 * half + 16 * nt + 4 * fq; const size_t go = m * D_RWKV + h * 64 + ch0;
                        const f32x4 w0 = *(LAS const f32x4*)(cst + 0 * 64 + ch0), a0 = *(LAS const f32x4*)(cst + 1 * 64 + ch0), kkc = *(LAS const f32x4*)(cst + 2 * 64 + ch0), kac = *(LAS const f32x4*)(cst + 3 * 64 + ch0),
                                    rkc = *(LAS const f32x4*)(cst + 4 * 64 + ch0), mur = *(LAS const f32x4*)(cst + 5 * 64 + ch0), muk = *(LAS const f32x4*)(cst + 6 * 64 + ch0);
                        f32x4 rc = ld4bf(R + go), kc = ld4bf(Kb + go), rp = (f32x4){0.f, 0.f, 0.f, 0.f}, kpv = rp;
                        if (hp) { rp = ld4bf(R + go - D_RWKV); kpv = ld4bf(Kb + go - D_RWKV); }
                        const f32x4 r4 = rc + (rp - rc) * mur, k4 = kc + (kpv - kc) * muk;
                        f32x4 wv, ag;
#pragma unroll
                        for (int i = 0; i < 4; ++i) { const float sg = 1.f / (1.f + __expf(-(w0[i] + accw[nt][i]))); wv[i] = __expf(-0.60653066f * sg); ag[i] = 1.f / (1.f + __expf(-(a0[i] + acca[nt][i]))); }
                        const f32x4 kk = k4 * kkc, kp4 = k4 * (1.f + (ag - 1.f) * kac), b4 = kk * ag;
                        ssp += (kk.x * kk.x + kk.y * kk.y) + (kk.z * kk.z + kk.w * kk.w);
                        const f32x4 bo4 = r4 * kp4 * rkc; bop += (bo4.x + bo4.y) + (bo4.z + bo4.w);
                        *(LAS f32x4*)(r_an + tok * 64 + ch0) = kk; *(LAS f32x4*)(r_ww + tok * 64 + ch0) = wv; *(LAS f32x4*)(r_bb + tok * 64 + ch0) = b4; *(LAS f32x4*)(r_kp + tok * 64 + ch0) = kp4; *(LAS f32x4*)(r_rr + tok * 64 + ch0) = r4;
                        if (2 * half + nt == q) {
                            const f32x4 muv = *(LAS const f32x4*)(cst + 7 * 64 + ch0);
                            const f32x4 vc = ld4bf(V + go); f32x4 vp = (f32x4){0.f, 0.f, 0.f, 0.f}; if (hp) vp = ld4bf(V + go - D_RWKV);
                            *(LAS f32x4*)(r_vv + tok * 16 + 4 * fq) = vc + (vp - vc) * muv;
                        }
                    }
                    ssp += __shfl_xor(ssp, 16); ssp += __shfl_xor(ssp, 32); bop += __shfl_xor(bop, 16); bop += __shfl_xor(bop, 32);
                    if (fq == 0) { r_ss[tok * 2 + half] = ssp; if (q == 0) BON[(m * 32 + h) * 2 + half] = bop; }
                }
                if (c <= NCH) __syncthreads();
            }
        } else {
            __builtin_amdgcn_s_setprio(2);
            const int cw = wave, g = lane >> 4, l16 = lane & 15, row = 4 * cw + g;
            float S0 = 0.f, S1 = 0.f, S2 = 0.f, S3 = 0.f;
            __syncthreads();
            for (int c = 0; c < NCH; ++c) {
                LAS const float* rg = (LAS const float*)(lds + (c & 1) * R2_RING);
                LAS const float* r_an = rg + 4 * l16; LAS const float* r_ww = rg + 2048 + 4 * l16; LAS const float* r_bb = rg + 4096 + 4 * l16; LAS const float* r_kp = rg + 6144 + 4 * l16; LAS const float* r_rr = rg + 8192 + 4 * l16;
                LAS const float* r_vv = rg + 10240 + row; LAS const float* r_ss = rg + 10240 + 512;
                LAS float* yo = (LAS float*)(lds + 2 * R2_RING + (c & 1) * 2048) + row;
                float cv; { const int tt = lane & 31; cv = -1.f / fmaxf(r_ss[2 * tt] + r_ss[2 * tt + 1], 1e-24f); }
#pragma unroll
                for (int t = 0; t < T; ++t) {
                    const f32x4 a4 = *(LAS const f32x4*)(r_an + t * 64), w4 = *(LAS const f32x4*)(r_ww + t * 64), b4 = *(LAS const f32x4*)(r_bb + t * 64), k4 = *(LAS const f32x4*)(r_kp + t * 64), r4 = *(LAS const f32x4*)(r_rr + t * 64);
                    const float vr = r_vv[t * 16];
                    const float ct = __builtin_bit_cast(float, __builtin_amdgcn_readlane(__builtin_bit_cast(int, cv), t));
                    float sa = (S0 * a4.x + S1 * a4.y) + (S2 * a4.z + S3 * a4.w);
                    sa = red16(sa) * ct;
                    S0 = S0 * w4.x + (vr * k4.x + sa * b4.x); S1 = S1 * w4.y + (vr * k4.y + sa * b4.y); S2 = S2 * w4.z + (vr * k4.z + sa * b4.z); S3 = S3 * w4.w + (vr * k4.w + sa * b4.w);
                    float y = (S0 * r4.x + S1 * r4.y) + (S2 * r4.z + S3 * r4.w);
                    y = red16(y);
                    if (l16 == 0) yo[t * 16] = y;
                }
                __syncthreads();
            }
            __builtin_amdgcn_s_setprio(0);
        }
    }
}

__device__ void phase_rwkv_post(const Params& p, bf16_t* ymix, int wg, int nwg) {
    const int tid = otid(), lane = tid & 63, wave = tid >> 6, fr = lane & 15, fq = lane >> 4;
    const bf16_t* AG = (const bf16_t*)(p.ws + WS_AG); const bf16_t* G2 = (const bf16_t*)(p.ws + WS_G2); const bf16_t* YRAW = (const bf16_t*)(p.ws + WS_YRAW); const bf16_t* V = (const bf16_t*)(p.ws + WS_V);
    const float* BON = (const float*)(p.ws + WS_BON); const float* mu = p.in[I_MU];
    for (int item = wg; item < 128 * 32; item += nwg) {
        const int grp = item >> 5, h = item & 31, mt = grp * 8 + wave;
        const size_t m = (size_t)mt * 16 + fr; const bool hp = (m % SEQ) > 0;
        f32x4 acc[4];
#pragma unroll
        for (int nt = 0; nt < 4; ++nt) acc[nt] = (f32x4){0.f, 0.f, 0.f, 0.f};
#pragma unroll
        for (int ks = 0; ks < 8; ++ks) {
            const bf16x8 a = *(const bf16x8*)(AG + m * 256 + 32 * ks + 8 * fq);
#pragma unroll
            for (int nt = 0; nt < 4; ++nt) { const bf16x8 bfr = *(const bf16x8*)(G2 + (size_t)(h * 64 + 16 * nt + fr) * 256 + 32 * ks + 8 * fq); acc[nt] = __builtin_amdgcn_mfma_f32_16x16x32_bf16(bfr, a, acc[nt], 0, 0, 0); }
        }
        f32x4 y[4]; float s1 = 0.f;
#pragma unroll
        for (int nt = 0; nt < 4; ++nt) { y[nt] = ld4bf(YRAW + m * D_RWKV + h * 64 + 16 * nt + 4 * fq); s1 += (y[nt].x + y[nt].y) + (y[nt].z + y[nt].w); }
        s1 += __shfl_xor(s1, 16); s1 += __shfl_xor(s1, 32);
        const float mean = s1 * (1.f / 64.f); float s2 = 0.f;
#pragma unroll
        for (int nt = 0; nt < 4; ++nt) { y[nt] = y[nt] - mean; s2 += (y[nt].x * y[nt].x + y[nt].y * y[nt].y) + (y[nt].z * y[nt].z + y[nt].w * y[nt].w); }
        s2 += __shfl_xor(s2, 16); s2 += __shfl_xor(s2, 32);
        const float rstd = 1.f / sqrtf(s2 * (1.f / 64.f) + GN_EPS);
        const float bon = BON[(m * 32 + h) * 2] + BON[(m * 32 + h) * 2 + 1];
#pragma unroll
        for (int nt = 0; nt < 4; ++nt) {
            const int c = h * 64 + 16 * nt + 4 * fq;
            const f32x4 vc = ld4bf(V + m * D_RWKV + c); f32x4 vp = (f32x4){0.f, 0.f, 0.f, 0.f}; if (hp) vp = ld4bf(V + (m - 1) * D_RWKV + c);
            const f32x4 muv = *(const f32x4*)(mu + MU_V + c), gw = *(const f32x4*)(p.in[I_GNW] + c), gb = *(const f32x4*)(p.in[I_GNB] + c);
            const f32x4 v4 = vc + (vp - vc) * muv;
            const f32x4 o = (y[nt] * rstd * gw + gb + v4 * bon) * acc[nt];
            u32x2 w; w.x = pg8::cvt_pk_bf16(o.x, o.y); w.y = pg8::cvt_pk_bf16(o.z, o.w);
            *(u32x2*)(ymix + m * D_MIX + 2048 + c) = w;
        }
    }
}

__device__ void phase_final(const Params& p, int wg, int nwg) {
    const int tid = otid(), lane = tid & 63, wave = tid >> 6;
    const float* rowss2 = (const float*)(p.ws + WS_CTL) + M; const float* gf = p.in[I_NFG];
    for (int m = wg * 8 + wave; m < M; m += nwg * 8) {
        const float rstd = 1.f / sqrtf(rowss2[m] * (1.f / DM) + RMS_EPS);
        f32x4* o = (f32x4*)(p.out + (size_t)m * DM) + lane;
#pragma unroll
        for (int j = 0; j < 8; ++j) { const f32x4 g = ((const f32x4*)gf)[64 * j + lane]; f32x4 v = o[64 * j]; v = v * rstd * g; o[64 * j] = v; }
    }
}

__global__ void __launch_bounds__(512, 2) k_mega(Params p) {
    extern __shared__ __attribute__((aligned(16))) unsigned char lds_raw[];
    LAS unsigned char* lds = (LAS unsigned char*)lds_raw;
    cg::grid_group grid = cg::this_grid();
    const int wg = blockIdx.x, nwg = gridDim.x;
    bf16_t* ymix = (bf16_t*)(p.ws + WS_R);
    float* rowss1 = (float*)(p.ws + WS_CTL); float* rowss2 = rowss1 + M;
    phase_p0a(p, lds, wg, nwg);
    grid.sync();
    run_gemm(lds, (const bf16_t*)p.out, (const bf16_t*)(p.ws + WS_WIN), M, NP, DM, EpiP{p.ws});
    grid.sync();
    phase_rwkv_pre(p, wg, nwg);
    phase_ssd1(p, lds, wg, nwg);
    grid.sync();
    phase_ssd2(p, wg, nwg);
    phase_rwkv_scan(p, lds, wg, nwg);
    grid.sync();
    phase_ssd3(p, ymix, lds, wg, nwg);
    phase_rwkv_post(p, ymix, wg, nwg);
    grid.sync();
    phase_p0b(p, lds, wg, nwg);
    __syncthreads();
    run_gemm(lds, ymix, (const bf16_t*)(p.ws + WS_WOUT), M, DM, D_MIX, EpiOut{p.in[I_X], (float*)(p.ws + WS_H1), (bf16_t*)(p.ws + WS_H1B), rowss1, 0.f});
    grid.sync();
    run_gemm(lds, (const bf16_t*)(p.ws + WS_H1B), (const bf16_t*)(p.ws + WS_WGU), M, NGU, DM, EpiGU{rowss1, (bf16_t*)(p.ws + WS_ACT)});
    grid.sync();
    run_gemm(lds, (const bf16_t*)(p.ws + WS_ACT), (const bf16_t*)(p.ws + WS_WDN), M, DM, D_FF, EpiDown{(const float*)(p.ws + WS_H1), p.out, rowss2, 0.f});
    grid.sync();
    phase_final(p, wg, nwg);
}

constexpr int LDS_BYTES = 147456;
extern "C" void kernel_launch(void* const* d_in, const int* in_sizes, int n_in, void* d_out, int out_size, void* d_ws, size_t ws_size, hipStream_t stream) {
    static int grid = 0;
    if (grid == 0) {
        if (n_in != 26 || ws_size < WS_END) { fprintf(stderr, "kernel_launch: unexpected n_in %d / ws_size %zu\n", n_in, ws_size); grid = -1; return; }
        int dev = 0, cus = 0, per_cu = 0;
        (void)hipGetDevice(&dev);
        (void)hipDeviceGetAttribute(&cus, hipDeviceAttributeMultiprocessorCount, dev);
        (void)hipFuncSetAttribute((const void*)k_mega, hipFuncAttributeMaxDynamicSharedMemorySize, LDS_BYTES);
        (void)hipOccupancyMaxActiveBlocksPerMultiprocessor(&per_cu, (const void*)k_mega, 512, LDS_BYTES);
        if (per_cu < 1) { fprintf(stderr, "kernel_launch: occupancy query says %d blocks/CU\n", per_cu); grid = -1; return; }
        grid = cus;
        fprintf(stderr, "kernel_launch: cus %d per_cu %d grid %d ws %zu\n", cus, per_cu, grid, ws_size);
    }
    if (grid < 0) return;
    Params p{};
    for (int i = 0; i < 26; ++i) p.in[i] = (const float*)d_in[i];
    p.out = (float*)d_out; p.ws = (unsigned char*)d_ws;
    (void)hipMemsetAsync((char*)d_ws + WS_CTL, 0, CTL_BYTES, stream);
    void* args[] = {&p};
    hipError_t e = hipLaunchCooperativeKernel((const void*)k_mega, dim3(grid), dim3(512), args, LDS_BYTES, stream);
    if (e != hipSuccess) fprintf(stderr, "cooperative launch failed: %s (grid %d)\n", hipGetErrorString(e), grid);
}
```

```cpp
#include <hip/hip_runtime.h>
#include <hip/hip_cooperative_groups.h>
#include <cstdio>
#include <cstdint>

#ifndef RWKV_CHUNKED
#define RWKV_CHUNKED 2
#endif
#ifndef PROBE_PH
#define PROBE_PH 0
#endif
#define LAS __attribute__((address_space(3)))
constexpr int LDS_BYTES_C = 163840;
namespace cg = cooperative_groups;
typedef unsigned short bf16_t;
typedef short bf16x8 __attribute__((ext_vector_type(8)));
typedef float f32x4 __attribute__((ext_vector_type(4)));
typedef unsigned u32x4 __attribute__((ext_vector_type(4)));
typedef unsigned u32x2 __attribute__((ext_vector_type(2)));
typedef float f32x2 __attribute__((ext_vector_type(2)));

constexpr int BATCH = 2, SEQ = 8192, DM = 2048, M = BATCH * SEQ;
constexpr int D_SSD = 2048, D_RWKV = 2048, D_MIX = 4096, NHEAD = 32, HD = 64, NGRP = 4, NSTATE = 128;
constexpr int D_XBC = 3072, D_IN = 11744, NP = 11776  , D_FF = 5632, NGU = 11264;
constexpr int LW = 96, LG = 256;
constexpr float RMS_EPS = 1e-6f, GATED_EPS = 1e-5f, GN_EPS = 64e-5f;
constexpr int O_Z = 0, O_XBC = 2048, O_DT = 5120, O_R = 5152, O_K = 7200, O_V = 9248, O_WD = 11296, O_AD = 11392, O_GD = 11488;
constexpr int MU_R = 0, MU_K = 2048, MU_V = 4096, MU_WD = 6144, MU_AD = 6240, MU_GD = 6336;

constexpr size_t MiB = 1u << 20;
constexpr size_t WS_CTL = 0, CTL_BYTES = 1 * MiB;
constexpr size_t WS_WIN = 1 * MiB;
constexpr size_t WS_WOUT = 47 * MiB;
constexpr size_t WS_G2 = 63 * MiB;
constexpr size_t WS_Z = 64 * MiB;
constexpr size_t WS_XBC = 128 * MiB;
constexpr size_t WS_V = 224 * MiB;
constexpr size_t WS_SM = 288 * MiB;
constexpr size_t WS_GD = 304 * MiB;
constexpr size_t WS_R = 312 * MiB;
constexpr size_t WS_K = 376 * MiB;
constexpr size_t WS_FREE = 440 * MiB;
constexpr size_t WS_H2B = 64 * MiB;
constexpr size_t WS_H1B = 192 * MiB;
constexpr size_t WS_ACT = 256 * MiB;
constexpr size_t WS_WGU = 440 * MiB;
constexpr size_t WS_WDN = 484 * MiB;
constexpr size_t WS_END = 512 * MiB;
static_assert(WS_WDN + (size_t)2048 * 5632 * 2 <= WS_END, "ws map");

struct Params {
    const float* in[26];
    float* out;
    unsigned char* ws;
};
enum { I_X = 0, I_N1G, I_WIN, I_CONVW, I_CONVB, I_DTB, I_ALOG, I_SSDD, I_SSDNG, I_MU, I_W0, I_W2, I_A0, I_A2, I_G2, I_KK, I_KA, I_RK, I_GNW, I_GNB, I_WOUT, I_N2G, I_WGATE, I_WUP, I_WDOWN, I_NFG };

__device__ __forceinline__ unsigned f2bf(float f) { unsigned u = __builtin_bit_cast(unsigned, f); return (u + 0x7fffu + ((u >> 16) & 1u)) >> 16; }
__device__ __forceinline__ unsigned pk2(float lo, float hi) { return f2bf(lo) | (f2bf(hi) << 16); }
__device__ __forceinline__ float bf2f(bf16_t v) { return __builtin_bit_cast(float, (unsigned)v << 16); }
__device__ __forceinline__ float wave_sum(float v) {
#pragma unroll
    for (int o = 1; o < 64; o <<= 1) v += __shfl_xor(v, o);
    return v;
}
__device__ __forceinline__ int otid() { int t = threadIdx.x; asm volatile("" : "+v"(t)); return t; }
__device__ __forceinline__ float sigmoidf_(float x) { return __builtin_amdgcn_rcpf(1.f + __expf(-x)); }
__device__ __forceinline__ float siluf_(float x) { return x * __builtin_amdgcn_rcpf(1.f + __expf(-x)); }
__device__ __forceinline__ float softplusf_(float x) { return fmaxf(x, 0.f) + log1pf(__expf(-fabsf(x))); }

__device__ __forceinline__ void transpose_item(const float* W, int ldw, int K, bf16_t* WT, int n_dst0, int src_col0, const float* kscale, LAS float* scr, int kb, int nb, int lane) {
    const int k0 = 64 * kb, n0 = 32 * nb;
    const int r8 = lane >> 3, n4 = lane & 7;
    f32x4 v[8];
#pragma unroll
    for (int i = 0; i < 8; ++i) v[i] = __builtin_nontemporal_load((const f32x4*)(W + (size_t)(k0 + 8 * i + r8) * ldw + src_col0 + n0 + 4 * n4));
#pragma unroll
    for (int i = 0; i < 8; ++i) { const int kk = 8 * i + r8; f32x4 x = v[i]; if (kscale) x = x * kscale[k0 + kk];
        LAS float* d = scr + kk * 33 + 4 * n4; d[0] = x.x; d[1] = x.y; d[2] = x.z; d[3] = x.w; }
    asm volatile("s_waitcnt lgkmcnt(0)" ::: "memory");
    const int c = lane & 7;
#pragma unroll
    for (int j = 0; j < 4; ++j) { const int n = (lane >> 3) + 8 * j; const LAS float* s = scr + (8 * c) * 33 + n;
        u32x4 o; o.x = pk2(s[0 * 33], s[1 * 33]); o.y = pk2(s[2 * 33], s[3 * 33]); o.z = pk2(s[4 * 33], s[5 * 33]); o.w = pk2(s[6 * 33], s[7 * 33]);
        *(u32x4*)(WT + (size_t)(n_dst0 + n0 + n) * K + k0 + 8 * c) = o; }
    asm volatile("s_waitcnt lgkmcnt(0)" ::: "memory");
}
__device__ __forceinline__ void convert_seg(const float* W, int ldw, int K, bf16_t* WT, int n_dst0, int count, int src_col0, const float* kscale, LAS float* scr, int gw, int ngw, int lane) {
    const int nblk = count / 32, nit = (K / 64) * nblk;
    for (int it = gw; it < nit; it += ngw) transpose_item(W, ldw, K, WT, n_dst0, src_col0, kscale, scr, it / nblk, it % nblk, lane);
}
__device__ __forceinline__ void zero_rows(bf16_t* WT, int K, int n0, int count, int gw, int ngw, int lane) {
    const int chunks = count * K / 8;
    u32x4 z = {0u, 0u, 0u, 0u};
    for (int i = gw * 64 + lane; i < chunks; i += ngw * 64) *(u32x4*)(WT + (size_t)n0 * K + (size_t)i * 8) = z;
}

__device__ void phase_p0a(const Params& p, LAS unsigned char* lds, int wg, int nwg) {
    const int tid = otid(), lane = tid & 63, wave = tid >> 6;
    LAS float* scr = (LAS float*)(lds + wave * 16384);
    const int gw = wg * 8 + wave, ngw = nwg * 8;
    bf16_t* WIN = (bf16_t*)(p.ws + WS_WIN); bf16_t* WOUT = (bf16_t*)(p.ws + WS_WOUT);
    const float* w_in = p.in[I_WIN];
    convert_seg(w_in, D_IN, DM, WIN, 0, 2048, O_Z, nullptr, scr, gw, ngw, lane);
    convert_seg(w_in, D_IN, DM, WIN, 2048, 3072, O_XBC, nullptr, scr, gw, ngw, lane);
    convert_seg(w_in, D_IN, DM, WIN, 5120, 2048, O_R, nullptr, scr, gw, ngw, lane);
    convert_seg(w_in, D_IN, DM, WIN, 7168, 2048, O_K, nullptr, scr, gw, ngw, lane);
    convert_seg(w_in, D_IN, DM, WIN, 9216, 2048, O_V, nullptr, scr, gw, ngw, lane);
    convert_seg(w_in, D_IN, DM, WIN, 11264, 32, O_DT, nullptr, scr, gw, ngw, lane);
    convert_seg(w_in, D_IN, DM, WIN, 11296, 96, O_WD, nullptr, scr, gw, ngw, lane);
    convert_seg(w_in, D_IN, DM, WIN, 11392, 96, O_AD, nullptr, scr, gw, ngw, lane);
    zero_rows(WIN, DM, 11488, 32, gw, ngw, lane);
    convert_seg(w_in, D_IN, DM, WIN, 11520, 256, O_GD, nullptr, scr, gw, ngw, lane);
    convert_seg(p.in[I_WOUT], DM, D_MIX, WOUT, 0, 2048, 0, nullptr, scr, gw, ngw, lane);
    convert_seg(p.in[I_G2], D_RWKV, LG, (bf16_t*)(p.ws + WS_G2), 0, 2048, 0, nullptr, scr, gw, ngw, lane);
    bf16_t* U = (bf16_t*)p.out; const float* x = p.in[I_X]; const float* g1 = p.in[I_N1G];
    for (int m = gw; m < M; m += ngw) {
        const f32x4* xr = (const f32x4*)(x + (size_t)m * DM) + lane; f32x4 v[8]; float s = 0.f;
#pragma unroll
        for (int j = 0; j < 8; ++j) { v[j] = __builtin_nontemporal_load(&xr[64 * j]); s += (v[j].x * v[j].x + v[j].y * v[j].y) + (v[j].z * v[j].z + v[j].w * v[j].w); }
        const float rstd = 1.f / sqrtf(wave_sum(s) * (1.f / DM) + RMS_EPS);
        u32x2* o = (u32x2*)(U + (size_t)m * DM) + lane;
#pragma unroll
        for (int j = 0; j < 8; ++j) { const f32x4 g = ((const f32x4*)g1)[64 * j + lane]; u32x2 w; w.x = pk2(v[j].x * rstd * g.x, v[j].y * rstd * g.y); w.y = pk2(v[j].z * rstd * g.z, v[j].w * rstd * g.w); o[64 * j] = w; }
    }
}
__device__ void phase_p0b(const Params& p, LAS unsigned char* lds, int wg, int nwg) {
    const int tid = otid(), lane = tid & 63, wave = tid >> 6;
    LAS float* scr = (LAS float*)(lds + wave * 16384);
    const int gw = wg * 8 + wave, ngw = nwg * 8;
    bf16_t* WGU = (bf16_t*)(p.ws + WS_WGU); bf16_t* WDN = (bf16_t*)(p.ws + WS_WDN);
    const int nblk = 4, per_half = (DM / 64) * nblk, nit = (D_FF / 128) * 2 * per_half;
    for (int it = gw; it < nit; it += ngw) {
        const int th = it / per_half, r = it % per_half, tile = th >> 1, half = th & 1;
        transpose_item(half ? p.in[I_WUP] : p.in[I_WGATE], D_FF, DM, WGU, 256 * tile + 128 * half, 128 * tile, p.in[I_N2G], scr, r / nblk, r % nblk, lane);
    }
    convert_seg(p.in[I_WDOWN], DM, D_FF, WDN, 0, 2048, 0, nullptr, scr, gw, ngw, lane);
}

namespace pg8 {
#define PG8_LAS __attribute__((address_space(3)))
typedef unsigned short bf16_t;
typedef short bf16x8 __attribute__((ext_vector_type(8)));
typedef float f32x4 __attribute__((ext_vector_type(4)));
typedef unsigned u32x4 __attribute__((ext_vector_type(4)));
constexpr int BM = 256, BK = 64, HALF = 128, HTB = HALF * BK * 2  , STAGE_BYTES = 8 * HTB, NXCD = 8, WGM = 8;

__host__ __device__ __forceinline__ int lds_byte(int r, int c) { const int st = (r >> 4) * 2 + (c >> 5), rr = r & 15, cc = c & 31, ob = rr * 64 + cc * 2; return st * 1024 + (ob ^ (((ob >> 9) & 1) << 5)); }
__host__ __device__ __forceinline__ void stage_rc(int b, int& R, int& C) { const int st = b / 1024, sb = b % 1024, swz = sb ^ (((sb >> 9) & 1) << 5); R = (st >> 1) * 16 + swz / 64; C = (st & 1) * 32 + (swz % 64) / 2; }
__host__ __device__ __forceinline__ int perm32(int rho) { const int n = rho >> 4, i = rho & 15; return 8 * (i >> 2) + 4 * n + (i & 3); }

struct Unit { int pm, pn; };
struct Gemm { const bf16_t* A; const bf16_t* Bt; int M, N, K; };

struct StaticOrder {
    int nM, nN, nwg, G, c;
    __host__ __device__ void init(int M, int N, int G_, int c_) { nM = M / BM; nN = N / BM; nwg = nM * nN; G = G_; c = c_; }
    __host__ __device__ bool next(int i, Unit& u) const {
        const long L = (long)i * G + c; if (L >= nwg) return false;
        int wgid = (int)L; { const int q = nwg / NXCD, r = nwg % NXCD, xcd = wgid % NXCD, off = wgid / NXCD; wgid = (xcd < r ? xcd * (q + 1) : r * (q + 1) + (xcd - r) * q) + off; }
        const int nig = WGM * nN, gid = wgid / nig, fm = gid * WGM, gsz = (nM - fm) < WGM ? (nM - fm) : WGM;
        u.pm = fm + ((wgid % nig) % gsz); u.pn = (wgid % nig) / gsz; return true;
    }
    __device__ __forceinline__ void a_ready(const Unit&) const {}
    __device__ __forceinline__ void done(const Unit&) const {}
};

typedef float f32x2_ __attribute__((ext_vector_type(2))); typedef __bf16 bf16v2_ __attribute__((ext_vector_type(2)));
__device__ __forceinline__ unsigned cvt_pk_bf16(float lo, float hi) { unsigned r; asm volatile("v_cvt_pk_bf16_f32 %0, %1, %2" : "=v"(r) : "v"(lo), "v"(hi)); return r; }
__device__ __forceinline__ unsigned cvt_pk_bf16_c(float lo, float hi) { const f32x2_ v = {lo, hi}; return __builtin_bit_cast(unsigned, __builtin_convertvector(v, bf16v2_)); }

template <class F> struct EpiAdapt {
    static constexpr bool PERM = true, AFTER_DRAIN = false;
    F f;
    __device__ __forceinline__ void operator()(const f32x4 (&acc)[2][2][4][2], const Unit& u, int wr, int wc, int fr, int fq) const {
        F g = f;
#pragma unroll
        for (int ai = 0; ai < 2; ++ai)
#pragma unroll
            for (int m = 0; m < 4; ++m) {
                const int row = u.pm * BM + ai * HALF + wr * 64 + m * 16 + fr;
                g.begin();
                if constexpr (F::PAIR) g.pair8(row, u.pn, wc * 32 + 8 * fq, acc[ai][0][m][0], acc[ai][0][m][1], acc[ai][1][m][0], acc[ai][1][m][1]);
                else {
#pragma unroll
                    for (int bj = 0; bj < 2; ++bj) g.oct(row, u.pn, bj * HALF + wc * 32 + 8 * fq, acc[ai][bj][m][0], acc[ai][bj][m][1]);
                }
                g.end(row);
            }
    }
};
template <class Epi, class Sched, bool ALIGN_EPI = false, bool SP2 = false>
__device__ __forceinline__ void gemm_phase(PG8_LAS unsigned char* lds, const Gemm g, const Sched& S, const Epi& E) {
    int tid_ = threadIdx.x; asm volatile("" : "+v"(tid_));
    const int tid = tid_, wid = __builtin_amdgcn_readfirstlane(tid >> 6), lane = tid & 63, wr = wid >> 2, wc = wid & 3, fr = lane & 15, fq = lane >> 4;
    const int K = g.K, nt = K / BK;
    unsigned voffA[2], voffB[2];
#pragma unroll
    for (int i = 0; i < 2; ++i) { int R, C; stage_rc(tid * 16 + i * 8192, R, C); const int Rb = Epi::PERM ? ((R & ~31) + perm32(R & 31)) : R;
        voffA[i] = (unsigned)(R * K + C) * 2u; voffB[i] = (unsigned)(Rb * K + C) * 2u; }
    const size_t kstep = (size_t)(BK * 2);
    const size_t hstep = (size_t)HALF * K * 2;
    const size_t tstep = 2 * hstep;
    const unsigned ldsw = (unsigned)wid * 1024u;
    const int aoff = lds_byte(wr * 64 + fr, fq * 8), boff = lds_byte(wc * 32 + fr, fq * 8);
#define PG8_SA(b, h) (((b) * 2 + (h)) * HTB)
#define PG8_SB(b, h) ((4 + (b) * 2 + (h)) * HTB)
#define PG8_STAGE(bufoff, gbase, voff) do { _Pragma("unroll") for (int _i = 0; _i < 2; ++_i) \
        __builtin_amdgcn_global_load_lds((const unsigned*)((const char*)(gbase) + (voff)[_i]), (PG8_LAS unsigned*)(lds + (bufoff) + ldsw + _i * 8192), 16, 0, 0); } while (0)
#define PG8_LDA(dst, b, h) do { _Pragma("unroll") for (int m = 0; m < 4; ++m) _Pragma("unroll") for (int k = 0; k < 2; ++k) dst[m][k] = *(const PG8_LAS bf16x8*)(lds + PG8_SA(b, h) + aoff + m * 2048 + k * 1024); } while (0)
#define PG8_LDB(dst, b, h) do { _Pragma("unroll") for (int n = 0; n < 2; ++n) _Pragma("unroll") for (int k = 0; k < 2; ++k) dst[n][k] = *(const PG8_LAS bf16x8*)(lds + PG8_SB(b, h) + boff + n * 2048 + k * 1024); } while (0)
#define PG8_MMA(ai, bj, At, Bt) do { __builtin_amdgcn_s_setprio(1); _Pragma("unroll") for (int m = 0; m < 4; ++m) _Pragma("unroll") for (int n = 0; n < 2; ++n) _Pragma("unroll") for (int k = 0; k < 2; ++k) \
        acc[ai][bj][m][n] = __builtin_amdgcn_mfma_f32_16x16x32_bf16(Bt[n][k], At[m][k], acc[ai][bj][m][n], 0, 0, 0); __builtin_amdgcn_s_setprio(0); } while (0)
#define PG8_WAIT_V(n) asm volatile("s_waitcnt vmcnt(" #n ")" ::: "memory")
#define PG8_WAIT_L(n) asm volatile("s_waitcnt lgkmcnt(" #n ")" ::: "memory")
#define PG8_BAR __builtin_amdgcn_s_barrier()
#define PG8_SCHED __builtin_amdgcn_sched_barrier(0)
    Unit cur, nxt; int ui = 0;
    if (!S.next(0, cur)) return;
    f32x4 acc[2][2][4][2];
#pragma unroll
    for (int a = 0; a < 2; ++a)
#pragma unroll
        for (int b = 0; b < 2; ++b)
#pragma unroll
            for (int m = 0; m < 4; ++m)
#pragma unroll
                for (int n = 0; n < 2; ++n) acc[a][b][m][n] = (f32x4){0.f, 0.f, 0.f, 0.f};
    bf16x8 At[4][2], B0[2][2], B1[2][2];
    const char* cA = (const char*)g.A + (size_t)cur.pm * tstep; const char* cB = (const char*)g.Bt + (size_t)cur.pn * tstep;
    S.a_ready(cur);
    if constexpr (SP2) {
        PG8_STAGE(PG8_SB(0, 0), cB, voffB); PG8_STAGE(PG8_SB(0, 1), cB + hstep, voffB); PG8_STAGE(PG8_SA(0, 0), cA, voffA); PG8_STAGE(PG8_SA(0, 1), cA + hstep, voffA);
        if (wr == 1) PG8_BAR;
        PG8_WAIT_V(2); PG8_BAR;
        PG8_STAGE(PG8_SB(1, 0), cB + kstep, voffB); PG8_STAGE(PG8_SA(1, 0), cA + kstep, voffA); PG8_STAGE(PG8_SB(1, 1), cB + hstep + kstep, voffB);
        PG8_WAIT_V(6); PG8_BAR;
    } else {
        PG8_STAGE(PG8_SB(0, 0), cB, voffB); PG8_STAGE(PG8_SA(0, 0), cA, voffA); PG8_STAGE(PG8_SB(0, 1), cB + hstep, voffB); PG8_STAGE(PG8_SA(0, 1), cA + hstep, voffA);
        if (wr == 1) PG8_BAR;
        PG8_WAIT_V(4); PG8_BAR;
        PG8_STAGE(PG8_SB(1, 0), cB + kstep, voffB); PG8_STAGE(PG8_SA(1, 0), cA + kstep, voffA); PG8_STAGE(PG8_SB(1, 1), cB + hstep + kstep, voffB);
        PG8_WAIT_V(6); PG8_BAR;
    }
    for (;;) {
        const bool has_next = S.next(ui + 1, nxt);
        const char* nA = has_next ? (const char*)g.A + (size_t)nxt.pm * tstep : cA; const char* nB = has_next ? (const char*)g.Bt + (size_t)nxt.pn * tstep : cB;
        for (int t = 0; t < nt; t += 2) {
            const bool last = (t == nt - 2);
            const char* a1 = cA + (size_t)(t + 1) * kstep;
            const char* a2 = last ? nA : cA + (size_t)(t + 2) * kstep; const char* b2 = last ? nB : cB + (size_t)(t + 2) * kstep;
            const char* a3 = a2 + kstep; const char* b3 = b2 + kstep;
            if (last && has_next) S.a_ready(nxt);
            if constexpr (SP2) {
            PG8_LDB(B0, 0, 0); PG8_LDB(B1, 0, 1); PG8_SCHED; PG8_LDA(At, 0, 0); PG8_STAGE(PG8_SA(1, 1), a1 + hstep, voffA);
            PG8_WAIT_V(8); PG8_WAIT_L(0); PG8_BAR; PG8_MMA(0, 0, At, B0); PG8_MMA(0, 1, At, B1); PG8_BAR; PG8_SCHED;
            PG8_LDA(At, 0, 1); PG8_STAGE(PG8_SB(0, 0), b2, voffB); PG8_STAGE(PG8_SB(0, 1), b2 + hstep, voffB); PG8_STAGE(PG8_SA(0, 0), a2, voffA);
            PG8_WAIT_V(8); PG8_WAIT_L(0); PG8_BAR; PG8_MMA(1, 0, At, B0); PG8_MMA(1, 1, At, B1); PG8_BAR; PG8_SCHED;
            PG8_LDB(B0, 1, 0); PG8_LDB(B1, 1, 1); PG8_SCHED; PG8_LDA(At, 1, 0); PG8_STAGE(PG8_SA(0, 1), a2 + hstep, voffA);
            PG8_WAIT_V(8); PG8_WAIT_L(0); PG8_BAR; PG8_MMA(0, 0, At, B0); PG8_MMA(0, 1, At, B1); PG8_BAR; PG8_SCHED;
            PG8_LDA(At, 1, 1); PG8_STAGE(PG8_SB(1, 0), b3, voffB); PG8_STAGE(PG8_SB(1, 1), b3 + hstep, voffB); PG8_STAGE(PG8_SA(1, 0), a3, voffA);
            PG8_WAIT_V(8); PG8_WAIT_L(0); PG8_BAR; PG8_MMA(1, 0, At, B0); PG8_MMA(1, 1, At, B1); PG8_BAR; PG8_SCHED;
            } else {
            PG8_LDB(B0, 0, 0); PG8_SCHED; PG8_LDA(At, 0, 0); PG8_STAGE(PG8_SA(1, 1), a1 + hstep, voffA);
            PG8_WAIT_L(8); PG8_BAR; PG8_WAIT_L(0); PG8_MMA(0, 0, At, B0); PG8_BAR; PG8_SCHED;
            PG8_LDB(B1, 0, 1); PG8_STAGE(PG8_SB(0, 0), b2, voffB);
            PG8_BAR; PG8_WAIT_L(0); PG8_MMA(0, 1, At, B1); PG8_BAR;
            PG8_LDA(At, 0, 1); PG8_STAGE(PG8_SA(0, 0), a2, voffA);
            PG8_BAR; PG8_WAIT_L(0); PG8_MMA(1, 0, At, B0); PG8_BAR; PG8_SCHED;
            PG8_STAGE(PG8_SB(0, 1), b2 + hstep, voffB);
            PG8_WAIT_V(6); PG8_BAR; PG8_MMA(1, 1, At, B1); PG8_BAR;
            PG8_LDB(B0, 1, 0); PG8_SCHED; PG8_LDA(At, 1, 0); PG8_STAGE(PG8_SA(0, 1), a2 + hstep, voffA);
            PG8_WAIT_L(8); PG8_BAR; PG8_WAIT_L(0); PG8_MMA(0, 0, At, B0); PG8_BAR; PG8_SCHED;
            PG8_LDB(B1, 1, 1); PG8_STAGE(PG8_SB(1, 0), b3, voffB);
            PG8_BAR; PG8_WAIT_L(0); PG8_MMA(0, 1, At, B1); PG8_BAR;
            PG8_LDA(At, 1, 1); PG8_STAGE(PG8_SA(1, 0), a3, voffA);
            PG8_BAR; PG8_WAIT_L(0); PG8_MMA(1, 0, At, B0); PG8_BAR; PG8_SCHED;
            PG8_STAGE(PG8_SB(1, 1), b3 + hstep, voffB);
            PG8_WAIT_V(6); PG8_BAR; PG8_MMA(1, 1, At, B1); PG8_BAR;
            }
        }
        if constexpr (ALIGN_EPI) { if (wr == 0) PG8_BAR; }
        if constexpr (!Epi::AFTER_DRAIN) { E(acc, cur, wr, wc, fr, fq); S.done(cur); }
        if (!has_next) break;
#pragma unroll
        for (int a = 0; a < 2; ++a)
#pragma unroll
            for (int b = 0; b < 2; ++b)
#pragma unroll
                for (int m = 0; m < 4; ++m)
#pragma unroll
                    for (int n = 0; n < 2; ++n) acc[a][b][m][n] = (f32x4){0.f, 0.f, 0.f, 0.f};
        cur = nxt; cA = nA; cB = nB; ++ui;
        if constexpr (ALIGN_EPI) { if (wr == 1) PG8_BAR; }
    }
    PG8_WAIT_V(0);
    if constexpr (!ALIGN_EPI) { if (wr == 0) PG8_BAR; }
    PG8_BAR;
    if constexpr (Epi::AFTER_DRAIN) { E.fused(acc, cur, wr, wc, fr, fq, lds, wid, lane); S.done(cur); }
#undef PG8_SA
#undef PG8_SB
#undef PG8_STAGE
#undef PG8_LDA
#undef PG8_LDB
#undef PG8_MMA
#undef PG8_WAIT_V
#undef PG8_WAIT_L
#undef PG8_BAR
#undef PG8_SCHED
}
}

__device__ __forceinline__ u32x4 pack8(f32x4 a, f32x4 b) { u32x4 w; w.x = pg8::cvt_pk_bf16(a.x, a.y); w.y = pg8::cvt_pk_bf16(a.z, a.w); w.z = pg8::cvt_pk_bf16(b.x, b.y); w.w = pg8::cvt_pk_bf16(b.z, b.w); return w; }
__device__ __forceinline__ f32x4 ld4bf(const bf16_t* p) { const u32x2 w = *(const u32x2*)p; f32x4 r; r.x = __builtin_bit_cast(float, w.x << 16); r.y = __builtin_bit_cast(float, w.x & 0xffff0000u); r.z = __builtin_bit_cast(float, w.y << 16); r.w = __builtin_bit_cast(float, w.y & 0xffff0000u); return r; }
__device__ __forceinline__ f32x4 up4(u32x2 w) { f32x4 r; r.x = __builtin_bit_cast(float, w.x << 16); r.y = __builtin_bit_cast(float, w.x & 0xffff0000u); r.z = __builtin_bit_cast(float, w.y << 16); r.w = __builtin_bit_cast(float, w.y & 0xffff0000u); return r; }
__device__ __forceinline__ float sumsq4(f32x4 h) { return (h.x * h.x + h.y * h.y) + (h.z * h.z + h.w * h.w); }
struct EpiP {
    static constexpr bool PAIR = false;
    unsigned char* ws;
    __device__ __forceinline__ void begin() {}
    __device__ __forceinline__ void end(int) {}
    __device__ __forceinline__ void oct(int row, int pn, int c, f32x4 v0, f32x4 v1) {
        if (pn == 44) { float* d = (float*)(ws + WS_SM) + (size_t)row * 256 + c; *(f32x4*)d = v0; *(f32x4*)(d + 4) = v1; return; }
        bf16_t* base; int ld, col;
        if (pn < 8) { base = (bf16_t*)(ws + WS_Z); ld = 2048; col = pn * 256 + c; }
        else if (pn < 20) { base = (bf16_t*)(ws + WS_XBC); ld = 3072; col = (pn - 8) * 256 + c; }
        else if (pn < 44) {
            base = (bf16_t*)(ws + (pn < 28 ? WS_R : (pn < 36 ? WS_K : WS_V))); const int cs = ((pn - 20) & 7) * 256 + c, hd = cs >> 6;
            *(u32x4*)(base + ((size_t)((row / SEQ) * 32 + hd) * SEQ + (row % SEQ)) * 64 + (cs & 63)) = pack8(v0, v1); return; }
        else { base = (bf16_t*)(ws + WS_GD); ld = 256; col = c; }
        *(u32x4*)(base + (size_t)row * ld + col) = pack8(v0, v1);
    }
};
struct EpiOut {
    static constexpr bool PAIR = false;
    const float* x; bf16_t* h1b; float* rowss; float s;
    __device__ __forceinline__ void begin() { s = 0.f; }
    __device__ __forceinline__ void oct(int row, int pn, int c, f32x4 v0, f32x4 v1) {
        const size_t off = (size_t)row * DM + pn * 256 + c;
        const f32x4 a = *(const f32x4*)(x + off) + v0, b = *(const f32x4*)(x + off + 4) + v1;
        *(u32x4*)(h1b + off) = pack8(a, b);
        s += sumsq4(a) + sumsq4(b);
    }
    __device__ __forceinline__ void end(int row) { float t = s; t += __shfl_xor(t, 16); t += __shfl_xor(t, 32); if ((otid() & 63) < 16) atomicAdd(rowss + row, t); }
};
struct EpiGU {
    static constexpr bool PAIR = true;
    const float* rowss; bf16_t* act;
    __device__ __forceinline__ void begin() {}
    __device__ __forceinline__ void end(int) {}
    __device__ __forceinline__ void pair8(int row, int pn, int c, f32x4 g0, f32x4 g1, f32x4 u0, f32x4 u1) {
        const float rs = __builtin_amdgcn_rsqf(rowss[row] * (1.f / DM) + RMS_EPS);
        g0 = g0 * rs; g1 = g1 * rs; u0 = u0 * rs; u1 = u1 * rs;
        f32x4 a, b;
        a.x = siluf_(g0.x) * u0.x; a.y = siluf_(g0.y) * u0.y; a.z = siluf_(g0.z) * u0.z; a.w = siluf_(g0.w) * u0.w;
        b.x = siluf_(g1.x) * u1.x; b.y = siluf_(g1.y) * u1.y; b.z = siluf_(g1.z) * u1.z; b.w = siluf_(g1.w) * u1.w;
        *(u32x4*)(act + (size_t)row * D_FF + pn * 128 + c) = pack8(a, b);
    }
};
struct EpiDown {
    static constexpr bool PAIR = false;
    const bf16_t* h1b; bf16_t* h2b; float* rowss; float s;
    __device__ __forceinline__ void begin() { s = 0.f; }
    __device__ __forceinline__ void oct(int row, int pn, int c, f32x4 v0, f32x4 v1) {
        const size_t off = (size_t)row * DM + pn * 256 + c;
        const u32x4 hw = *(const u32x4*)(h1b + off);
        const f32x4 a = up4((u32x2){hw.x, hw.y}) + v0, b = up4((u32x2){hw.z, hw.w}) + v1;
        *(u32x4*)(h2b + off) = pack8(a, b);
        s += sumsq4(a) + sumsq4(b);
    }
    __device__ __forceinline__ void end(int row) { float t = s; t += __shfl_xor(t, 16); t += __shfl_xor(t, 32); if ((otid() & 63) < 16) atomicAdd(rowss + row, t); }
};
template <class F> __device__ __forceinline__ void run_gemm(LAS unsigned char* lds, const bf16_t* A, const bf16_t* Bt, int Mr, int N, int K, const F& f) {
    pg8::Gemm g{A, Bt, Mr, N, K}; pg8::StaticOrder S; S.init(Mr, N, (int)gridDim.x, (int)blockIdx.x);
    pg8::EpiAdapt<F> E{f};
    pg8::gemm_phase<pg8::EpiAdapt<F>, pg8::StaticOrder, true, true>(lds, g, S, E);
}

constexpr int SSD_XT = 0;
constexpr int SSD_B = 73728;
constexpr int SSD_C = SSD_B + 18432;
constexpr int SSD_CB = SSD_C + 17408;
constexpr int SSD_ACS = SSD_CB + 17408;
constexpr int SSD_DT = SSD_ACS + 2048;
constexpr int SSD_PART = SSD_DT + 2048;
constexpr size_t WS_CD = 128 * 1024;
__device__ __forceinline__ void unpack8(u32x4 w, float (&f)[8]) {
    f[0] = __builtin_bit_cast(float, w.x << 16); f[1] = __builtin_bit_cast(float, w.x & 0xffff0000u); f[2] = __builtin_bit_cast(float, w.y << 16); f[3] = __builtin_bit_cast(float, w.y & 0xffff0000u);
    f[4] = __builtin_bit_cast(float, w.z << 16); f[5] = __builtin_bit_cast(float, w.z & 0xffff0000u); f[6] = __builtin_bit_cast(float, w.w << 16); f[7] = __builtin_bit_cast(float, w.w & 0xffff0000u);
}
template <bool WITH_C, bool B_TR>
__device__ __forceinline__ void ssd_stage(const Params& p, LAS unsigned char* lds, int b, int c, int g) {
    const int tid = otid(); constexpr int NCG = WITH_C ? 96 : 80;
    if (tid < NCG * 4) {
        const int cg = tid >> 2, seg = tid & 3;
        const int kind = cg < 64 ? 0 : (cg < 80 ? 1 : 2);
        const int col0 = kind == 0 ? 512 * g + 8 * cg : (kind == 1 ? 2048 + 128 * g + 8 * (cg - 64) : 2560 + 128 * g + 8 * (cg - 80));
        const float* cw = p.in[I_CONVW] + col0; const float* cb = p.in[I_CONVB] + col0;
        float w0[8], w1[8], w2[8], w3[8], bs[8];
#pragma unroll
        for (int i = 0; i < 8; ++i) { w0[i] = cw[i]; w1[i] = cw[D_XBC + i]; w2[i] = cw[2 * D_XBC + i]; w3[i] = cw[3 * D_XBC + i]; bs[i] = cb[i]; }
        const int tb = 64 * c + 16 * seg;
        const bf16_t* src = (const bf16_t*)(p.ws + WS_XBC) + ((size_t)b * SEQ + tb) * D_XBC + col0;
        const u32x4 zz = {0u, 0u, 0u, 0u};
        u32x4 rows[19];
        rows[0] = tb >= 3 ? *(const u32x4*)(src - 3 * D_XBC) : zz; rows[1] = tb >= 2 ? *(const u32x4*)(src - 2 * D_XBC) : zz; rows[2] = tb >= 1 ? *(const u32x4*)(src - 1 * D_XBC) : zz;
#pragma unroll
        for (int tt = 0; tt < 16; ++tt) rows[3 + tt] = *(const u32x4*)(src + (size_t)tt * D_XBC);
        float u1[8], u2[8], u3[8];
        unpack8(rows[0], u3); unpack8(rows[1], u2); unpack8(rows[2], u1);
#pragma unroll
        for (int hb = 0; hb < 2; ++hb) {
            float y[8][8];
#pragma unroll
            for (int tt = 0; tt < 8; ++tt) {
                float u0[8]; unpack8(rows[3 + 8 * hb + tt], u0);
#pragma unroll
                for (int i = 0; i < 8; ++i) { const float a = w0[i] * u3[i] + w1[i] * u2[i] + w2[i] * u1[i] + w3[i] * u0[i] + bs[i]; y[tt][i] = a * __builtin_amdgcn_rcpf(1.f + __expf(-a)); u3[i] = u2[i]; u2[i] = u1[i]; u1[i] = u0[i]; }
            }
            const bool tr = (kind == 0) || (kind == 1 && B_TR);
            if (tr) {
                LAS unsigned char* img = lds + (kind == 0 ? SSD_XT : SSD_B);
                const int r0 = kind == 0 ? 8 * cg : 8 * (cg - 64);
#pragma unroll
                for (int i = 0; i < 8; ++i) { u32x4 w; w.x = pg8::cvt_pk_bf16(y[0][i], y[1][i]); w.y = pg8::cvt_pk_bf16(y[2][i], y[3][i]); w.z = pg8::cvt_pk_bf16(y[4][i], y[5][i]); w.w = pg8::cvt_pk_bf16(y[6][i], y[7][i]);
                    *(LAS u32x4*)(img + ((r0 + i) * 72 + 16 * seg + 8 * hb) * 2) = w; }
            } else {
                LAS unsigned char* img = lds + (kind == 1 ? SSD_B : SSD_C);
                const int c0 = kind == 1 ? 8 * (cg - 64) : 8 * (cg - 80);
#pragma unroll
                for (int tt = 0; tt < 8; ++tt) { u32x4 w; w.x = pg8::cvt_pk_bf16(y[tt][0], y[tt][1]); w.y = pg8::cvt_pk_bf16(y[tt][2], y[tt][3]); w.z = pg8::cvt_pk_bf16(y[tt][4], y[tt][5]); w.w = pg8::cvt_pk_bf16(y[tt][6], y[tt][7]);
                    *(LAS u32x4*)(img + ((16 * seg + 8 * hb + tt) * 136 + c0) * 2) = w; }
            }
        }
    }
}
__device__ __forceinline__ void ssd_dt(const Params& p, LAS unsigned char* lds, int b, int c, int g) {
    const int lane = otid() & 63, e = otid() >> 6, eg = 8 * g + e;
    const float* SM = (const float*)(p.ws + WS_SM);
    const float dt = softplusf_(SM[((size_t)b * SEQ + 64 * c + lane) * 256 + eg] + p.in[I_DTB][eg]);
    float a = dt * -__expf(p.in[I_ALOG][eg]);
#pragma unroll
    for (int o = 1; o < 64; o <<= 1) { const float t = __shfl_up(a, o); if (lane >= o) a += t; }
    ((LAS float*)(lds + SSD_ACS))[lane * 8 + e] = a; ((LAS float*)(lds + SSD_DT))[lane * 8 + e] = dt;
}
__device__ void phase_ssd1(const Params& p, LAS unsigned char* lds, int wg, int nwg) {
    const int tid = otid(), lane = tid & 63, e = tid >> 6, fr = lane & 15, fq = lane >> 4;
    bf16_t* S = (bf16_t*)p.out; float* CD = (float*)(p.ws + WS_CTL + WS_CD);
    for (int unit = wg; unit < BATCH * 128 * NGRP; unit += nwg) {
        const int g = unit & 3, c = (unit >> 2) & 127, b = unit >> 9, eg = 8 * g + e;
        __syncthreads();
        ssd_stage<false, true>(p, lds, b, c, g);
        ssd_dt(p, lds, b, c, g);
        __syncthreads();
        LAS const float* ACS = (LAS const float*)(lds + SSD_ACS); LAS const float* DT = (LAS const float*)(lds + SSD_DT);
        const float alast = ACS[63 * 8 + e];
        f32x4 acc[8][4];
#pragma unroll
        for (int nt = 0; nt < 8; ++nt)
#pragma unroll
            for (int pt = 0; pt < 4; ++pt) acc[nt][pt] = (f32x4){0.f, 0.f, 0.f, 0.f};
#pragma unroll
        for (int ks = 0; ks < 2; ++ks) {
            float wl[8];
#pragma unroll
            for (int j = 0; j < 8; ++j) { const int s = 32 * ks + 8 * fq + j; wl[j] = DT[s * 8 + e] * __expf(alast - ACS[s * 8 + e]); }
            bf16x8 xb[4];
#pragma unroll
            for (int pt = 0; pt < 4; ++pt) {
                float f[8]; unpack8(*(LAS const u32x4*)(lds + SSD_XT + ((64 * e + 16 * pt + fr) * 72 + 32 * ks + 8 * fq) * 2), f);
                u32x4 w; w.x = pg8::cvt_pk_bf16(f[0] * wl[0], f[1] * wl[1]); w.y = pg8::cvt_pk_bf16(f[2] * wl[2], f[3] * wl[3]); w.z = pg8::cvt_pk_bf16(f[4] * wl[4], f[5] * wl[5]); w.w = pg8::cvt_pk_bf16(f[6] * wl[6], f[7] * wl[7]);
                xb[pt] = __builtin_bit_cast(bf16x8, w);
            }
#pragma unroll
            for (int nt = 0; nt < 8; ++nt) {
                const bf16x8 bt = *(LAS const bf16x8*)(lds + SSD_B + ((16 * nt + fr) * 72 + 32 * ks + 8 * fq) * 2);
#pragma unroll
                for (int pt = 0; pt < 4; ++pt) acc[nt][pt] = __builtin_amdgcn_mfma_f32_16x16x32_bf16(bt, xb[pt], acc[nt][pt], 0, 0, 0);
            }
        }
        bf16_t* sb = S + ((((size_t)b * 128 + c) * 32 + eg) * 64) * 128;
#pragma unroll
        for (int pt = 0; pt < 4; ++pt)
#pragma unroll
            for (int nt = 0; nt < 8; ++nt) { u32x2 w; w.x = pg8::cvt_pk_bf16_c(acc[nt][pt].x, acc[nt][pt].y); w.y = pg8::cvt_pk_bf16_c(acc[nt][pt].z, acc[nt][pt].w); *(u32x2*)(sb + (size_t)(16 * pt + fr) * 128 + 16 * nt + 4 * fq) = w; }
        if (lane == 0) CD[(b * 128 + c) * 32 + eg] = __expf(alast);
    }
}
__device__ void phase_ssd2(const Params& p, int wg, int nwg) {
    bf16_t* S = (bf16_t*)p.out; const float* CD = (const float*)(p.ws + WS_CTL + WS_CD);
    for (int idx = wg * 512 + otid(); idx < BATCH * 32 * 64 * 32; idx += nwg * 512) {
        const int n4 = idx & 31, pp = (idx >> 5) & 63, eg = (idx >> 11) & 31, b = idx >> 16;
        bf16_t* base = S + ((((size_t)b * 128) * 32 + eg) * 64 + pp) * 128 + 4 * n4;
        const float* cd = CD + (b * 128) * 32 + eg;
        f32x4 h = {0.f, 0.f, 0.f, 0.f};
#pragma unroll 16
        for (int c = 0; c < 128; ++c) {
            bf16_t* q = base + (size_t)c * (32 * 64 * 128);
            const f32x4 s = ld4bf(q); const float d = cd[c * 32];
            u32x2 w; w.x = pg8::cvt_pk_bf16(h.x, h.y); w.y = pg8::cvt_pk_bf16(h.z, h.w); *(u32x2*)q = w;
            h = h * d + s;
        }
    }
}
__device__ void phase_ssd3(const Params& p, bf16_t* ymix, LAS unsigned char* lds, int wg, int nwg) {
    const int tid = otid(), lane = tid & 63, e = tid >> 6, fr = lane & 15, fq = lane >> 4;
    const bf16_t* S = (const bf16_t*)p.out; const bf16_t* Z = (const bf16_t*)(p.ws + WS_Z);
    for (int unit = wg; unit < BATCH * 128 * NGRP; unit += nwg) {
        const int g = unit & 3, c = (unit >> 2) & 127, b = unit >> 9, eg = 8 * g + e;
        const size_t m0 = (size_t)b * SEQ + 64 * c;
        __syncthreads();
        ssd_stage<true, false>(p, lds, b, c, g);
        ssd_dt(p, lds, b, c, g);
        const bf16_t* hb = S + ((((size_t)b * 128 + c) * 32 + eg) * 64) * 128;
        bf16x8 hfa[4][4];
#pragma unroll
        for (int ks = 0; ks < 4; ++ks)
#pragma unroll
            for (int pt = 0; pt < 4; ++pt) hfa[ks][pt] = *(const bf16x8*)(hb + (size_t)(16 * pt + fr) * 128 + 32 * ks + 8 * fq);
        __syncthreads();
        {
            const int st = e >> 1;
            f32x4 cbacc[2] = {(f32x4){0.f, 0.f, 0.f, 0.f}, (f32x4){0.f, 0.f, 0.f, 0.f}};
#pragma unroll
            for (int ks = 0; ks < 4; ++ks) {
                const bf16x8 bfr = *(LAS const bf16x8*)(lds + SSD_B + ((16 * st + fr) * 136 + 32 * ks + 8 * fq) * 2);
#pragma unroll
                for (int j = 0; j < 2; ++j) { const int lt = 2 * (e & 1) + j; const bf16x8 cfr = *(LAS const bf16x8*)(lds + SSD_C + ((16 * lt + fr) * 136 + 32 * ks + 8 * fq) * 2); cbacc[j] = __builtin_amdgcn_mfma_f32_16x16x32_bf16(bfr, cfr, cbacc[j], 0, 0, 0); }
            }
#pragma unroll
            for (int j = 0; j < 2; ++j) { const int lt = 2 * (e & 1) + j; *(LAS f32x4*)(lds + SSD_CB + ((16 * lt + fr) * 68 + 16 * st + 4 * fq) * 4) = cbacc[j]; }
        }
        __syncthreads();
        LAS const float* ACS = (LAS const float*)(lds + SSD_ACS); LAS const float* DT = (LAS const float*)(lds + SSD_DT);
        const float Dsk = p.in[I_SSDD][eg];
        f32x4 acc[4][4];
#pragma unroll
        for (int pt = 0; pt < 4; ++pt)
#pragma unroll
            for (int lt = 0; lt < 4; ++lt) acc[pt][lt] = (f32x4){0.f, 0.f, 0.f, 0.f};
#pragma unroll
        for (int ks = 0; ks < 4; ++ks) {
            bf16x8 hf[4], cf[4];
#pragma unroll
            for (int pt = 0; pt < 4; ++pt) hf[pt] = hfa[ks][pt];
#pragma unroll
            for (int lt = 0; lt < 4; ++lt) cf[lt] = *(LAS const bf16x8*)(lds + SSD_C + ((16 * lt + fr) * 136 + 32 * ks + 8 * fq) * 2);
#pragma unroll
            for (int pt = 0; pt < 4; ++pt)
#pragma unroll
                for (int lt = 0; lt < 4; ++lt) acc[pt][lt] = __builtin_amdgcn_mfma_f32_16x16x32_bf16(hf[pt], cf[lt], acc[pt][lt], 0, 0, 0);
        }
        u32x2 zr[4][4];
#pragma unroll
        for (int lt = 0; lt < 4; ++lt)
#pragma unroll
            for (int pt = 0; pt < 4; ++pt) zr[lt][pt] = *(const u32x2*)(Z + (m0 + 16 * lt + fr) * D_SSD + 64 * eg + 16 * pt + 4 * fq);
        float acl[4];
#pragma unroll
        for (int lt = 0; lt < 4; ++lt) { acl[lt] = ACS[(16 * lt + fr) * 8 + e]; const float sc = __expf(acl[lt]);
#pragma unroll
            for (int pt = 0; pt < 4; ++pt) acc[pt][lt] = acc[pt][lt] * sc; }
#pragma unroll
        for (int ks = 0; ks < 2; ++ks) {
            float as_[8], ds_[8];
#pragma unroll
            for (int j = 0; j < 8; ++j) { const int s = 32 * ks + 8 * fq + j; as_[j] = ACS[s * 8 + e]; ds_[j] = DT[s * 8 + e]; }
            bf16x8 xa[4];
#pragma unroll
            for (int pt = 0; pt < 4; ++pt) xa[pt] = *(LAS const bf16x8*)(lds + SSD_XT + ((64 * e + 16 * pt + fr) * 72 + 32 * ks + 8 * fq) * 2);
#pragma unroll
            for (int lt = 0; lt < 4; ++lt) {
                if (32 * ks > 16 * lt + 15) continue;
                const int l = 16 * lt + fr;
                const f32x4 c0 = *(LAS const f32x4*)(lds + SSD_CB + (l * 68 + 32 * ks + 8 * fq) * 4), c1 = *(LAS const f32x4*)(lds + SSD_CB + (l * 68 + 32 * ks + 8 * fq + 4) * 4);
                float mv[8];
#pragma unroll
                for (int j = 0; j < 8; ++j) { const int s = 32 * ks + 8 * fq + j; const float cbv = j < 4 ? c0[j] : c1[j - 4];
                    float v = cbv * __expf(fminf(acl[lt] - as_[j], 0.f)) * ds_[j]; v = (s <= l) ? v : 0.f; mv[j] = (s == l) ? v + Dsk : v; }
                u32x4 w; w.x = pg8::cvt_pk_bf16(mv[0], mv[1]); w.y = pg8::cvt_pk_bf16(mv[2], mv[3]); w.z = pg8::cvt_pk_bf16(mv[4], mv[5]); w.w = pg8::cvt_pk_bf16(mv[6], mv[7]);
                const bf16x8 mf = __builtin_bit_cast(bf16x8, w);
#pragma unroll
                for (int pt = 0; pt < 4; ++pt) acc[pt][lt] = __builtin_amdgcn_mfma_f32_16x16x32_bf16(xa[pt], mf, acc[pt][lt], 0, 0, 0);
            }
        }
        float ssq[4];
#pragma unroll
        for (int lt = 0; lt < 4; ++lt) {
            float s = 0.f;
#pragma unroll
            for (int pt = 0; pt < 4; ++pt) {
                const f32x4 z = up4(zr[lt][pt]);
                f32x4 y = acc[pt][lt];
                y.x *= siluf_(z.x); y.y *= siluf_(z.y); y.z *= siluf_(z.z); y.w *= siluf_(z.w);
                acc[pt][lt] = y; s += (y.x * y.x + y.y * y.y) + (y.z * y.z + y.w * y.w);
            }
            s += __shfl_xor(s, 16); s += __shfl_xor(s, 32); ssq[lt] = s;
            if (fq == 0) ((LAS float*)(lds + SSD_PART))[e * 64 + 16 * lt + fr] = s;
        }
        __syncthreads();
#pragma unroll
        for (int lt = 0; lt < 4; ++lt) {
            float tot = 0.f;
#pragma unroll
            for (int w = 0; w < 8; ++w) tot += ((LAS const float*)(lds + SSD_PART))[w * 64 + 16 * lt + fr];
            const float rstd = 1.f / sqrtf(tot * (1.f / 512.f) + GATED_EPS);
#pragma unroll
            for (int pt = 0; pt < 4; ++pt) {
                const int col = 64 * eg + 16 * pt + 4 * fq;
                const f32x4 ng = *(const f32x4*)(p.in[I_SSDNG] + col);
                const f32x4 o = acc[pt][lt] * rstd * ng;
                u32x2 w; w.x = pg8::cvt_pk_bf16(o.x, o.y); w.y = pg8::cvt_pk_bf16(o.z, o.w);
                *(u32x2*)(ymix + (m0 + 16 * lt + fr) * D_MIX + col) = w;
            }
        }
    }
}

constexpr size_t WS_AW = 1 * MiB;
constexpr size_t WS_AA = 5 * MiB;
constexpr size_t WS_AG = 504 * MiB;
constexpr size_t WS_BON = WS_GD;
constexpr size_t WS_YRAW = WS_FREE;
__device__ void phase_rwkv_pre(const Params& p, int wg, int nwg) {
    const int tid = otid(), lane = tid & 63, wave = tid >> 6;
    const float* SM = (const float*)(p.ws + WS_SM); const bf16_t* GD = (const bf16_t*)(p.ws + WS_GD); const float* mu = p.in[I_MU];
    bf16_t* AW = (bf16_t*)(p.ws + WS_AW); bf16_t* AA = (bf16_t*)(p.ws + WS_AA); bf16_t* AG = (bf16_t*)(p.ws + WS_AG);
#pragma unroll 4
    for (int m = wg * 8 + wave; m < M; m += nwg * 8) {
        const bool hp = (m % SEQ) > 0;
#pragma unroll
        for (int i = 0; i < 2; ++i) {
            const int j = lane + 64 * i;
            float vw = 0.f, va = 0.f;
            if (j < 96) {
                { const float cur = SM[(size_t)m * 256 + 32 + j], prev = hp ? SM[(size_t)(m - 1) * 256 + 32 + j] : 0.f; vw = tanhf(cur + (prev - cur) * mu[MU_WD + j]); }
                { const float cur = SM[(size_t)m * 256 + 128 + j], prev = hp ? SM[(size_t)(m - 1) * 256 + 128 + j] : 0.f; va = cur + (prev - cur) * mu[MU_AD + j]; }
            }
            AW[(size_t)m * 128 + j] = (bf16_t)f2bf(vw); AA[(size_t)m * 128 + j] = (bf16_t)f2bf(va);
        }
#pragma unroll
        for (int i = 0; i < 4; ++i) {
            const int j = lane + 64 * i;
            const float cur = bf2f(GD[(size_t)m * 256 + j]), prev = hp ? bf2f(GD[(size_t)(m - 1) * 256 + j]) : 0.f;
            AG[(size_t)m * 256 + j] = (bf16_t)f2bf(sigmoidf_(cur + (prev - cur) * mu[MU_GD + j]));
        }
    }
}

__device__ __forceinline__ float afma(float a, float b, float c) { float d; asm("v_fma_f32 %0, %1, %2, %3" : "=v"(d) : "v"(a), "v"(b), "v"(c)); return d; }
__device__ __forceinline__ float amul(float a, float b) { float d; asm("v_mul_f32 %0, %1, %2" : "=v"(d) : "v"(a), "v"(b)); return d; }
#define LDS_BARRIER() do { asm volatile("s_waitcnt lgkmcnt(0)" ::: "memory"); __builtin_amdgcn_s_barrier(); asm volatile("" ::: "memory"); } while (0)
template <int CTRL> __device__ __forceinline__ float dpp_f(float x) { return __builtin_bit_cast(float, __builtin_amdgcn_update_dpp(0, __builtin_bit_cast(int, x), CTRL, 0xf, 0xf, true)); }
__device__ __forceinline__ float red16(float x) { x += dpp_f<0xB1>(x); x += dpp_f<0x4E>(x); x += dpp_f<0x124>(x); x += dpp_f<0x128>(x); return x; }

constexpr int R2_T = 32, R2_RING = 5 * 8192 + 2304 + 256, R2_W2H = 2 * R2_RING + 4096 + 2048;
__device__ void phase_rwkv_scan(const Params& p, LAS unsigned char* lds, int wg, int nwg) {
    constexpr int T = R2_T, NCH = SEQ / T;
    const int tid = otid(), lane = tid & 63, wave = __builtin_amdgcn_readfirstlane(tid >> 6);
    LAS float* cst = (LAS float*)(lds + 2 * R2_RING + 4096);
    const bf16_t* R = (const bf16_t*)(p.ws + WS_R); const bf16_t* Kb = (const bf16_t*)(p.ws + WS_K); const bf16_t* V = (const bf16_t*)(p.ws + WS_V);
    const bf16_t* AW = (const bf16_t*)(p.ws + WS_AW); const bf16_t* AA = (const bf16_t*)(p.ws + WS_AA);
    float* BON = (float*)(p.ws + WS_BON); bf16_t* YRAW = (bf16_t*)(p.ws + WS_YRAW);
    for (int unit = wg; unit < 256; unit += nwg) {
        const int xcd = unit & 7, idx = unit >> 3, q = idx & 3, bh = xcd * 8 + (idx >> 2), b = bh >> 5, h = bh & 31;
        __syncthreads();
        { const int arr = tid >> 6, ch = tid & 63; const float* srcs[8] = {p.in[I_W0], p.in[I_A0], p.in[I_KK], p.in[I_KA], p.in[I_RK], p.in[I_MU] + MU_R, p.in[I_MU] + MU_K, p.in[I_MU] + MU_V};
          float v = 0.f;
#pragma unroll
          for (int a = 0; a < 8; ++a) if (arr == a) v = srcs[a][h * 64 + ch];
          cst[arr * 64 + ch] = v; }
        {
            LAS bf16_t* w2h = (LAS bf16_t*)(lds + R2_W2H); LAS bf16_t* a2h = (LAS bf16_t*)(lds + R2_W2H + 17408);
            for (int i = tid; i < 128 * 64; i += 512) { const int k = i >> 6, ch = i & 63; float w2v = 0.f, a2v = 0.f;
                if (k < 96) { w2v = p.in[I_W2][(size_t)k * D_RWKV + h * 64 + ch]; a2v = p.in[I_A2][(size_t)k * D_RWKV + h * 64 + ch]; }
                w2h[ch * 136 + k] = (bf16_t)f2bf(w2v); a2h[ch * 136 + k] = (bf16_t)f2bf(a2v); }
        }
        __syncthreads();
        if (wave >= 4) {
            const int pw = wave - 4, mt = pw & 1, half = pw >> 1, fr = lane & 15, fq = lane >> 4;
            bf16x8 nAW[4], nAA[4]; u32x2 nR[2][2], nK[2][2], nV[2];
            const int vnt = q - 2 * half;
            const auto rsAW = __builtin_amdgcn_make_buffer_rsrc((void*)AW, 0, (int)(M * 128 * 2), 0x00020000), rsAA = __builtin_amdgcn_make_buffer_rsrc((void*)AA, 0, (int)(M * 128 * 2), 0x00020000);
            const auto rsR = __builtin_amdgcn_make_buffer_rsrc((void*)R, 0, (int)(M * 2048 * 2), 0x00020000), rsK = __builtin_amdgcn_make_buffer_rsrc((void*)Kb, 0, (int)(M * 2048 * 2), 0x00020000), rsV = __builtin_amdgcn_make_buffer_rsrc((void*)V, 0, (int)(M * 2048 * 2), 0x00020000);
            const int voA = ((16 * mt + fr) * 128 + 8 * fq) * 2, voR = ((16 * mt + fr) * 2048 + h * 64 + 32 * half + 4 * fq) * 2;
#define R2_PREFETCH(cc) do { const int row0_ = b * SEQ + T * (cc); const bool hp_ = (T * (cc) + 16 * mt + fr) > 0; const int soA_ = row0_ * 256, soR_ = row0_ * 4096, soP_ = row0_ > 0 ? (row0_ - 1) * 4096 : 0, vaP_ = row0_ > 0 ? 0 : -4096;     \
                _Pragma("unroll") for (int ks = 0; ks < 4; ++ks) { nAW[ks] = __builtin_bit_cast(bf16x8, __builtin_amdgcn_raw_buffer_load_b128(rsAW, voA + 64 * ks, soA_, 0)); nAA[ks] = __builtin_bit_cast(bf16x8, __builtin_amdgcn_raw_buffer_load_b128(rsAA, voA + 64 * ks, soA_, 0)); } \
                _Pragma("unroll") for (int nt = 0; nt < 2; ++nt) { \
                    nR[nt][0] = __builtin_bit_cast(u32x2, __builtin_amdgcn_raw_buffer_load_b64(rsR, voR + 32 * nt, soR_, 0)); nK[nt][0] = __builtin_bit_cast(u32x2, __builtin_amdgcn_raw_buffer_load_b64(rsK, voR + 32 * nt, soR_, 0)); nR[nt][1] = (u32x2){0u, 0u}; nK[nt][1] = (u32x2){0u, 0u}; \
                    if (hp_) { nR[nt][1] = __builtin_bit_cast(u32x2, __builtin_amdgcn_raw_buffer_load_b64(rsR, voR + 32 * nt + vaP_, soP_, 0)); nK[nt][1] = __builtin_bit_cast(u32x2, __builtin_amdgcn_raw_buffer_load_b64(rsK, voR + 32 * nt + vaP_, soP_, 0)); } \
                    if (nt == vnt) { nV[0] = __builtin_bit_cast(u32x2, __builtin_amdgcn_raw_buffer_load_b64(rsV, voR + 32 * nt, soR_, 0)); nV[1] = (u32x2){0u, 0u}; if (hp_) nV[1] = __builtin_bit_cast(u32x2, __builtin_amdgcn_raw_buffer_load_b64(rsV, voR + 32 * nt + vaP_, soP_, 0)); } } } while (0)
            R2_PREFETCH(0);
            unsigned long long pacc = 0;
            for (int c = 0; c <= NCH + 1; ++c) {
                unsigned long long tq0 = 0; if (PROBE_PH == 12 && blockIdx.x == 0 && pw == 0) tq0 = __builtin_amdgcn_s_memrealtime();
                if (c >= 2 && pw == 0) {
                    LAS const float* yo = (LAS const float*)(lds + 2 * R2_RING + ((c - 2) & 1) * 2048);
                    const int tok = lane >> 1, hf = lane & 1;
                    const f32x4 y0 = *(LAS const f32x4*)(yo + tok * 16 + 8 * hf), y1 = *(LAS const f32x4*)(yo + tok * 16 + 8 * hf + 4);
                    *(u32x4*)(YRAW + ((size_t)b * SEQ + (size_t)T * (c - 2) + tok) * D_RWKV + h * 64 + 16 * q + 8 * hf) = pack8(y0, y1);
                }
                if (c < NCH) {
                    LAS float* rg = (LAS float*)(lds + (c & 1) * R2_RING);
                    LAS float* r_an = rg; LAS float* r_ww = rg + 2048; LAS float* r_bb = rg + 4096; LAS float* r_kp = rg + 6144; LAS float* r_rr = rg + 8192; LAS float* r_vv = rg + 10240; LAS float* r_ss = rg + 10240 + 576;
                    const int tok = 16 * mt + fr; const size_t m = (size_t)b * SEQ + T * c + tok;
                    f32x4 accw[2], acca[2];
#pragma unroll
                    for (int nt = 0; nt < 2; ++nt) { accw[nt] = (f32x4){0.f, 0.f, 0.f, 0.f}; acca[nt] = (f32x4){0.f, 0.f, 0.f, 0.f}; }
#pragma unroll
                    for (int ks = 0; ks < 4; ++ks)
#pragma unroll
                        for (int nt = 0; nt < 2; ++nt) { const int bo = R2_W2H + ((32 * half + 16 * nt + fr) * 136 + 32 * ks + 8 * fq) * 2;
                            accw[nt] = __builtin_amdgcn_mfma_f32_16x16x32_bf16(*(LAS const bf16x8*)(lds + bo), nAW[ks], accw[nt], 0, 0, 0); acca[nt] = __builtin_amdgcn_mfma_f32_16x16x32_bf16(*(LAS const bf16x8*)(lds + bo + 17408), nAA[ks], acca[nt], 0, 0, 0); }
                    f32x4 rc_[2], rp_[2], kc_[2], kq_[2];
#pragma unroll
                    for (int nt = 0; nt < 2; ++nt) { rc_[nt] = up4(nR[nt][0]); rp_[nt] = up4(nR[nt][1]); kc_[nt] = up4(nK[nt][0]); kq_[nt] = up4(nK[nt][1]); }
                    const f32x4 vc_ = up4(nV[0]), vp_ = up4(nV[1]);
                    asm volatile("" : "+v"(accw[0]), "+v"(accw[1]), "+v"(acca[0]), "+v"(acca[1]));
                    if (c + 1 < NCH) R2_PREFETCH(c + 1);
                    float ssp = 0.f, bop = 0.f;
#pragma unroll
                    for (int nt = 0; nt < 2; ++nt) {
                        const int ch0 = 32 * half + 16 * nt + 4 * fq;
                        const f32x4 w0 = *(LAS const f32x4*)(cst + 0 * 64 + ch0), a0 = *(LAS const f32x4*)(cst + 1 * 64 + ch0), kkc = *(LAS const f32x4*)(cst + 2 * 64 + ch0), kac = *(LAS const f32x4*)(cst + 3 * 64 + ch0),
                                    rkc = *(LAS const f32x4*)(cst + 4 * 64 + ch0), mur = *(LAS const f32x4*)(cst + 5 * 64 + ch0), muk = *(LAS const f32x4*)(cst + 6 * 64 + ch0);
                        const f32x4 r4 = rc_[nt] + (rp_[nt] - rc_[nt]) * mur, k4 = kc_[nt] + (kq_[nt] - kc_[nt]) * muk;
                        f32x4 wv, ag;
#pragma unroll
                        for (int i = 0; i < 4; ++i) { const float sg = __builtin_amdgcn_rcpf(1.f + __expf(-(w0[i] + accw[nt][i]))); wv[i] = __expf(-0.60653066f * sg); ag[i] = __builtin_amdgcn_rcpf(1.f + __expf(-(a0[i] + acca[nt][i]))); }
                        const f32x4 kk = k4 * kkc, kp4 = k4 * (1.f + (ag - 1.f) * kac), b4 = kk * ag;
                        ssp += (kk.x * kk.x + kk.y * kk.y) + (kk.z * kk.z + kk.w * kk.w);
                        const f32x4 bo4 = r4 * kp4 * rkc; bop += (bo4.x + bo4.y) + (bo4.z + bo4.w);
                        const int so = tok * 64 + (ch0 ^ ((tok & 7) << 2));
                        *(LAS f32x4*)(r_an + so) = kk; *(LAS f32x4*)(r_ww + so) = wv; *(LAS f32x4*)(r_bb + so) = b4; *(LAS f32x4*)(r_kp + so) = kp4; *(LAS f32x4*)(r_rr + so) = r4;
                        if (nt == vnt) {
                            const f32x4 muv = *(LAS const f32x4*)(cst + 7 * 64 + ch0);
                            const f32x4 vv4 = vc_ + (vp_ - vc_) * muv;
                            r_vv[(4 * fq + 0) * 36 + tok] = vv4.x; r_vv[(4 * fq + 1) * 36 + tok] = vv4.y; r_vv[(4 * fq + 2) * 36 + tok] = vv4.z; r_vv[(4 * fq + 3) * 36 + tok] = vv4.w;
                        }
                    }
                    ssp += __shfl_xor(ssp, 16); ssp += __shfl_xor(ssp, 32); bop += __shfl_xor(bop, 16); bop += __shfl_xor(bop, 32);
                    if (fq == 0) { r_ss[tok * 2 + half] = ssp; if (q == 0) BON[(m * 32 + h) * 2 + half] = bop; }
                }
                if (PROBE_PH == 12 && blockIdx.x == 0 && pw == 0) { asm volatile("s_waitcnt lgkmcnt(0)" ::: "memory"); pacc += __builtin_amdgcn_s_memrealtime() - tq0; }
                if (c <= NCH) LDS_BARRIER();
            }
            if (PROBE_PH == 12 && blockIdx.x == 0 && pw == 0 && lane == 0) *(LAS unsigned long long*)(lds + 163840 - 16) = pacc;
#undef R2_PREFETCH
        } else {
            __builtin_amdgcn_s_setprio(2);
            const int cw = wave, g = lane >> 4, l16 = lane & 15, row = 4 * cw + g;
            float S0 = 0.f, S1 = 0.f, S2 = 0.f, S3 = 0.f;
            float yrot = 0.f;
            unsigned long long pacc = 0;
            LDS_BARRIER();
            for (int c = 0; c < NCH; ++c) {
                LAS const float* rg = (LAS const float*)(lds + (c & 1) * R2_RING);
                LAS const float* r_vv = rg + 10240 + row * 36; LAS const float* r_ss = rg + 10240 + 576;
                LAS float* yo = (LAS float*)(lds + 2 * R2_RING + (c & 1) * 2048) + row + (15 - l16) * 16;
                f32x4 vq[8];
#pragma unroll
                for (int i = 0; i < 8; ++i) vq[i] = *(LAS const f32x4*)(r_vv + 4 * i);
                float cv; { const int tt = lane & 31; cv = -__builtin_amdgcn_rcpf(fmaxf(r_ss[2 * tt] + r_ss[2 * tt + 1], 1e-24f)); }
                constexpr int PF = 4;
                f32x4 qa[PF], qw[PF], qb[PF], qk[PF], qr[PF];
#pragma unroll
                for (int t = 0; t < PF; ++t) { qa[t] = *(LAS const f32x4*)(rg + (4 * (l16 ^ (t & 7))) + t * 64); qw[t] = *(LAS const f32x4*)(rg + (4 * (l16 ^ (t & 7))) + 2048 + t * 64); qb[t] = *(LAS const f32x4*)(rg + (4 * (l16 ^ (t & 7))) + 4096 + t * 64); qk[t] = *(LAS const f32x4*)(rg + (4 * (l16 ^ (t & 7))) + 6144 + t * 64); qr[t] = *(LAS const f32x4*)(rg + (4 * (l16 ^ (t & 7))) + 8192 + t * 64); }
                unsigned long long tq0 = 0; if (PROBE_PH == 11 && blockIdx.x == 0 && wave == 0) tq0 = __builtin_amdgcn_s_memrealtime(); if (PROBE_PH == 13 && blockIdx.x == 0 && wave == 0) tq0 = __builtin_amdgcn_s_memtime();
                float sa = red16(afma(S0, qa[0].x, amul(S1, qa[0].y)) + afma(S2, qa[0].z, amul(S3, qa[0].w))) * __builtin_bit_cast(float, __builtin_amdgcn_readlane(__builtin_bit_cast(int, cv), 0));
#pragma unroll
                for (int t = 0; t < T; ++t) {
                    const int sl = t % PF;
                    const f32x4 w4 = qw[sl], b4 = qb[sl], k4 = qk[sl], r4 = qr[sl]; const float vr = vq[t >> 2][t & 3];
                    const f32x4 an = qa[(t + 1) % PF];
                    if (t + PF < T) { const int u = t + PF; qa[sl] = *(LAS const f32x4*)(rg + (4 * (l16 ^ (u & 7))) + u * 64); qw[sl] = *(LAS const f32x4*)(rg + (4 * (l16 ^ (u & 7))) + 2048 + u * 64); qb[sl] = *(LAS const f32x4*)(rg + (4 * (l16 ^ (u & 7))) + 4096 + u * 64); qk[sl] = *(LAS const f32x4*)(rg + (4 * (l16 ^ (u & 7))) + 6144 + u * 64); qr[sl] = *(LAS const f32x4*)(rg + (4 * (l16 ^ (u & 7))) + 8192 + u * 64); }
                    float y, z, m0, m1, m2, m3;
                    asm("v_mul_f32 %[m0], %[vr], %[k0]\n\tv_mul_f32 %[m1], %[vr], %[k1]\n\tv_mul_f32 %[m2], %[vr], %[k2]\n\tv_mul_f32 %[m3], %[vr], %[k3]\n\t"
                        "v_fma_f32 %[m0], %[sa], %[b0], %[m0]\n\tv_fma_f32 %[m1], %[sa], %[b1], %[m1]\n\tv_fma_f32 %[m2], %[sa], %[b2], %[m2]\n\tv_fma_f32 %[m3], %[sa], %[b3], %[m3]\n\t"
                        "v_fma_f32 %[S0], %[S0], %[w0], %[m0]\n\tv_fma_f32 %[S1], %[S1], %[w1], %[m1]\n\tv_fma_f32 %[S2], %[S2], %[w2], %[m2]\n\tv_fma_f32 %[S3], %[S3], %[w3], %[m3]\n\t"
                        "v_mul_f32 %[m0], %[S1], %[r1]\n\tv_mul_f32 %[m1], %[S3], %[r3]\n\tv_mul_f32 %[m2], %[S1], %[a1]\n\tv_mul_f32 %[m3], %[S3], %[a3]\n\t"
                        "v_fma_f32 %[m0], %[S0], %[r0], %[m0]\n\tv_fma_f32 %[m1], %[S2], %[r2], %[m1]\n\tv_fma_f32 %[m2], %[S0], %[a0], %[m2]\n\tv_fma_f32 %[m3], %[S2], %[a2], %[m3]\n\t"
                        "v_add_f32 %[y], %[m0], %[m1]\n\tv_add_f32 %[z], %[m2], %[m3]"
                        : [S0] "+v"(S0), [S1] "+v"(S1), [S2] "+v"(S2), [S3] "+v"(S3), [y] "=&v"(y), [z] "=&v"(z), [m0] "=&v"(m0), [m1] "=&v"(m1), [m2] "=&v"(m2), [m3] "=&v"(m3)
                        : [sa] "v"(sa), [vr] "v"(vr), [k0] "v"(k4.x), [k1] "v"(k4.y), [k2] "v"(k4.z), [k3] "v"(k4.w), [b0] "v"(b4.x), [b1] "v"(b4.y), [b2] "v"(b4.z), [b3] "v"(b4.w),
                          [w0] "v"(w4.x), [w1] "v"(w4.y), [w2] "v"(w4.z), [w3] "v"(w4.w), [r0] "v"(r4.x), [r1] "v"(r4.y), [r2] "v"(r4.z), [r3] "v"(r4.w), [a0] "v"(an.x), [a1] "v"(an.y), [a2] "v"(an.z), [a3] "v"(an.w));
                    y += dpp_f<0xB1>(y); z += dpp_f<0xB1>(z); y += dpp_f<0x4E>(y); z += dpp_f<0x4E>(z); y += dpp_f<0x124>(y); z += dpp_f<0x124>(z); y += dpp_f<0x128>(y); z += dpp_f<0x128>(z);
                    sa = z * __builtin_bit_cast(float, __builtin_amdgcn_readlane(__builtin_bit_cast(int, cv), (t + 1) % T));
                    yrot = __builtin_bit_cast(float, __builtin_amdgcn_update_dpp(__builtin_bit_cast(int, y), __builtin_bit_cast(int, yrot), 0x111, 0xf, 0xf, false));
                    if ((t & 15) == 15) yo[(t - 15) * 16] = yrot;
                }
                if (PROBE_PH == 11 && blockIdx.x == 0 && wave == 0) { asm volatile("s_waitcnt lgkmcnt(0)" ::: "memory"); pacc += __builtin_amdgcn_s_memrealtime() - tq0; }
                if (PROBE_PH == 13 && blockIdx.x == 0 && wave == 0) { asm volatile("s_waitcnt lgkmcnt(0)" ::: "memory"); pacc += __builtin_amdgcn_s_memtime() - tq0; }
                LDS_BARRIER();
            }
            if (PROBE_PH == 11 && blockIdx.x == 0 && wave == 0 && lane == 0) *(LAS unsigned long long*)(lds + 163840 - 16) = pacc;
            if (PROBE_PH == 13 && blockIdx.x == 0 && wave == 0 && lane == 0) *(LAS unsigned long long*)(lds + 163840 - 16) = pacc / 100;
            __builtin_amdgcn_s_setprio(0);
        }
    }
}

typedef short bf16x4 __attribute__((ext_vector_type(4)));
__device__ __forceinline__ bf16x4 pk4(f32x4 v) { u32x2 w; w.x = pg8::cvt_pk_bf16_c(v.x, v.y); w.y = pg8::cvt_pk_bf16_c(v.z, v.w); return __builtin_bit_cast(bf16x4, w); }
__device__ __forceinline__ bf16x8 pk8(f32x4 a, f32x4 b) { u32x4 w; w.x = pg8::cvt_pk_bf16_c(a.x, a.y); w.y = pg8::cvt_pk_bf16_c(a.z, a.w); w.z = pg8::cvt_pk_bf16_c(b.x, b.y); w.w = pg8::cvt_pk_bf16_c(b.z, b.w); return __builtin_bit_cast(bf16x8, w); }
#define MFMA16(a, b, c) __builtin_amdgcn_mfma_f32_16x16x16bf16_1k(a, b, c, 0, 0, 0)
#define MFMA32(a, b, c) __builtin_amdgcn_mfma_f32_16x16x32_bf16(a, b, c, 0, 0, 0)
constexpr int RC_SL = 11008, RC_AT = 0, RC_RT = 2048, RC_BT = 4096, RC_KT = 6144, RC_MAK = 8192, RC_MRB = 8704, RC_MRK = 9216, RC_TI = 9728, RC_VT = 10240, RC_GL = 10752;
constexpr int RC_BLK = 6, RC_NCHK = SEQ / 16, RC_NB = (RC_NCHK + RC_BLK - 1) / RC_BLK;
constexpr int RC_W2H = 2 * RC_BLK * RC_SL, RC_A2H = RC_W2H + 13312, RC_CST = RC_A2H + 13312;
static_assert(RC_CST + 2048 <= 163840 - 64, "R2c LDS map");
static_assert((RC_NB + 1) * 12 >= 8 * 128, "SSD2 slices cover all 128 chunks of all 8 items per lane (256-workgroup grid)");
__device__ void phase_rwkv_chunked(const Params& p, LAS unsigned char* lds, int wg, int nwg) {
    const int tid = otid(), lane = tid & 63, wave = __builtin_amdgcn_readfirstlane(tid >> 6), r = lane & 15, q = lane >> 4;
    LAS float* cst = (LAS float*)(lds + RC_CST);
    const bf16_t* R = (const bf16_t*)(p.ws + WS_R); const bf16_t* Kb = (const bf16_t*)(p.ws + WS_K); const bf16_t* V = (const bf16_t*)(p.ws + WS_V);
    const bf16_t* AW = (const bf16_t*)(p.ws + WS_AW); const bf16_t* AA = (const bf16_t*)(p.ws + WS_AA);
    float* BON = (float*)(p.ws + WS_BON); bf16_t* YRAW = (bf16_t*)(p.ws + WS_YRAW);
    for (int unit = wg; unit < 256; unit += nwg) {
        const int xcd = unit & 7, idx = unit >> 3, qw = idx & 3, bh = xcd * 8 + (idx >> 2), b = bh >> 5, h = bh & 31;
        __syncthreads();
        { const int arr = tid >> 6, ch = tid & 63; const float* srcs[8] = {p.in[I_W0], p.in[I_A0], p.in[I_KK], p.in[I_KA], p.in[I_RK], p.in[I_MU] + MU_R, p.in[I_MU] + MU_K, p.in[I_MU] + MU_V};
          float v = 0.f;
#pragma unroll
          for (int a = 0; a < 8; ++a) if (arr == a) v = srcs[a][h * 64 + ch];
          cst[arr * 64 + ch] = v; }
        {   LAS bf16_t* w2h = (LAS bf16_t*)(lds + RC_W2H); LAS bf16_t* a2h = (LAS bf16_t*)(lds + RC_A2H);
            for (int i = tid; i < 96 * 64; i += 512) { const int k = i >> 6, ch = i & 63;
                w2h[ch * 104 + k] = (bf16_t)f2bf(p.in[I_W2][(size_t)k * D_RWKV + h * 64 + ch]); a2h[ch * 104 + k] = (bf16_t)f2bf(p.in[I_A2][(size_t)k * D_RWKV + h * 64 + ch]); } }
        __syncthreads();
        if (wave == 0) {
            __builtin_amdgcn_s_setprio(3);
            f32x4 Sacc[4];
#pragma unroll
            for (int ct = 0; ct < 4; ++ct) Sacc[ct] = (f32x4){0.f, 0.f, 0.f, 0.f};
            const f32x4 zero4 = {0.f, 0.f, 0.f, 0.f};
            unsigned long long pacc = 0;
            for (int blk = 0; blk <= RC_NB; ++blk) {
                unsigned long long tq0 = 0; if (PROBE_PH == 21 && blockIdx.x == 0) tq0 = __builtin_amdgcn_s_memrealtime();
                if (blk >= 1) {
                    for (int j = 0; j < RC_BLK; ++j) {
                        const int ci = (blk - 1) * RC_BLK + j; if (ci >= RC_NCHK) break;
                        LAS const unsigned char* sl = lds + (((blk - 1) & 1) * RC_BLK + j) * RC_SL;
                        const bf16x8 at0 = *(LAS const bf16x8*)(sl + RC_AT + lane * 16), at1 = *(LAS const bf16x8*)(sl + RC_AT + 1024 + lane * 16);
                        const bf16x8 rt0 = *(LAS const bf16x8*)(sl + RC_RT + lane * 16), rt1 = *(LAS const bf16x8*)(sl + RC_RT + 1024 + lane * 16);
                        const bf16x4 mak = *(LAS const bf16x4*)(sl + RC_MAK + lane * 8), mrb = *(LAS const bf16x4*)(sl + RC_MRB + lane * 8), mrk = *(LAS const bf16x4*)(sl + RC_MRK + lane * 8),
                                     ti = *(LAS const bf16x4*)(sl + RC_TI + lane * 8), vt = *(LAS const bf16x4*)(sl + RC_VT + lane * 8);
                        bf16x4 bt[4], kt[4]; f32x4 gl[4];
#pragma unroll
                        for (int ct = 0; ct < 4; ++ct) { bt[ct] = *(LAS const bf16x4*)(sl + RC_BT + (ct * 64 + lane) * 8); kt[ct] = *(LAS const bf16x4*)(sl + RC_KT + (ct * 64 + lane) * 8); gl[ct] = *(LAS const f32x4*)(sl + RC_GL + (16 * ct + 4 * q) * 4); }
                        const bf16x8 sop0 = pk8(Sacc[0], Sacc[1]), sop1 = pk8(Sacc[2], Sacc[3]);
                        f32x4 X = MFMA32(at0, sop0, zero4); X = MFMA32(at1, sop1, X); X = MFMA16(mak, vt, X);
                        const f32x4 U = MFMA16(ti, pk4(X), zero4);
                        const bf16x4 up = pk4(U);
                        f32x4 Y = MFMA32(rt0, sop0, zero4); Y = MFMA32(rt1, sop1, Y); Y = MFMA16(mrb, up, Y); Y = MFMA16(mrk, vt, Y);
#pragma unroll
                        for (int ct = 0; ct < 4; ++ct) { Sacc[ct] = MFMA16(bt[ct], up, Sacc[ct]); Sacc[ct] = MFMA16(kt[ct], vt, Sacc[ct]); Sacc[ct] = Sacc[ct] * gl[ct]; }
                        bf16_t* yo = YRAW + ((size_t)b * SEQ + 16 * ci + 4 * q) * D_RWKV + h * 64 + 16 * qw + r;
                        yo[0] = (bf16_t)f2bf(Y.x); yo[D_RWKV] = (bf16_t)f2bf(Y.y); yo[2 * D_RWKV] = (bf16_t)f2bf(Y.z); yo[3 * D_RWKV] = (bf16_t)f2bf(Y.w);
                    }
                }
                if (PROBE_PH == 21 && blockIdx.x == 0) { asm volatile("s_waitcnt lgkmcnt(0)" ::: "memory"); pacc += __builtin_amdgcn_s_memrealtime() - tq0; }
                LDS_BARRIER();
            }
            __builtin_amdgcn_s_setprio(0);
            if (PROBE_PH == 21 && blockIdx.x == 0 && lane == 0) *(LAS unsigned long long*)(lds + 163840 - 16) = pacc;
        } else if (wave != 4) {
            const int pw = wave < 4 ? wave - 1 : wave - 2;
            const auto rsAW = __builtin_amdgcn_make_buffer_rsrc((void*)AW, 0, (int)(M * 128 * 2), 0x00020000), rsAA = __builtin_amdgcn_make_buffer_rsrc((void*)AA, 0, (int)(M * 128 * 2), 0x00020000);
            const auto rsR = __builtin_amdgcn_make_buffer_rsrc((void*)R, 0, (int)(M * 2048 * 2), 0x00020000), rsK = __builtin_amdgcn_make_buffer_rsrc((void*)Kb, 0, (int)(M * 2048 * 2), 0x00020000), rsV = __builtin_amdgcn_make_buffer_rsrc((void*)V, 0, (int)(M * 2048 * 2), 0x00020000);
            const int voA = (r * 128 + 8 * q) * 2, voR = (r * 2048 + h * 64 + 4 * q) * 2;
            bf16x8 nAW[3], nAA[3]; u32x2 nR[4][2], nK[4][2], nV[2];
#define RC_PREFETCH_A(cc) do { const int soA_ = (b * SEQ + 16 * (cc)) * 256; \
                _Pragma("unroll") for (int ks = 0; ks < 3; ++ks) { nAW[ks] = __builtin_bit_cast(bf16x8, __builtin_amdgcn_raw_buffer_load_b128(rsAW, voA + 64 * ks, soA_, 0)); nAA[ks] = __builtin_bit_cast(bf16x8, __builtin_amdgcn_raw_buffer_load_b128(rsAA, voA + 64 * ks, soA_, 0)); } } while (0)
#define RC_PREFETCH_R(cc) do { const int row0_ = b * SEQ + 16 * (cc); const int soR_ = row0_ * 4096, soP_ = row0_ > 0 ? (row0_ - 1) * 4096 : 0, vaP_ = row0_ > 0 ? 0 : -4096; \
                _Pragma("unroll") for (int nt = 0; nt < 4; ++nt) { \
                    nR[nt][0] = __builtin_bit_cast(u32x2, __builtin_amdgcn_raw_buffer_load_b64(rsR, voR + 32 * nt, soR_, 0)); nK[nt][0] = __builtin_bit_cast(u32x2, __builtin_amdgcn_raw_buffer_load_b64(rsK, voR + 32 * nt, soR_, 0)); \
                    nR[nt][1] = __builtin_bit_cast(u32x2, __builtin_amdgcn_raw_buffer_load_b64(rsR, voR + 32 * nt + vaP_, soP_, 0)); nK[nt][1] = __builtin_bit_cast(u32x2, __builtin_amdgcn_raw_buffer_load_b64(rsK, voR + 32 * nt + vaP_, soP_, 0)); } \
                nV[0] = __builtin_bit_cast(u32x2, __builtin_amdgcn_raw_buffer_load_b64(rsV, voR + 32 * qw, soR_, 0)); nV[1] = __builtin_bit_cast(u32x2, __builtin_amdgcn_raw_buffer_load_b64(rsV, voR + 32 * qw + vaP_, soP_, 0)); } while (0)
            RC_PREFETCH_A(pw); RC_PREFETCH_R(pw);
            LAS const unsigned char* wb = lds + RC_W2H + (r * 104 + 8 * q) * 2;
            LAS const float* cq = cst + 4 * q;
            asm volatile("" : "+v"(wb), "+v"(cq));
            bf16x4 ident; { u32x2 w; w.x = ((4 * q + 0 == r) ? 0x3F80u : 0u) | ((4 * q + 1 == r) ? 0x3F800000u : 0u); w.y = ((4 * q + 2 == r) ? 0x3F80u : 0u) | ((4 * q + 3 == r) ? 0x3F800000u : 0u); ident = __builtin_bit_cast(bf16x4, w); }
            const f32x4 zero4 = {0.f, 0.f, 0.f, 0.f};
            unsigned long long pacc = 0;
            for (int blk = 0; blk <= RC_NB; ++blk) {
                unsigned long long tq0 = 0; if (PROBE_PH == 22 && blockIdx.x == 0 && pw == 0) tq0 = __builtin_amdgcn_s_memrealtime();
                const int ci = blk * RC_BLK + pw;
                if (blk < RC_NB && ci < RC_NCHK) {
                    LAS unsigned char* sl = lds + ((blk & 1) * RC_BLK + pw) * RC_SL;
                    LAS unsigned char* sl16 = sl + lane * 16; LAS unsigned char* sl8 = sl + lane * 8; LAS unsigned char* slg = sl + RC_GL + 16 * q;
                    asm volatile("" : "+v"(sl16), "+v"(sl8), "+v"(slg));
                    const size_t m = (size_t)b * SEQ + 16 * ci + r; const bool first = (16 * ci + r) == 0;
                    f32x4 accw[4], acca[4];
#pragma unroll
                    for (int nt = 0; nt < 4; ++nt) { accw[nt] = zero4; acca[nt] = zero4; }
#pragma unroll
                    for (int ks = 0; ks < 3; ++ks)
#pragma unroll
                        for (int nt = 0; nt < 4; ++nt) { const int bo = (16 * nt * 104 + 32 * ks) * 2;
                            accw[nt] = MFMA32(*(LAS const bf16x8*)(wb + bo), nAW[ks], accw[nt]); acca[nt] = MFMA32(*(LAS const bf16x8*)(wb + 13312 + bo), nAA[ks], acca[nt]); }
                    __builtin_amdgcn_sched_barrier(0);
                    if (ci + RC_BLK < RC_NCHK) RC_PREFETCH_A(ci + RC_BLK);
                    float ss = 0.f, bo = 0.f;
#pragma unroll
                    for (int nt = 0; nt < 4; ++nt) { const f32x4 muk = *(LAS const f32x4*)(cq + 6 * 64 + 16 * nt), kkc = *(LAS const f32x4*)(cq + 2 * 64 + 16 * nt);
                        const f32x4 kc = up4(nK[nt][0]); f32x4 kq = up4(nK[nt][1]); if (first) kq = zero4; const f32x4 kkv = (kc + (kq - kc) * muk) * kkc; ss += sumsq4(kkv); }
                    ss += __shfl_xor(ss, 16); ss += __shfl_xor(ss, 32);
                    const float rn = __builtin_amdgcn_rsqf(fmaxf(ss, 1e-24f));
                    bf16x4 qa[4], qb[4], qk[4], qr[4];
#pragma unroll
                    for (int nt = 0; nt < 4; ++nt) {
                        const f32x4 w0 = *(LAS const f32x4*)(cq + 0 * 64 + 16 * nt), a0 = *(LAS const f32x4*)(cq + 1 * 64 + 16 * nt);
                        f32x4 lw, ag;
#pragma unroll
                        for (int i = 0; i < 4; ++i) { lw[i] = -0.60653066f * __builtin_amdgcn_rcpf(1.f + __expf(-(w0[i] + accw[nt][i]))); ag[i] = __builtin_amdgcn_rcpf(1.f + __expf(-(a0[i] + acca[nt][i]))); }
                        const f32x4 mur = *(LAS const f32x4*)(cq + 5 * 64 + 16 * nt), muk = *(LAS const f32x4*)(cq + 6 * 64 + 16 * nt), kkc = *(LAS const f32x4*)(cq + 2 * 64 + 16 * nt), kac = *(LAS const f32x4*)(cq + 3 * 64 + 16 * nt), rkc = *(LAS const f32x4*)(cq + 4 * 64 + 16 * nt);
                        const f32x4 rc = up4(nR[nt][0]), kc = up4(nK[nt][0]); f32x4 rp = up4(nR[nt][1]), kq = up4(nK[nt][1]); if (first) { rp = zero4; kq = zero4; }
                        const f32x4 r4 = rc + (rp - rc) * mur, k4 = kc + (kq - kc) * muk;
                        const f32x4 kn = k4 * kkc * rn, kp = k4 * (1.f + (ag - 1.f) * kac);
                        const f32x4 b4_ = r4 * kp * rkc; bo += (b4_.x + b4_.y) + (b4_.z + b4_.w);
                        f32x4 G = lw;
#pragma unroll
                        for (int i = 0; i < 4; ++i) { float g = G[i]; g += dpp_f<0x111>(g); g += dpp_f<0x112>(g); g += dpp_f<0x114>(g); g += dpp_f<0x118>(g); G[i] = g; }
                        f32x4 eG, eGx, eI;
#pragma unroll
                        for (int i = 0; i < 4; ++i) { eG[i] = __expf(G[i]); eGx[i] = __builtin_bit_cast(float, __builtin_amdgcn_update_dpp(0x3F800000, __builtin_bit_cast(int, eG[i]), 0x111, 0xf, 0xf, false)); eI[i] = __builtin_amdgcn_rcpf(eG[i]); }
                        qa[nt] = pk4((zero4 - kn) * eGx); qb[nt] = pk4(kn * ag * eI); qk[nt] = pk4(kp * eI); qr[nt] = pk4(r4 * eG);
                        if (r == 15) *(LAS f32x4*)(slg + 64 * nt) = eG;
                        const f32x4 d1 = MFMA16(qb[nt], ident, zero4), d2 = MFMA16(qk[nt], ident, zero4);
                        *(LAS bf16x4*)(sl8 + RC_BT + nt * 512) = pk4(d1); *(LAS bf16x4*)(sl8 + RC_KT + nt * 512) = pk4(d2);
                    }
                    bo += __shfl_xor(bo, 16); bo += __shfl_xor(bo, 32);
                    if (qw == 0 && q == 0) { BON[(m * 32 + h) * 2] = bo; BON[(m * 32 + h) * 2 + 1] = 0.f; }
                    f32x4 v4; { const f32x4 muv = *(LAS const f32x4*)(cq + 7 * 64 + 16 * qw); const f32x4 vc = up4(nV[0]); f32x4 vp = up4(nV[1]); if (first) vp = zero4; v4 = vc + (vp - vc) * muv; }
                    __builtin_amdgcn_sched_barrier(0);
                    if (ci + RC_BLK < RC_NCHK) RC_PREFETCH_R(ci + RC_BLK);
                    __builtin_amdgcn_sched_barrier(0);
                    { const f32x4 d3 = MFMA16(pk4(v4), ident, zero4); *(LAS bf16x4*)(sl8 + RC_VT) = pk4(d3); }
#define CAT8(lo, hi) __builtin_shufflevector(lo, hi, 0, 1, 2, 3, 4, 5, 6, 7)
                    const bf16x8 pa0 = CAT8(qa[0], qa[1]), pa1 = CAT8(qa[2], qa[3]), pr0 = CAT8(qr[0], qr[1]), pr1 = CAT8(qr[2], qr[3]), pb0 = CAT8(qb[0], qb[1]), pb1 = CAT8(qb[2], qb[3]), pk0 = CAT8(qk[0], qk[1]), pk1 = CAT8(qk[2], qk[3]);
#undef CAT8
                    *(LAS bf16x8*)(sl16 + RC_AT) = pa0; *(LAS bf16x8*)(sl16 + RC_AT + 1024) = pa1; *(LAS bf16x8*)(sl16 + RC_RT) = pr0; *(LAS bf16x8*)(sl16 + RC_RT + 1024) = pr1;
                    __builtin_amdgcn_sched_barrier(0);
                    f32x4 mab = MFMA32(pb0, pa0, zero4); mab = MFMA32(pb1, pa1, mab);
                    f32x4 mak = MFMA32(pk0, pa0, zero4); mak = MFMA32(pk1, pa1, mak);
                    f32x4 mrb = MFMA32(pb0, pr0, zero4); mrb = MFMA32(pb1, pr1, mrb);
                    f32x4 mrk = MFMA32(pk0, pr0, zero4); mrk = MFMA32(pk1, pr1, mrk);
#pragma unroll
                    for (int t = 0; t < 4; ++t) { const int j = 4 * q + t; if (!(j < r)) { mab[t] = 0.f; mak[t] = 0.f; } if (!(j <= r)) { mrb[t] = 0.f; mrk[t] = 0.f; } }
                    *(LAS bf16x4*)(sl8 + RC_MAK) = pk4(mak); *(LAS bf16x4*)(sl8 + RC_MRB) = pk4(mrb); *(LAS bf16x4*)(sl8 + RC_MRK) = pk4(mrk);
                    __builtin_amdgcn_sched_barrier(0);
                    {
                        const bf16x4 nA = pk4(mab);
                        const bf16x4 nB = pk4(MFMA16(nA, ident, zero4));
                        f32x4 s;
#pragma unroll
                        for (int t = 0; t < 4; ++t) s[t] = mab[t] + ((4 * q + t == r) ? 1.f : 0.f);
                        const bf16x4 z2a = pk4(MFMA16(nA, nB, zero4)), z2b = pk4(MFMA16(nB, nA, zero4));
                        s = MFMA16(z2a, pk4(s), s);
                        const bf16x4 z4a = pk4(MFMA16(z2b, z2a, zero4)), z4b = pk4(MFMA16(z2a, z2b, zero4));
                        s = MFMA16(z4a, pk4(s), s);
                        const bf16x4 z8a = pk4(MFMA16(z4b, z4a, zero4));
                        s = MFMA16(z8a, pk4(s), s);
                        *(LAS bf16x4*)(sl8 + RC_TI) = pk4(s);
                    }
                }
                if (PROBE_PH == 22 && blockIdx.x == 0 && pw == 0) { asm volatile("s_waitcnt lgkmcnt(0)" ::: "memory"); pacc += __builtin_amdgcn_s_memrealtime() - tq0; }
                LDS_BARRIER();
            }
            if (PROBE_PH == 22 && blockIdx.x == 0 && pw == 0 && lane == 0) *(LAS unsigned long long*)(lds + 163840 - 16) = pacc;
#undef RC_PREFETCH_A
#undef RC_PREFETCH_R
        } else {
            bf16_t* SS = (bf16_t*)p.out; const float* CD = (const float*)(p.ws + WS_CTL + WS_CD);
            const int nitem = (BATCH * 32 * 64 * 32 + nwg * 64 - 1) / (nwg * 64), nstep = nitem * 128;
            constexpr int PER = 12;
            int s = (unit == wg) ? 0 : nstep; f32x4 hh = {0.f, 0.f, 0.f, 0.f};
            for (int blk = 0; blk <= RC_NB; ++blk) {
                u32x2 raw[PER]; float dd[PER]; bf16_t* qq[PER]; bool ok[PER];
#pragma unroll
                for (int k = 0; k < PER; ++k) { const int ss = s + k, item = ss >> 7, cc = ss & 127, idx = item * (nwg * 64) + wg * 64 + lane; ok[k] = ss < nstep && idx < BATCH * 32 * 64 * 32;
                    const int n4 = idx & 31, pp = (idx >> 5) & 63, eg = (idx >> 11) & 31, bb = idx >> 16;
                    qq[k] = SS + ((((size_t)bb * 128 + cc) * 32 + eg) * 64 + pp) * 128 + 4 * n4; raw[k] = (u32x2){0u, 0u}; dd[k] = 0.f;
                    if (ok[k]) { raw[k] = *(const u32x2*)qq[k]; dd[k] = CD[(bb * 128 + cc) * 32 + eg]; } }
#pragma unroll
                for (int k = 0; k < PER; ++k) { if (((s + k) & 127) == 0) hh = (f32x4){0.f, 0.f, 0.f, 0.f};
                    if (ok[k]) { u32x2 w; w.x = pg8::cvt_pk_bf16(hh.x, hh.y); w.y = pg8::cvt_pk_bf16(hh.z, hh.w); *(u32x2*)qq[k] = w; hh = hh * dd[k] + up4(raw[k]); } }
                s += PER;
                LDS_BARRIER();
            }
            for (; s < nstep; ++s) {
                const int item = s >> 7, cc = s & 127, idx = item * (nwg * 64) + wg * 64 + lane; if ((s & 127) == 0) hh = (f32x4){0.f, 0.f, 0.f, 0.f};
                if (idx < BATCH * 32 * 64 * 32) { const int n4 = idx & 31, pp = (idx >> 5) & 63, eg = (idx >> 11) & 31, bb = idx >> 16;
                    bf16_t* q1 = SS + ((((size_t)bb * 128 + cc) * 32 + eg) * 64 + pp) * 128 + 4 * n4; const f32x4 sv = ld4bf(q1); const float d1 = CD[(bb * 128 + cc) * 32 + eg];
                    u32x2 w; w.x = pg8::cvt_pk_bf16(hh.x, hh.y); w.y = pg8::cvt_pk_bf16(hh.z, hh.w); *(u32x2*)q1 = w; hh = hh * d1 + sv; } }
        }
    }
}

constexpr int RD_NG = 56;
constexpr int RD_NL = 12;
constexpr int RD_SLOTG = 10496;
constexpr int RD_BK = 4096, RD_MM = 8192;
constexpr size_t WS_RING = 9 * MiB;
constexpr size_t CTL_READY = 256 * 1024, CTL_DONE = 512 * 1024, CTL_ERR = 192 * 1024;
static_assert(WS_RING + (size_t)64 * RD_NG * RD_SLOTG <= 47 * MiB, "ring fits the dead WIN' region");
constexpr int RD_FLAGS = RC_CST + 2048;
static_assert(RD_FLAGS + 64 <= 163840, "R2d LDS map");
#define RD_SPIN_MAX (1u << 19)
__device__ void phase_rwkv_dist(const Params& p, LAS unsigned char* lds, int wg, int nwg) {
    const int tid = otid(), lane = tid & 63, wave = __builtin_amdgcn_readfirstlane(tid >> 6), r = lane & 15, q = lane >> 4;
    LAS float* cst = (LAS float*)(lds + RC_CST);
    volatile LAS unsigned* lflag = (volatile LAS unsigned*)(lds + RD_FLAGS);
    float* BON = (float*)(p.ws + WS_BON); bf16_t* YRAW = (bf16_t*)(p.ws + WS_YRAW);
    unsigned* READY = (unsigned*)(p.ws + WS_CTL + CTL_READY); unsigned* DONE = (unsigned*)(p.ws + WS_CTL + CTL_DONE); unsigned* ERR = (unsigned*)(p.ws + WS_CTL + CTL_ERR);
    const auto rsWS = __builtin_amdgcn_make_buffer_rsrc((void*)p.ws, 0, (int)WS_END, 0x00020000);
    for (int unit = wg; unit < 256; unit += nwg) {
        const int xcd = unit & 7, idx = unit >> 3, qw = idx & 3, bh = xcd * 8 + (idx >> 2), b = bh >> 5, h = bh & 31;
        __syncthreads();
        { const int arr = tid >> 6, ch = tid & 63; const float* srcs[8] = {p.in[I_W0], p.in[I_A0], p.in[I_KK], p.in[I_KA], p.in[I_RK], p.in[I_MU] + MU_R, p.in[I_MU] + MU_K, p.in[I_MU] + MU_V};
          float v = 0.f;
#pragma unroll
          for (int a = 0; a < 8; ++a) if (arr == a) v = srcs[a][h * 64 + ch];
          cst[arr * 64 + ch] = v; }
        {   LAS bf16_t* w2h = (LAS bf16_t*)(lds + RC_W2H); LAS bf16_t* a2h = (LAS bf16_t*)(lds + RC_A2H);
            for (int i = tid; i < 96 * 64; i += 512) { const int k = i >> 6, ch = i & 63;
                w2h[ch * 104 + k] = (bf16_t)f2bf(p.in[I_W2][(size_t)k * D_RWKV + h * 64 + ch]); a2h[ch * 104 + k] = (bf16_t)f2bf(p.in[I_A2][(size_t)k * D_RWKV + h * 64 + ch]); } }
        if (tid < 13) lflag[tid] = 0u;
        __syncthreads();
        const f32x4 zero4 = {0.f, 0.f, 0.f, 0.f};
        bf16x4 ident; { u32x2 w; w.x = ((4 * q + 0 == r) ? 0x3F80u : 0u) | ((4 * q + 1 == r) ? 0x3F800000u : 0u); w.y = ((4 * q + 2 == r) ? 0x3F80u : 0u) | ((4 * q + 3 == r) ? 0x3F800000u : 0u); ident = __builtin_bit_cast(bf16x4, w); }
        const int ringbase = (int)WS_RING + bh * (RD_NG * RD_SLOTG);
        bool dead = false;
        if (wave == 0) {
            __builtin_amdgcn_s_setprio(3);
            f32x4 Sacc[4];
#pragma unroll
            for (int ct = 0; ct < 4; ++ct) Sacc[ct] = zero4;
            for (int ci = 0; ci < RC_NCHK; ++ci) {
                { unsigned sp = 0; while (!dead && lflag[ci % RD_NL] != (unsigned)(ci + 1)) { __builtin_amdgcn_s_sleep(1); if (++sp > RD_SPIN_MAX) { if (lane == 0) atomicAdd(ERR, 1u); dead = true; } } }
                asm volatile("" ::: "memory");
                LAS const unsigned char* sl = lds + (ci % RD_NL) * RC_SL;
                const bf16x8 at0 = *(LAS const bf16x8*)(sl + RC_AT + lane * 16), at1 = *(LAS const bf16x8*)(sl + RC_AT + 1024 + lane * 16);
                const bf16x8 rt0 = *(LAS const bf16x8*)(sl + RC_RT + lane * 16), rt1 = *(LAS const bf16x8*)(sl + RC_RT + 1024 + lane * 16);
                const bf16x8 mm0 = *(LAS const bf16x8*)(sl + RD_MM + lane * 32), mm1 = *(LAS const bf16x8*)(sl + RD_MM + lane * 32 + 16);
                const bf16x4 vt = *(LAS const bf16x4*)(sl + RC_VT + lane * 8);
                bf16x8 bk[4]; f32x4 gl[4];
#pragma unroll
                for (int ct = 0; ct < 4; ++ct) { bk[ct] = *(LAS const bf16x8*)(sl + RD_BK + (ct * 64 + lane) * 16); gl[ct] = *(LAS const f32x4*)(sl + RC_GL + (16 * ct + 4 * q) * 4); }
                asm volatile("s_waitcnt lgkmcnt(0)" ::: "memory");
                lflag[12] = (unsigned)(ci + 1);
                const bf16x4 mak = __builtin_shufflevector(mm0, mm0, 0, 1, 2, 3), mrb = __builtin_shufflevector(mm0, mm0, 4, 5, 6, 7), mrk = __builtin_shufflevector(mm1, mm1, 0, 1, 2, 3), ti = __builtin_shufflevector(mm1, mm1, 4, 5, 6, 7);
                const bf16x8 sop0 = pk8(Sacc[0], Sacc[1]), sop1 = pk8(Sacc[2], Sacc[3]);
                f32x4 X = MFMA32(at0, sop0, zero4); X = MFMA32(at1, sop1, X); X = MFMA16(mak, vt, X);
                const f32x4 U = MFMA16(ti, pk4(X), zero4);
                const bf16x4 up = pk4(U);
                f32x4 Y = MFMA32(rt0, sop0, zero4); Y = MFMA32(rt1, sop1, Y); Y = MFMA16(mrb, up, Y); Y = MFMA16(mrk, vt, Y);
#pragma unroll
                for (int ct = 0; ct < 4; ++ct) { const bf16x4 btc = __builtin_shufflevector(bk[ct], bk[ct], 0, 1, 2, 3), ktc = __builtin_shufflevector(bk[ct], bk[ct], 4, 5, 6, 7);
                    Sacc[ct] = MFMA16(btc, up, Sacc[ct]); Sacc[ct] = MFMA16(ktc, vt, Sacc[ct]); Sacc[ct] = Sacc[ct] * gl[ct]; }
                const f32x4 Yt = MFMA16(pk4(Y), ident, zero4);
                *(u32x2*)(YRAW + ((size_t)bh * SEQ + 16 * ci + r) * 64 + 16 * qw + 4 * q) = __builtin_bit_cast(u32x2, pk4(Yt));
            }
            __builtin_amdgcn_s_setprio(0);
        } else if (wave >= 4) {
            const int fw = wave - 4;
            __builtin_amdgcn_s_setprio(2);
            const int voV = (r * 64 + 16 * qw + 4 * q) * 2;
            const f32x4 muv = *(LAS const f32x4*)(cst + 7 * 64 + 16 * qw + 4 * q);
            u32x4 fa[2][10]; u32x4 fg[2]; u32x2 fv[2][2];
#define RD_PEEK(cc) __hip_atomic_load(READY + bh * 512 + (cc), __ATOMIC_RELAXED, __HIP_MEMORY_SCOPE_AGENT)
#define RD_ISSUE(cc, s_, pre_) do { const int c_ = (cc); unsigned sp_ = 0; \
                    if (__builtin_amdgcn_readfirstlane(pre_) == 0u) while (!dead && __hip_atomic_load(READY + bh * 512 + c_, __ATOMIC_RELAXED, __HIP_MEMORY_SCOPE_AGENT) == 0u) { __builtin_amdgcn_s_sleep(2); if (++sp_ > RD_SPIN_MAX) { if (lane == 0) atomicAdd(ERR, 1u); dead = true; } } \
                    const int so_ = ringbase + (c_ % RD_NG) * RD_SLOTG; \
                    _Pragma("unroll") for (int j_ = 0; j_ < 10; ++j_) fa[s_][j_] = __builtin_bit_cast(u32x4, __builtin_amdgcn_raw_buffer_load_b128(rsWS, lane * 16 + 1024 * (j_ & 3), so_ + 4096 * (j_ >> 2), 16));     \
                    fg[s_] = __builtin_bit_cast(u32x4, __builtin_amdgcn_raw_buffer_load_b128(rsWS, (lane & 15) * 16, so_ + 10240, 16)); \
                    { const int soR_ = (bh * SEQ + 16 * c_) * 128, soP_ = soR_ > 0 ? soR_ - 128 : 0, vaP_ = soR_ > 0 ? 0 : -128; \
                      fv[s_][0] = __builtin_bit_cast(u32x2, __builtin_amdgcn_raw_buffer_load_b64(rsWS, voV, (int)WS_V + soR_, 0)); fv[s_][1] = __builtin_bit_cast(u32x2, __builtin_amdgcn_raw_buffer_load_b64(rsWS, voV + vaP_, (int)WS_V + soP_, 0)); } } while (0)
#define RD_STAGE(cc, s_) do { const int c_ = (cc); { unsigned sp_ = 0; while (!dead && (int)lflag[12] < c_ - RD_NL + 1) { __builtin_amdgcn_s_sleep(1); if (++sp_ > RD_SPIN_MAX) { if (lane == 0) atomicAdd(ERR, 1u); dead = true; } } } \
                    LAS unsigned char* sl_ = lds + (c_ % RD_NL) * RC_SL; \
                    f32x4 vc_ = up4(fv[s_][0]), vp_ = up4(fv[s_][1]); if (16 * c_ + r == 0) vp_ = zero4; const f32x4 v4_ = vc_ + (vp_ - vc_) * muv; \
                    const f32x4 d3_ = MFMA16(pk4(v4_), ident, zero4); \
                    _Pragma("unroll") for (int j_ = 0; j_ < 10; ++j_) *(LAS u32x4*)(sl_ + lane * 16 + 1024 * j_) = fa[s_][j_]; \
                    *(LAS u32x4*)(sl_ + RC_GL + (lane & 15) * 16) = fg[s_]; \
                    *(LAS bf16x4*)(sl_ + RC_VT + lane * 8) = pk4(d3_); \
                    asm volatile("s_waitcnt lgkmcnt(0)" ::: "memory"); \
                    lflag[c_ % RD_NL] = (unsigned)(c_ + 1); __hip_atomic_fetch_add(DONE + bh * 512 + c_, 1u, __ATOMIC_RELAXED, __HIP_MEMORY_SCOPE_AGENT); } while (0)
            bf16_t* SS = (bf16_t*)p.out; const float* CD = (const float*)(p.ws + WS_CTL + WS_CD);
            const int nitem = (BATCH * 32 * 64 * 32 + nwg * 64 - 1) / (nwg * 64), nstep = ((nitem + 3) / 4) * 128;
            const int per = (nitem + 3) / 4;
            int s2 = (unit == wg) ? 0 : nstep; f32x4 hh = zero4;
            RD_ISSUE(fw, 0, 0u);
            for (int c2 = fw; c2 < RC_NCHK; c2 += 8) {
                const unsigned pr1 = RD_PEEK(c2 + 4), pr0 = (c2 + 8 < RC_NCHK) ? RD_PEEK(c2 + 8) : 0u;
                u32x2 raw[4]; float dd[4]; bf16_t* qq[4]; bool ok[4];
#pragma unroll
                for (int k = 0; k < 4; ++k) { const int ss = s2 + k, item = fw * per + (ss >> 7), cc = ss & 127, idx = item * (nwg * 64) + wg * 64 + lane; ok[k] = ss < nstep && (ss >> 7) < per && item < nitem && idx < BATCH * 32 * 64 * 32;
                    const int n4 = idx & 31, pp = (idx >> 5) & 63, eg = (idx >> 11) & 31, bb = idx >> 16;
                    qq[k] = SS + ((((size_t)bb * 128 + cc) * 32 + eg) * 64 + pp) * 128 + 4 * n4; raw[k] = (u32x2){0u, 0u}; dd[k] = 0.f;
                    if (ok[k]) { raw[k] = *(const u32x2*)qq[k]; dd[k] = CD[(bb * 128 + cc) * 32 + eg]; } }
                RD_ISSUE(c2 + 4, 1, pr1);
                RD_STAGE(c2, 0);
                if (c2 + 8 < RC_NCHK) RD_ISSUE(c2 + 8, 0, pr0);
                RD_STAGE(c2 + 4, 1);
#pragma unroll
                for (int k = 0; k < 4; ++k) { if (((s2 + k) & 127) == 0) hh = zero4;
                    if (ok[k]) { u32x2 w; w.x = pg8::cvt_pk_bf16(hh.x, hh.y); w.y = pg8::cvt_pk_bf16(hh.z, hh.w); *(u32x2*)qq[k] = w; hh = hh * dd[k] + up4(raw[k]); } }
                s2 += 4;
            }
            for (; s2 < nstep; ++s2) {
                const int item = fw * per + (s2 >> 7), cc = s2 & 127, idx = item * (nwg * 64) + wg * 64 + lane; if ((s2 & 127) == 0) hh = zero4;
                if (item < nitem && idx < BATCH * 32 * 64 * 32) { const int n4 = idx & 31, pp = (idx >> 5) & 63, eg = (idx >> 11) & 31, bb = idx >> 16;
                    bf16_t* q1 = SS + ((((size_t)bb * 128 + cc) * 32 + eg) * 64 + pp) * 128 + 4 * n4; const f32x4 sv = ld4bf(q1); const float d1 = CD[(bb * 128 + cc) * 32 + eg];
                    u32x2 w; w.x = pg8::cvt_pk_bf16(hh.x, hh.y); w.y = pg8::cvt_pk_bf16(hh.z, hh.w); *(u32x2*)q1 = w; hh = hh * d1 + sv; } }
#undef RD_ISSUE
#undef RD_PEEK
#undef RD_STAGE
            __builtin_amdgcn_s_setprio(0);
        } else {
            const int pw = wave - 1;
            const bf16_t* dummy = nullptr; (void)dummy;
            const int voA = (r * 128 + 8 * q) * 2, voR = (r * 64 + 4 * q) * 2;
            bf16x8 nAW[3], nAA[3]; u32x2 nX[8][2];
#define RD_PREFETCH_A(cc) do { const int soA_ = (b * SEQ + 16 * (cc)) * 256; \
                _Pragma("unroll") for (int ks = 0; ks < 3; ++ks) { nAW[ks] = __builtin_bit_cast(bf16x8, __builtin_amdgcn_raw_buffer_load_b128(rsWS, voA + 64 * ks, (int)WS_AW + soA_, 0)); nAA[ks] = __builtin_bit_cast(bf16x8, __builtin_amdgcn_raw_buffer_load_b128(rsWS, voA + 64 * ks, (int)WS_AA + soA_, 0)); } } while (0)
#define RD_PREFETCH_R(cc) do { const int soR_ = (bh * SEQ + 16 * (cc)) * 128, soP_ = soR_ > 0 ? soR_ - 128 : 0, vaP_ = soR_ > 0 ? 0 : -128; \
                _Pragma("unroll") for (int xi = 0; xi < 8; ++xi) { const int base_ = xi < 4 ? (int)WS_R : (int)WS_K, vo_ = voR + 32 * (xi & 3); \
                    nX[xi][0] = __builtin_bit_cast(u32x2, __builtin_amdgcn_raw_buffer_load_b64(rsWS, vo_, base_ + soR_, 0)); nX[xi][1] = __builtin_bit_cast(u32x2, __builtin_amdgcn_raw_buffer_load_b64(rsWS, vo_ + vaP_, base_ + soP_, 0)); } } while (0)
            LAS const unsigned char* wb = lds + RC_W2H + (r * 104 + 8 * q) * 2;
            LAS const float* cq = cst + 4 * q;
            asm volatile("" : "+v"(wb), "+v"(cq));
            { const int c0 = 6 * qw + pw; if (c0 < RC_NCHK) { RD_PREFETCH_A(c0); } }
            int pend = -1;
            for (int cj = 0; cj < 2 * ((RC_NCHK + 23) / 24); ++cj) {
                const int ci = 24 * (cj >> 1) + 6 * qw + pw + 3 * (cj & 1); if (ci >= RC_NCHK) continue;
                const int cn = 24 * ((cj + 1) >> 1) + 6 * qw + pw + 3 * ((cj + 1) & 1);
                RD_PREFETCH_R(ci);
                const size_t m = (size_t)b * SEQ + 16 * ci + r; const bool first = (16 * ci + r) == 0;
                f32x4 accw[4], acca[4];
#pragma unroll
                for (int nt = 0; nt < 4; ++nt) { accw[nt] = zero4; acca[nt] = zero4; }
#pragma unroll
                for (int ks = 0; ks < 3; ++ks)
#pragma unroll
                    for (int nt = 0; nt < 4; ++nt) { const int bo = (16 * nt * 104 + 32 * ks) * 2;
                        accw[nt] = MFMA32(*(LAS const bf16x8*)(wb + bo), nAW[ks], accw[nt]); acca[nt] = MFMA32(*(LAS const bf16x8*)(wb + 13312 + bo), nAA[ks], acca[nt]); }
                __builtin_amdgcn_sched_barrier(0);
                if (pend >= 0) { asm volatile("s_waitcnt vmcnt(0)" ::: "memory"); __hip_atomic_store(READY + bh * 512 + pend, 1u, __ATOMIC_RELAXED, __HIP_MEMORY_SCOPE_AGENT); }
                __builtin_amdgcn_sched_barrier(0);
                if (cn < RC_NCHK) RD_PREFETCH_A(cn);
                float ss = 0.f, bo = 0.f;
#pragma unroll
                for (int nt = 0; nt < 4; ++nt) { const f32x4 muk = *(LAS const f32x4*)(cq + 6 * 64 + 16 * nt), kkc = *(LAS const f32x4*)(cq + 2 * 64 + 16 * nt);
                    const f32x4 kc = up4(nX[4 + nt][0]); f32x4 kq = up4(nX[4 + nt][1]); if (first) kq = zero4; const f32x4 kkv = (kc + (kq - kc) * muk) * kkc; ss += sumsq4(kkv); }
                ss += __shfl_xor(ss, 16); ss += __shfl_xor(ss, 32);
                const float rn = __builtin_amdgcn_rsqf(fmaxf(ss, 1e-24f));
                if (ci >= RD_NG) { unsigned sp = 0; while (!dead && __hip_atomic_load(DONE + bh * 512 + (ci - RD_NG), __ATOMIC_RELAXED, __HIP_MEMORY_SCOPE_AGENT) < 256u) { __builtin_amdgcn_s_sleep(2); if (++sp > RD_SPIN_MAX) { if (lane == 0) atomicAdd(ERR, 1u); dead = true; } } }
                const int so = ringbase + (ci % RD_NG) * RD_SLOTG;
                bf16x4 qa[4], qb[4], qk[4], qr[4];
#pragma unroll
                for (int nt = 0; nt < 4; ++nt) {
                    const f32x4 w0 = *(LAS const f32x4*)(cq + 0 * 64 + 16 * nt), a0 = *(LAS const f32x4*)(cq + 1 * 64 + 16 * nt);
                    f32x4 lw, ag;
#pragma unroll
                    for (int i = 0; i < 4; ++i) { lw[i] = -0.60653066f * __builtin_amdgcn_rcpf(1.f + __expf(-(w0[i] + accw[nt][i]))); ag[i] = __builtin_amdgcn_rcpf(1.f + __expf(-(a0[i] + acca[nt][i]))); }
                    const f32x4 mur = *(LAS const f32x4*)(cq + 5 * 64 + 16 * nt), muk = *(LAS const f32x4*)(cq + 6 * 64 + 16 * nt), kkc = *(LAS const f32x4*)(cq + 2 * 64 + 16 * nt), kac = *(LAS const f32x4*)(cq + 3 * 64 + 16 * nt), rkc = *(LAS const f32x4*)(cq + 4 * 64 + 16 * nt);
                    const f32x4 rc = up4(nX[nt][0]), kc = up4(nX[4 + nt][0]); f32x4 rp = up4(nX[nt][1]), kq = up4(nX[4 + nt][1]); if (first) { rp = zero4; kq = zero4; }
                    const f32x4 r4 = rc + (rp - rc) * mur, k4 = kc + (kq - kc) * muk;
                    const f32x4 kn = k4 * kkc * rn, kp = k4 * (1.f + (ag - 1.f) * kac);
                    const f32x4 b4_ = r4 * kp * rkc; bo += (b4_.x + b4_.y) + (b4_.z + b4_.w);
                    f32x4 G = lw;
#pragma unroll
                    for (int i = 0; i < 4; ++i) { float g = G[i]; g += dpp_f<0x111>(g); g += dpp_f<0x112>(g); g += dpp_f<0x114>(g); g += dpp_f<0x118>(g); G[i] = g; }
                    f32x4 eG, eGx, eI;
#pragma unroll
                    for (int i = 0; i < 4; ++i) { eG[i] = __expf(G[i]); eGx[i] = __builtin_bit_cast(float, __builtin_amdgcn_update_dpp(0x3F800000, __builtin_bit_cast(int, eG[i]), 0x111, 0xf, 0xf, false)); eI[i] = __builtin_amdgcn_rcpf(eG[i]); }
                    qa[nt] = pk4((zero4 - kn) * eGx); qb[nt] = pk4(kn * ag * eI); qk[nt] = pk4(kp * eI); qr[nt] = pk4(r4 * eG);
                    if (r == 15) __builtin_amdgcn_raw_buffer_store_b128(__builtin_bit_cast(u32x4, eG), rsWS, (16 * nt + 4 * q) * 4, so + 10240, 16);
                    const f32x4 d1 = MFMA16(qb[nt], ident, zero4), d2 = MFMA16(qk[nt], ident, zero4);
                    { const bf16x4 e1 = pk4(d1), e2 = pk4(d2); __builtin_amdgcn_raw_buffer_store_b128(__builtin_bit_cast(u32x4, __builtin_shufflevector(e1, e2, 0, 1, 2, 3, 4, 5, 6, 7)), rsWS, lane * 16 + 1024 * nt, so + RD_BK, 16); }
                }
                bo += __shfl_xor(bo, 16); bo += __shfl_xor(bo, 32);
                if (q == 0) { BON[(m * 32 + h) * 2] = bo; BON[(m * 32 + h) * 2 + 1] = 0.f; }
#define CAT8(lo, hi) __builtin_shufflevector(lo, hi, 0, 1, 2, 3, 4, 5, 6, 7)
                const bf16x8 pa0 = CAT8(qa[0], qa[1]), pa1 = CAT8(qa[2], qa[3]), pr0 = CAT8(qr[0], qr[1]), pr1 = CAT8(qr[2], qr[3]), pb0 = CAT8(qb[0], qb[1]), pb1 = CAT8(qb[2], qb[3]), pk0 = CAT8(qk[0], qk[1]), pk1 = CAT8(qk[2], qk[3]);
#undef CAT8
                __builtin_amdgcn_raw_buffer_store_b128(__builtin_bit_cast(u32x4, pa0), rsWS, lane * 16, so + RC_AT, 16); __builtin_amdgcn_raw_buffer_store_b128(__builtin_bit_cast(u32x4, pa1), rsWS, lane * 16 + 1024, so + RC_AT, 16);
                __builtin_amdgcn_raw_buffer_store_b128(__builtin_bit_cast(u32x4, pr0), rsWS, lane * 16, so + RC_RT, 16); __builtin_amdgcn_raw_buffer_store_b128(__builtin_bit_cast(u32x4, pr1), rsWS, lane * 16 + 1024, so + RC_RT, 16);
                __builtin_amdgcn_sched_barrier(0);
                f32x4 mab = MFMA32(pb0, pa0, zero4); mab = MFMA32(pb1, pa1, mab);
                f32x4 mak = MFMA32(pk0, pa0, zero4); mak = MFMA32(pk1, pa1, mak);
                f32x4 mrb = MFMA32(pb0, pr0, zero4); mrb = MFMA32(pb1, pr1, mrb);
                f32x4 mrk = MFMA32(pk0, pr0, zero4); mrk = MFMA32(pk1, pr1, mrk);
#pragma unroll
                for (int t = 0; t < 4; ++t) { const int j = 4 * q + t; if (!(j < r)) { mab[t] = 0.f; mak[t] = 0.f; } if (!(j <= r)) { mrb[t] = 0.f; mrk[t] = 0.f; } }
                { const bf16x4 e1 = pk4(mak), e2 = pk4(mrb); __builtin_amdgcn_raw_buffer_store_b128(__builtin_bit_cast(u32x4, __builtin_shufflevector(e1, e2, 0, 1, 2, 3, 4, 5, 6, 7)), rsWS, lane * 32, so + RD_MM, 16); }
                const bf16x4 mrkp = pk4(mrk);
                __builtin_amdgcn_sched_barrier(0);
                {   const bf16x4 nA = pk4(mab);
                    const bf16x4 nB = pk4(MFMA16(nA, ident, zero4));
                    f32x4 s;
#pragma unroll
                    for (int t = 0; t < 4; ++t) s[t] = mab[t] + ((4 * q + t == r) ? 1.f : 0.f);
                    const bf16x4 z2a = pk4(MFMA16(nA, nB, zero4)), z2b = pk4(MFMA16(nB, nA, zero4));
                    s = MFMA16(z2a, pk4(s), s);
                    const bf16x4 z4a = pk4(MFMA16(z2b, z2a, zero4)), z4b = pk4(MFMA16(z2a, z2b, zero4));
                    s = MFMA16(z4a, pk4(s), s);
                    const bf16x4 z8a = pk4(MFMA16(z4b, z4a, zero4));
                    s = MFMA16(z8a, pk4(s), s);
                    { const bf16x4 e2 = pk4(s); __builtin_amdgcn_raw_buffer_store_b128(__builtin_bit_cast(u32x4, __builtin_shufflevector(mrkp, e2, 0, 1, 2, 3, 4, 5, 6, 7)), rsWS, lane * 32 + 16, so + RD_MM, 16); }
                }
                pend = ci;
            }
            if (pend >= 0) { asm volatile("s_waitcnt vmcnt(0)" ::: "memory"); __hip_atomic_store(READY + bh * 512 + pend, 1u, __ATOMIC_RELAXED, __HIP_MEMORY_SCOPE_AGENT); }
#undef RD_PREFETCH_A
#undef RD_PREFETCH_R
        }
    }
}

__device__ void phase_rwkv_post(const Params& p, bf16_t* ymix, LAS unsigned char* lds, int wg, int nwg) {
    const int tid = otid(), lane = tid & 63, wave = tid >> 6, fr = lane & 15, fq = lane >> 4;
    const bf16_t* AG = (const bf16_t*)(p.ws + WS_AG); const bf16_t* G2 = (const bf16_t*)(p.ws + WS_G2); const bf16_t* YRAW = (const bf16_t*)(p.ws + WS_YRAW); const bf16_t* V = (const bf16_t*)(p.ws + WS_V);
    const float* BON = (const float*)(p.ws + WS_BON); const float* mu = p.in[I_MU];
    for (int item = wg; item < 8 * 32; item += nwg) {
        const int hg = item >> 5, rng = item & 31;
        __syncthreads();
        for (int i = tid; i < 4 * 64 * 32; i += 512) { const int ch = i >> 5, c16 = i & 31; *(LAS u32x4*)(lds + (ch * 264 + c16 * 8) * 2) = *(const u32x4*)(G2 + (size_t)(hg * 256 + ch) * 256 + c16 * 8); }
        __syncthreads();
        for (int it = 0; it < 4; ++it) {
            const int mt = rng * 32 + it * 8 + wave;
            const size_t m = (size_t)mt * 16 + fr; const bool hp = (m % SEQ) > 0;
            bf16x8 af[8];
#pragma unroll
            for (int ks = 0; ks < 8; ++ks) af[ks] = *(const bf16x8*)(AG + m * 256 + 32 * ks + 8 * fq);
            for (int hh = 0; hh < 4; ++hh) {
                const int h = hg * 4 + hh;
                f32x4 y[4], vc[4], vp[4];
#pragma unroll
                for (int nt = 0; nt < 4; ++nt) { const size_t e = ((size_t)((int)(m / SEQ) * 32 + h) * SEQ + (m % SEQ)) * 64 + 16 * nt + 4 * fq;
                    y[nt] = ld4bf(YRAW + e); vc[nt] = ld4bf(V + e); vp[nt] = (f32x4){0.f, 0.f, 0.f, 0.f}; if (hp) vp[nt] = ld4bf(V + e - 64); }
                const float bon = BON[(m * 32 + h) * 2] + BON[(m * 32 + h) * 2 + 1];
                f32x4 acc[4];
#pragma unroll
                for (int nt = 0; nt < 4; ++nt) acc[nt] = (f32x4){0.f, 0.f, 0.f, 0.f};
#pragma unroll
                for (int ks = 0; ks < 8; ++ks)
#pragma unroll
                    for (int nt = 0; nt < 4; ++nt) acc[nt] = __builtin_amdgcn_mfma_f32_16x16x32_bf16(*(LAS const bf16x8*)(lds + ((64 * hh + 16 * nt + fr) * 264 + 32 * ks + 8 * fq) * 2), af[ks], acc[nt], 0, 0, 0);
                float s1 = 0.f;
#pragma unroll
                for (int nt = 0; nt < 4; ++nt) s1 += (y[nt].x + y[nt].y) + (y[nt].z + y[nt].w);
                s1 += __shfl_xor(s1, 16); s1 += __shfl_xor(s1, 32);
                const float mean = s1 * (1.f / 64.f); float s2 = 0.f;
#pragma unroll
                for (int nt = 0; nt < 4; ++nt) { y[nt] = y[nt] - mean; s2 += sumsq4(y[nt]); }
                s2 += __shfl_xor(s2, 16); s2 += __shfl_xor(s2, 32);
                const float rstd = __builtin_amdgcn_rsqf(s2 * (1.f / 64.f) + GN_EPS);
#pragma unroll
                for (int nt = 0; nt < 4; ++nt) {
                    const int c = h * 64 + 16 * nt + 4 * fq;
                    const f32x4 muv = *(const f32x4*)(mu + MU_V + c), gw = *(const f32x4*)(p.in[I_GNW] + c), gb = *(const f32x4*)(p.in[I_GNB] + c);
                    const f32x4 v4 = vc[nt] + (vp[nt] - vc[nt]) * muv;
                    const f32x4 o = (y[nt] * rstd * gw + gb + v4 * bon) * acc[nt];
                    u32x2 w; w.x = pg8::cvt_pk_bf16_c(o.x, o.y); w.y = pg8::cvt_pk_bf16_c(o.z, o.w);
                    *(u32x2*)(ymix + m * D_MIX + 2048 + c) = w;
                }
            }
        }
    }
}

__device__ void phase_final(const Params& p, int wg, int nwg) {
    const int tid = otid(), lane = tid & 63, wave = tid >> 6;
    const float* rowss2 = (const float*)(p.ws + WS_CTL) + M; const float* gf = p.in[I_NFG]; const bf16_t* H2B = (const bf16_t*)(p.ws + WS_H2B);
    for (int m = wg * 8 + wave; m < M; m += nwg * 8) {
        const float rstd = 1.f / sqrtf(rowss2[m] * (1.f / DM) + RMS_EPS);
        u32x4 hw[4];
#pragma unroll
        for (int j = 0; j < 4; ++j) hw[j] = *(const u32x4*)(H2B + (size_t)m * DM + (64 * j + lane) * 8);
#pragma unroll
        for (int j = 0; j < 4; ++j) { const int c = (64 * j + lane) * 8;
            const f32x4 g0 = *(const f32x4*)(gf + c), g1 = *(const f32x4*)(gf + c + 4);
            *(f32x4*)(p.out + (size_t)m * DM + c) = up4((u32x2){hw[j].x, hw[j].y}) * rstd * g0; *(f32x4*)(p.out + (size_t)m * DM + c + 4) = up4((u32x2){hw[j].z, hw[j].w}) * rstd * g1; }
    }
}

#define XB_TMO      128
#define XB_XCNT(j)  (256  + 64 * (j))
#define XB_XSUB(j)  (1280 + 64 * (j))
#define XB_XGEN(j)  (2304 + 64 * (j))
#define XB_TOP      3328
#define XB_TOPGEN   3392
#define XCD_BAR_WORDS 3456
#define XB_SPIN_CAP (1u << 18)

__device__ __forceinline__ unsigned xb_ld(unsigned* p)              { return __hip_atomic_load(p, __ATOMIC_RELAXED, __HIP_MEMORY_SCOPE_AGENT); }
__device__ __forceinline__ unsigned xb_add(unsigned* p, unsigned v) { return __hip_atomic_fetch_add(p, v, __ATOMIC_RELAXED, __HIP_MEMORY_SCOPE_AGENT); }
__device__ __forceinline__ unsigned xb_xcc_id() { return (unsigned)__builtin_amdgcn_s_getreg((3 << 11) | 20) & 0xFu; }
#define XB_SPIN(cond, bar) do { unsigned _sp = 0; while (cond) { __builtin_amdgcn_s_sleep(1); \
    if ((++_sp & 255u) == 0u) { if (xb_ld(&(bar)[XB_TMO])) break; if (_sp > XB_SPIN_CAP) { atomicAdd(&(bar)[XB_TMO], 1u); break; } } } } while (0)

struct XcdBarrier {
    unsigned* bar; unsigned x;
    volatile LAS unsigned* st;
};

__device__ __forceinline__ XcdBarrier xcd_barrier_post(unsigned* bar, volatile LAS unsigned* st) {
    XcdBarrier b; b.bar = bar; b.x = xb_xcc_id(); b.st = st;
    if (threadIdx.x == 0) (void)xb_add(&bar[XB_XCNT(b.x)], 1u);
    return b;
}
__device__ __forceinline__ void xcd_barrier_complete(unsigned* bar, unsigned x, unsigned& nloc, unsigned& nx) {
    const unsigned G = gridDim.x * gridDim.y * gridDim.z;
    unsigned sum, cnt, mine, sp = 0u;
    for (;;) {
        sum = 0u; cnt = 0u; mine = 0u;
#pragma unroll
        for (unsigned j = 0; j < 16; ++j) { const unsigned c = xb_ld(&bar[XB_XCNT(j)]); sum += c; cnt += (c > 0u) ? 1u : 0u; mine = (j == x) ? c : mine; }
        if (sum == G) break;
        __builtin_amdgcn_s_sleep(1);
        if ((++sp & 255u) == 0u) { if (xb_ld(&bar[XB_TMO])) break; if (sp > XB_SPIN_CAP) { atomicAdd(&bar[XB_TMO], 1u); break; } }
    }
    nloc = mine > 0u ? mine : 1u; nx = cnt > 0u ? cnt : 1u;
}

__device__ __forceinline__ void xcd_barrier(const XcdBarrier& b) {
    asm volatile("s_waitcnt vmcnt(0)" ::: "memory");
    __syncthreads();
    if (threadIdx.x == 0) {
        unsigned* bar = b.bar;
        __builtin_amdgcn_s_waitcnt(0);
        unsigned nloc = b.st[0], nx = b.st[1];
        if (nloc == 0u) { xcd_barrier_complete(bar, b.x, nloc, nx); b.st[0] = nloc; b.st[1] = nx; }
        const unsigned old = xb_add(&bar[XB_XSUB(b.x)], 1u);
        const unsigned gen = old / nloc;
        if (old + 1u == (gen + 1u) * nloc) {
            __builtin_amdgcn_fence(__ATOMIC_RELEASE, "agent");
            asm volatile("s_waitcnt vmcnt(0)" ::: "memory");
            const unsigned og = xb_add(&bar[XB_TOP], 1u);
            const unsigned tg = og / nx;
            if (og + 1u == (tg + 1u) * nx) xb_add(&bar[XB_TOPGEN], 1u);
            else XB_SPIN(xb_ld(&bar[XB_TOPGEN]) == tg, bar);
            __builtin_amdgcn_fence(__ATOMIC_ACQUIRE, "agent");
            xb_add(&bar[XB_XGEN(b.x)], 1u);
            asm volatile("s_waitcnt vmcnt(0)" ::: "memory");
        } else {
            XB_SPIN(xb_ld(&bar[XB_XGEN(b.x)]) == gen, bar);
            __builtin_amdgcn_fence(__ATOMIC_ACQUIRE, "agent");
            asm volatile("s_waitcnt vmcnt(0)" ::: "memory");
        }
    }
    __syncthreads();
}

constexpr size_t CTL_XBAR = 704 * 1024;
static_assert(CTL_XBAR + XCD_BAR_WORDS * 4 <= CTL_BYTES, "barrier words inside the memset");
#define PH_BEGIN(k) do { if (PROBE_PH == (k) && blockIdx.x == 0 && threadIdx.x == 0) pt0 = __builtin_amdgcn_s_memrealtime(); } while (0)
#define PH_END(k) do { if (PROBE_PH == (k) && blockIdx.x == 0 && threadIdx.x == 0) pt1 = __builtin_amdgcn_s_memrealtime(); } while (0)
__global__ void __launch_bounds__(512, 2) k_mega(Params p) {
    extern __shared__ __attribute__((aligned(16))) unsigned char lds_raw[];
    LAS unsigned char* lds = (LAS unsigned char*)lds_raw;
    cg::grid_group grid = cg::this_grid();
    const int wg = blockIdx.x, nwg = gridDim.x;
    bf16_t* ymix = (bf16_t*)(p.ws + WS_R);
    float* rowss1 = (float*)(p.ws + WS_CTL); float* rowss2 = rowss1 + M;
    unsigned long long pt0 = 0, pt1 = 0;
    volatile LAS unsigned* xbst = (volatile LAS unsigned*)(lds + LDS_BYTES_C - 64);
    if (threadIdx.x < 2) xbst[threadIdx.x] = 0u;
    __syncthreads();
    const XcdBarrier xbar = xcd_barrier_post((unsigned*)(p.ws + WS_CTL + CTL_XBAR), xbst);
    grid.sync();
    PH_BEGIN(1);
    phase_p0a(p, lds, wg, nwg);
    xcd_barrier(xbar);
    PH_END(1); PH_BEGIN(2);
    run_gemm(lds, (const bf16_t*)p.out, (const bf16_t*)(p.ws + WS_WIN), M, NP, DM, EpiP{p.ws});
    xcd_barrier(xbar);
    PH_END(2); PH_BEGIN(3);
    phase_rwkv_pre(p, wg, nwg);
    phase_ssd1(p, lds, wg, nwg);
    xcd_barrier(xbar);
    PH_END(3); PH_BEGIN(4); PH_BEGIN(10);
#if RWKV_CHUNKED == 0
    phase_ssd2(p, wg, nwg);
#endif
    PH_END(10);
#if RWKV_CHUNKED == 2
    phase_rwkv_dist(p, lds, wg, nwg);
#elif RWKV_CHUNKED == 1
    phase_rwkv_chunked(p, lds, wg, nwg);
#else
    phase_rwkv_scan(p, lds, wg, nwg);
#endif
    if (PROBE_PH == 12 || PROBE_PH == 22 || PROBE_PH == 21) __syncthreads();
    if ((PROBE_PH == 11 || PROBE_PH == 12 || PROBE_PH == 13 || PROBE_PH == 21 || PROBE_PH == 22) && blockIdx.x == 0 && threadIdx.x == 0) { pt0 = 0; pt1 = *(LAS unsigned long long*)(lds + 163840 - 16); }
    xcd_barrier(xbar);
    PH_END(4); PH_BEGIN(5); PH_BEGIN(14);
    phase_ssd3(p, ymix, lds, wg, nwg);
    if (PROBE_PH == 14) { asm volatile("s_waitcnt vmcnt(0)" ::: "memory"); } PH_END(14);
    phase_rwkv_post(p, ymix, lds, wg, nwg);
    xcd_barrier(xbar);
    PH_END(5); PH_BEGIN(6); PH_BEGIN(15);
    phase_p0b(p, lds, wg, nwg);
    if (PROBE_PH == 15) { asm volatile("s_waitcnt vmcnt(0)" ::: "memory"); } PH_END(15);
    __syncthreads();
    run_gemm(lds, ymix, (const bf16_t*)(p.ws + WS_WOUT), M, DM, D_MIX, EpiOut{p.in[I_X], (bf16_t*)(p.ws + WS_H1B), rowss1, 0.f});
    xcd_barrier(xbar);
    PH_END(6); PH_BEGIN(7);
    run_gemm(lds, (const bf16_t*)(p.ws + WS_H1B), (const bf16_t*)(p.ws + WS_WGU), M, NGU, DM, EpiGU{rowss1, (bf16_t*)(p.ws + WS_ACT)});
    xcd_barrier(xbar);
    PH_END(7); PH_BEGIN(8);
    run_gemm(lds, (const bf16_t*)(p.ws + WS_ACT), (const bf16_t*)(p.ws + WS_WDN), M, DM, D_FF, EpiDown{(const bf16_t*)(p.ws + WS_H1B), (bf16_t*)(p.ws + WS_H2B), rowss2, 0.f});
    xcd_barrier(xbar);
    PH_END(8); PH_BEGIN(9);
    phase_final(p, wg, nwg);
    PH_END(9);
    if (PROBE_PH != 0 && blockIdx.x == 0 && threadIdx.x == 0) { const unsigned long long t0 = __builtin_amdgcn_s_memrealtime(), d = pt1 - pt0; while (__builtin_amdgcn_s_memrealtime() - t0 < d) __builtin_amdgcn_s_sleep(8); }
}

constexpr int LDS_BYTES = 163840;
extern "C" void kernel_launch(void* const* d_in, const int* in_sizes, int n_in, void* d_out, int out_size, void* d_ws, size_t ws_size, hipStream_t stream) {
    static int grid = 0;
    if (grid == 0) {
        if (n_in != 26 || ws_size < WS_END) { fprintf(stderr, "kernel_launch: unexpected n_in %d / ws_size %zu\n", n_in, ws_size); grid = -1; return; }
        int dev = 0, cus = 0, per_cu = 0;
        (void)hipGetDevice(&dev);
        (void)hipDeviceGetAttribute(&cus, hipDeviceAttributeMultiprocessorCount, dev);
        (void)hipFuncSetAttribute((const void*)k_mega, hipFuncAttributeMaxDynamicSharedMemorySize, LDS_BYTES);
        (void)hipOccupancyMaxActiveBlocksPerMultiprocessor(&per_cu, (const void*)k_mega, 512, LDS_BYTES);
        if (per_cu < 1) { fprintf(stderr, "kernel_launch: occupancy query says %d blocks/CU\n", per_cu); grid = -1; return; }
        grid = cus;
        fprintf(stderr, "kernel_launch: cus %d per_cu %d grid %d ws %zu\n", cus, per_cu, grid, ws_size);
    }
    if (grid < 0) return;
    Params p{};
    for (int i = 0; i < 26; ++i) p.in[i] = (const float*)d_in[i];
    p.out = (float*)d_out; p.ws = (unsigned char*)d_ws;
    (void)hipMemsetAsync((char*)d_ws + WS_CTL, 0, CTL_BYTES, stream);
    void* args[] = {&p};
    hipError_t e = hipLaunchCooperativeKernel((const void*)k_mega, dim3(grid), dim3(512), args, LDS_BYTES, stream);
    if (e != hipSuccess) fprintf(stderr, "cooperative launch failed: %s (grid %d)\n", hipGetErrorString(e), grid);
}
```

```cpp
#include <hip/hip_runtime.h>
#include <hip/hip_cooperative_groups.h>
#include <cstdio>
#include <cstdint>

#ifndef RWKV_CHUNKED
#define RWKV_CHUNKED 2
#endif
#ifndef PROBE_PH
#define PROBE_PH 0
#endif
#define LAS __attribute__((address_space(3)))
constexpr int LDS_BYTES_C = 163840;
namespace cg = cooperative_groups;
typedef unsigned short bf16_t;
typedef short bf16x8 __attribute__((ext_vector_type(8)));
typedef float f32x4 __attribute__((ext_vector_type(4)));
typedef unsigned u32x4 __attribute__((ext_vector_type(4)));
typedef unsigned u32x2 __attribute__((ext_vector_type(2)));
typedef float f32x2 __attribute__((ext_vector_type(2)));

constexpr int BATCH = 2, SEQ = 8192, DM = 2048, M = BATCH * SEQ;
constexpr int D_SSD = 2048, D_RWKV = 2048, D_MIX = 4096, NHEAD = 32, HD = 64, NGRP = 4, NSTATE = 128;
constexpr int D_XBC = 3072, D_IN = 11744, NP = 11776  , D_FF = 5632, NGU = 11264;
constexpr int LW = 96, LG = 256;
constexpr float RMS_EPS = 1e-6f, GATED_EPS = 1e-5f, GN_EPS = 64e-5f;
constexpr int O_Z = 0, O_XBC = 2048, O_DT = 5120, O_R = 5152, O_K = 7200, O_V = 9248, O_WD = 11296, O_AD = 11392, O_GD = 11488;
constexpr int MU_R = 0, MU_K = 2048, MU_V = 4096, MU_WD = 6144, MU_AD = 6240, MU_GD = 6336;

constexpr size_t MiB = 1u << 20;
constexpr size_t WS_CTL = 0, CTL_BYTES = 1 * MiB;
constexpr size_t WS_WIN = 1 * MiB;
constexpr size_t WS_WOUT = 47 * MiB;
constexpr size_t WS_G2 = 63 * MiB;
constexpr size_t WS_Z = 64 * MiB;
constexpr size_t WS_XBC = 128 * MiB;
constexpr size_t WS_V = 224 * MiB;
constexpr size_t WS_SM = 288 * MiB;
constexpr size_t WS_GD = 304 * MiB;
constexpr size_t WS_R = 312 * MiB;
constexpr size_t WS_K = 376 * MiB;
constexpr size_t WS_FREE = 440 * MiB;
constexpr size_t WS_H2B = 64 * MiB;
constexpr size_t WS_H1B = 192 * MiB;
constexpr size_t WS_ACT = 256 * MiB;
constexpr size_t WS_WGU = 440 * MiB;
constexpr size_t WS_WDN = 484 * MiB;
constexpr size_t WS_END = 512 * MiB;
static_assert(WS_WDN + (size_t)2048 * 5632 * 2 <= WS_END, "ws map");

struct Params {
    const float* in[26];
    float* out;
    unsigned char* ws;
};
enum { I_X = 0, I_N1G, I_WIN, I_CONVW, I_CONVB, I_DTB, I_ALOG, I_SSDD, I_SSDNG, I_MU, I_W0, I_W2, I_A0, I_A2, I_G2, I_KK, I_KA, I_RK, I_GNW, I_GNB, I_WOUT, I_N2G, I_WGATE, I_WUP, I_WDOWN, I_NFG };

__device__ __forceinline__ unsigned f2bf(float f) { unsigned u = __builtin_bit_cast(unsigned, f); return (u + 0x7fffu + ((u >> 16) & 1u)) >> 16; }
__device__ __forceinline__ unsigned pk2(float lo, float hi) { return f2bf(lo) | (f2bf(hi) << 16); }
__device__ __forceinline__ float bf2f(bf16_t v) { return __builtin_bit_cast(float, (unsigned)v << 16); }
__device__ __forceinline__ float wave_sum(float v) {
#pragma unroll
    for (int o = 1; o < 64; o <<= 1) v += __shfl_xor(v, o);
    return v;
}
__device__ __forceinline__ int otid() { int t = threadIdx.x; asm volatile("" : "+v"(t)); return t; }
__device__ __forceinline__ float sigmoidf_(float x) { return __builtin_amdgcn_rcpf(1.f + __expf(-x)); }
__device__ __forceinline__ float siluf_(float x) { return x * __builtin_amdgcn_rcpf(1.f + __expf(-x)); }
__device__ __forceinline__ float softplusf_(float x) { return fmaxf(x, 0.f) + log1pf(__expf(-fabsf(x))); }

__device__ __forceinline__ void transpose_item(const float* W, int ldw, int K, bf16_t* WT, int n_dst0, int src_col0, const float* kscale, LAS float* scr, int kb, int nb, int lane) {
    const int k0 = 64 * kb, n0 = 32 * nb;
    const int r8 = lane >> 3, n4 = lane & 7;
    f32x4 v[8];
#pragma unroll
    for (int i = 0; i < 8; ++i) v[i] = __builtin_nontemporal_load((const f32x4*)(W + (size_t)(k0 + 8 * i + r8) * ldw + src_col0 + n0 + 4 * n4));
#pragma unroll
    for (int i = 0; i < 8; ++i) { const int kk = 8 * i + r8; f32x4 x = v[i]; if (kscale) x = x * kscale[k0 + kk];
        LAS float* d = scr + kk * 33 + 4 * n4; d[0] = x.x; d[1] = x.y; d[2] = x.z; d[3] = x.w; }
    asm volatile("s_waitcnt lgkmcnt(0)" ::: "memory");
    const int c = lane & 7;
#pragma unroll
    for (int j = 0; j < 4; ++j) { const int n = (lane >> 3) + 8 * j; const LAS float* s = scr + (8 * c) * 33 + n;
        u32x4 o; o.x = pk2(s[0 * 33], s[1 * 33]); o.y = pk2(s[2 * 33], s[3 * 33]); o.z = pk2(s[4 * 33], s[5 * 33]); o.w = pk2(s[6 * 33], s[7 * 33]);
        *(u32x4*)(WT + (size_t)(n_dst0 + n0 + n) * K + k0 + 8 * c) = o; }
    asm volatile("s_waitcnt lgkmcnt(0)" ::: "memory");
}
__device__ __forceinline__ void convert_seg(const float* W, int ldw, int K, bf16_t* WT, int n_dst0, int count, int src_col0, const float* kscale, LAS float* scr, int gw, int ngw, int lane) {
    const int nblk = count / 32, nit = (K / 64) * nblk;
    for (int it = gw; it < nit; it += ngw) transpose_item(W, ldw, K, WT, n_dst0, src_col0, kscale, scr, it / nblk, it % nblk, lane);
}
__device__ __forceinline__ void zero_rows(bf16_t* WT, int K, int n0, int count, int gw, int ngw, int lane) {
    const int chunks = count * K / 8;
    u32x4 z = {0u, 0u, 0u, 0u};
    for (int i = gw * 64 + lane; i < chunks; i += ngw * 64) *(u32x4*)(WT + (size_t)n0 * K + (size_t)i * 8) = z;
}

__device__ void phase_p0a(const Params& p, LAS unsigned char* lds, int wg, int nwg) {
    const int tid = otid(), lane = tid & 63, wave = tid >> 6;
    LAS float* scr = (LAS float*)(lds + wave * 16384);
    const int gw = wg * 8 + wave, ngw = nwg * 8;
    bf16_t* WIN = (bf16_t*)(p.ws + WS_WIN); bf16_t* WOUT = (bf16_t*)(p.ws + WS_WOUT);
    const float* w_in = p.in[I_WIN];
    convert_seg(w_in, D_IN, DM, WIN, 0, 2048, O_Z, nullptr, scr, gw, ngw, lane);
    convert_seg(w_in, D_IN, DM, WIN, 2048, 3072, O_XBC, nullptr, scr, gw, ngw, lane);
    convert_seg(w_in, D_IN, DM, WIN, 5120, 2048, O_R, nullptr, scr, gw, ngw, lane);
    convert_seg(w_in, D_IN, DM, WIN, 7168, 2048, O_K, nullptr, scr, gw, ngw, lane);
    convert_seg(w_in, D_IN, DM, WIN, 9216, 2048, O_V, nullptr, scr, gw, ngw, lane);
    convert_seg(w_in, D_IN, DM, WIN, 11264, 32, O_DT, nullptr, scr, gw, ngw, lane);
    convert_seg(w_in, D_IN, DM, WIN, 11296, 96, O_WD, nullptr, scr, gw, ngw, lane);
    convert_seg(w_in, D_IN, DM, WIN, 11392, 96, O_AD, nullptr, scr, gw, ngw, lane);
    zero_rows(WIN, DM, 11488, 32, gw, ngw, lane);
    convert_seg(w_in, D_IN, DM, WIN, 11520, 256, O_GD, nullptr, scr, gw, ngw, lane);
    convert_seg(p.in[I_WOUT], DM, D_MIX, WOUT, 0, 2048, 0, nullptr, scr, gw, ngw, lane);
    convert_seg(p.in[I_G2], D_RWKV, LG, (bf16_t*)(p.ws + WS_G2), 0, 2048, 0, nullptr, scr, gw, ngw, lane);
    bf16_t* U = (bf16_t*)p.out; const float* x = p.in[I_X]; const float* g1 = p.in[I_N1G];
    for (int m = gw; m < M; m += ngw) {
        const f32x4* xr = (const f32x4*)(x + (size_t)m * DM) + lane; f32x4 v[8]; float s = 0.f;
#pragma unroll
        for (int j = 0; j < 8; ++j) { v[j] = __builtin_nontemporal_load(&xr[64 * j]); s += (v[j].x * v[j].x + v[j].y * v[j].y) + (v[j].z * v[j].z + v[j].w * v[j].w); }
        const float rstd = 1.f / sqrtf(wave_sum(s) * (1.f / DM) + RMS_EPS);
        u32x2* o = (u32x2*)(U + (size_t)m * DM) + lane;
#pragma unroll
        for (int j = 0; j < 8; ++j) { const f32x4 g = ((const f32x4*)g1)[64 * j + lane]; u32x2 w; w.x = pk2(v[j].x * rstd * g.x, v[j].y * rstd * g.y); w.y = pk2(v[j].z * rstd * g.z, v[j].w * rstd * g.w); o[64 * j] = w; }
    }
}
__device__ void phase_p0b(const Params& p, LAS unsigned char* lds, int wg, int nwg) {
    const int tid = otid(), lane = tid & 63, wave = tid >> 6;
    LAS float* scr = (LAS float*)(lds + wave * 16384);
    const int gw = wg * 8 + wave, ngw = nwg * 8;
    bf16_t* WGU = (bf16_t*)(p.ws + WS_WGU); bf16_t* WDN = (bf16_t*)(p.ws + WS_WDN);
    const int nblk = 4, per_half = (DM / 64) * nblk, nit = (D_FF / 128) * 2 * per_half;
    for (int it = gw; it < nit; it += ngw) {
        const int th = it / per_half, r = it % per_half, tile = th >> 1, half = th & 1;
        transpose_item(half ? p.in[I_WUP] : p.in[I_WGATE], D_FF, DM, WGU, 256 * tile + 128 * half, 128 * tile, p.in[I_N2G], scr, r / nblk, r % nblk, lane);
    }
    convert_seg(p.in[I_WDOWN], DM, D_FF, WDN, 0, 2048, 0, nullptr, scr, gw, ngw, lane);
}

namespace pg8 {
#define PG8_LAS __attribute__((address_space(3)))
typedef unsigned short bf16_t;
typedef short bf16x8 __attribute__((ext_vector_type(8)));
typedef float f32x4 __attribute__((ext_vector_type(4)));
typedef unsigned u32x4 __attribute__((ext_vector_type(4)));
constexpr int BM = 256, BK = 64, HALF = 128, HTB = HALF * BK * 2  , STAGE_BYTES = 8 * HTB, NXCD = 8, WGM = 8;

__host__ __device__ __forceinline__ int lds_byte(int r, int c) { const int st = (r >> 4) * 2 + (c >> 5), rr = r & 15, cc = c & 31, ob = rr * 64 + cc * 2; return st * 1024 + (ob ^ (((ob >> 9) & 1) << 5)); }
__host__ __device__ __forceinline__ void stage_rc(int b, int& R, int& C) { const int st = b / 1024, sb = b % 1024, swz = sb ^ (((sb >> 9) & 1) << 5); R = (st >> 1) * 16 + swz / 64; C = (st & 1) * 32 + (swz % 64) / 2; }
__host__ __device__ __forceinline__ int perm32(int rho) { const int n = rho >> 4, i = rho & 15; return 8 * (i >> 2) + 4 * n + (i & 3); }

struct Unit { int pm, pn; };
struct Gemm { const bf16_t* A; const bf16_t* Bt; int M, N, K; };

struct StaticOrder {
    int nM, nN, nwg, G, c;
    __host__ __device__ void init(int M, int N, int G_, int c_) { nM = M / BM; nN = N / BM; nwg = nM * nN; G = G_; c = c_; }
    __host__ __device__ bool next(int i, Unit& u) const {
        const long L = (long)i * G + c; if (L >= nwg) return false;
        int wgid = (int)L; { const int q = nwg / NXCD, r = nwg % NXCD, xcd = wgid % NXCD, off = wgid / NXCD; wgid = (xcd < r ? xcd * (q + 1) : r * (q + 1) + (xcd - r) * q) + off; }
        const int nig = WGM * nN, gid = wgid / nig, fm = gid * WGM, gsz = (nM - fm) < WGM ? (nM - fm) : WGM;
        u.pm = fm + ((wgid % nig) % gsz); u.pn = (wgid % nig) / gsz; return true;
    }
    __device__ __forceinline__ void a_ready(const Unit&) const {}
    __device__ __forceinline__ void done(const Unit&) const {}
};

typedef float f32x2_ __attribute__((ext_vector_type(2))); typedef __bf16 bf16v2_ __attribute__((ext_vector_type(2)));
__device__ __forceinline__ unsigned cvt_pk_bf16(float lo, float hi) { unsigned r; asm volatile("v_cvt_pk_bf16_f32 %0, %1, %2" : "=v"(r) : "v"(lo), "v"(hi)); return r; }
__device__ __forceinline__ unsigned cvt_pk_bf16_c(float lo, float hi) { const f32x2_ v = {lo, hi}; return __builtin_bit_cast(unsigned, __builtin_convertvector(v, bf16v2_)); }

template <class F> struct EpiAdapt {
    static constexpr bool PERM = true, AFTER_DRAIN = false;
    F f;
    __device__ __forceinline__ void operator()(const f32x4 (&acc)[2][2][4][2], const Unit& u, int wr, int wc, int fr, int fq) const {
        F g = f;
#pragma unroll
        for (int ai = 0; ai < 2; ++ai)
#pragma unroll
            for (int m = 0; m < 4; ++m) {
                const int row = u.pm * BM + ai * HALF + wr * 64 + m * 16 + fr;
                g.begin();
                if constexpr (F::PAIR) g.pair8(row, u.pn, wc * 32 + 8 * fq, acc[ai][0][m][0], acc[ai][0][m][1], acc[ai][1][m][0], acc[ai][1][m][1]);
                else {
#pragma unroll
                    for (int bj = 0; bj < 2; ++bj) g.oct(row, u.pn, bj * HALF + wc * 32 + 8 * fq, acc[ai][bj][m][0], acc[ai][bj][m][1]);
                }
                g.end(row);
            }
    }
};
template <class Epi, class Sched, bool ALIGN_EPI = false, bool SP2 = false>
__device__ __forceinline__ void gemm_phase(PG8_LAS unsigned char* lds, const Gemm g, const Sched& S, const Epi& E) {
    int tid_ = threadIdx.x; asm volatile("" : "+v"(tid_));
    const int tid = tid_, wid = __builtin_amdgcn_readfirstlane(tid >> 6), lane = tid & 63, wr = wid >> 2, wc = wid & 3, fr = lane & 15, fq = lane >> 4;
    const int K = g.K, nt = K / BK;
    unsigned voffA[2], voffB[2];
#pragma unroll
    for (int i = 0; i < 2; ++i) { int R, C; stage_rc(tid * 16 + i * 8192, R, C); const int Rb = Epi::PERM ? ((R & ~31) + perm32(R & 31)) : R;
        voffA[i] = (unsigned)(R * K + C) * 2u; voffB[i] = (unsigned)(Rb * K + C) * 2u; }
    const size_t kstep = (size_t)(BK * 2);
    const size_t hstep = (size_t)HALF * K * 2;
    const size_t tstep = 2 * hstep;
    const unsigned ldsw = (unsigned)wid * 1024u;
    const int aoff = lds_byte(wr * 64 + fr, fq * 8), boff = lds_byte(wc * 32 + fr, fq * 8);
#define PG8_SA(b, h) (((b) * 2 + (h)) * HTB)
#define PG8_SB(b, h) ((4 + (b) * 2 + (h)) * HTB)
#define PG8_STAGE(bufoff, gbase, voff) do { _Pragma("unroll") for (int _i = 0; _i < 2; ++_i) \
        __builtin_amdgcn_global_load_lds((const unsigned*)((const char*)(gbase) + (voff)[_i]), (PG8_LAS unsigned*)(lds + (bufoff) + ldsw + _i * 8192), 16, 0, 0); } while (0)
#define PG8_LDA(dst, b, h) do { _Pragma("unroll") for (int m = 0; m < 4; ++m) _Pragma("unroll") for (int k = 0; k < 2; ++k) dst[m][k] = *(const PG8_LAS bf16x8*)(lds + PG8_SA(b, h) + aoff + m * 2048 + k * 1024); } while (0)
#define PG8_LDB(dst, b, h) do { _Pragma("unroll") for (int n = 0; n < 2; ++n) _Pragma("unroll") for (int k = 0; k < 2; ++k) dst[n][k] = *(const PG8_LAS bf16x8*)(lds + PG8_SB(b, h) + boff + n * 2048 + k * 1024); } while (0)
#define PG8_MMA(ai, bj, At, Bt) do { __builtin_amdgcn_s_setprio(1); _Pragma("unroll") for (int m = 0; m < 4; ++m) _Pragma("unroll") for (int n = 0; n < 2; ++n) _Pragma("unroll") for (int k = 0; k < 2; ++k) \
        acc[ai][bj][m][n] = __builtin_amdgcn_mfma_f32_16x16x32_bf16(Bt[n][k], At[m][k], acc[ai][bj][m][n], 0, 0, 0); __builtin_amdgcn_s_setprio(0); } while (0)
#define PG8_WAIT_V(n) asm volatile("s_waitcnt vmcnt(" #n ")" ::: "memory")
#define PG8_WAIT_L(n) asm volatile("s_waitcnt lgkmcnt(" #n ")" ::: "memory")
#define PG8_BAR __builtin_amdgcn_s_barrier()
#define PG8_SCHED __builtin_amdgcn_sched_barrier(0)
    Unit cur, nxt; int ui = 0;
    if (!S.next(0, cur)) return;
    f32x4 acc[2][2][4][2];
#pragma unroll
    for (int a = 0; a < 2; ++a)
#pragma unroll
        for (int b = 0; b < 2; ++b)
#pragma unroll
            for (int m = 0; m < 4; ++m)
#pragma unroll
                for (int n = 0; n < 2; ++n) acc[a][b][m][n] = (f32x4){0.f, 0.f, 0.f, 0.f};
    bf16x8 At[4][2], B0[2][2], B1[2][2];
    const char* cA = (const char*)g.A + (size_t)cur.pm * tstep; const char* cB = (const char*)g.Bt + (size_t)cur.pn * tstep;
    S.a_ready(cur);
    if constexpr (SP2) {
        PG8_STAGE(PG8_SB(0, 0), cB, voffB); PG8_STAGE(PG8_SB(0, 1), cB + hstep, voffB); PG8_STAGE(PG8_SA(0, 0), cA, voffA); PG8_STAGE(PG8_SA(0, 1), cA + hstep, voffA);
        if (wr == 1) PG8_BAR;
        PG8_WAIT_V(2); PG8_BAR;
        PG8_STAGE(PG8_SB(1, 0), cB + kstep, voffB); PG8_STAGE(PG8_SA(1, 0), cA + kstep, voffA); PG8_STAGE(PG8_SB(1, 1), cB + hstep + kstep, voffB);
        PG8_WAIT_V(6); PG8_BAR;
    } else {
        PG8_STAGE(PG8_SB(0, 0), cB, voffB); PG8_STAGE(PG8_SA(0, 0), cA, voffA); PG8_STAGE(PG8_SB(0, 1), cB + hstep, voffB); PG8_STAGE(PG8_SA(0, 1), cA + hstep, voffA);
        if (wr == 1) PG8_BAR;
        PG8_WAIT_V(4); PG8_BAR;
        PG8_STAGE(PG8_SB(1, 0), cB + kstep, voffB); PG8_STAGE(PG8_SA(1, 0), cA + kstep, voffA); PG8_STAGE(PG8_SB(1, 1), cB + hstep + kstep, voffB);
        PG8_WAIT_V(6); PG8_BAR;
    }
    for (;;) {
        const bool has_next = S.next(ui + 1, nxt);
        const char* nA = has_next ? (const char*)g.A + (size_t)nxt.pm * tstep : cA; const char* nB = has_next ? (const char*)g.Bt + (size_t)nxt.pn * tstep : cB;
        for (int t = 0; t < nt; t += 2) {
            const bool last = (t == nt - 2);
            const char* a1 = cA + (size_t)(t + 1) * kstep;
            const char* a2 = last ? nA : cA + (size_t)(t + 2) * kstep; const char* b2 = last ? nB : cB + (size_t)(t + 2) * kstep;
            const char* a3 = a2 + kstep; const char* b3 = b2 + kstep;
            if (last && has_next) S.a_ready(nxt);
            if constexpr (SP2) {
            PG8_LDB(B0, 0, 0); PG8_LDB(B1, 0, 1); PG8_SCHED; PG8_LDA(At, 0, 0); PG8_STAGE(PG8_SA(1, 1), a1 + hstep, voffA);
            PG8_WAIT_V(8); PG8_WAIT_L(0); PG8_BAR; PG8_MMA(0, 0, At, B0); PG8_MMA(0, 1, At, B1); PG8_BAR; PG8_SCHED;
            PG8_LDA(At, 0, 1); PG8_STAGE(PG8_SB(0, 0), b2, voffB); PG8_STAGE(PG8_SB(0, 1), b2 + hstep, voffB); PG8_STAGE(PG8_SA(0, 0), a2, voffA);
            PG8_WAIT_V(8); PG8_WAIT_L(0); PG8_BAR; PG8_MMA(1, 0, At, B0); PG8_MMA(1, 1, At, B1); PG8_BAR; PG8_SCHED;
            PG8_LDB(B0, 1, 0); PG8_LDB(B1, 1, 1); PG8_SCHED; PG8_LDA(At, 1, 0); PG8_STAGE(PG8_SA(0, 1), a2 + hstep, voffA);
            PG8_WAIT_V(8); PG8_WAIT_L(0); PG8_BAR; PG8_MMA(0, 0, At, B0); PG8_MMA(0, 1, At, B1); PG8_BAR; PG8_SCHED;
            PG8_LDA(At, 1, 1); PG8_STAGE(PG8_SB(1, 0), b3, voffB); PG8_STAGE(PG8_SB(1, 1), b3 + hstep, voffB); PG8_STAGE(PG8_SA(1, 0), a3, voffA);
            PG8_WAIT_V(8); PG8_WAIT_L(0); PG8_BAR; PG8_MMA(1, 0, At, B0); PG8_MMA(1, 1, At, B1); PG8_BAR; PG8_SCHED;
            } else {
            PG8_LDB(B0, 0, 0); PG8_SCHED; PG8_LDA(At, 0, 0); PG8_STAGE(PG8_SA(1, 1), a1 + hstep, voffA);
            PG8_WAIT_L(8); PG8_BAR; PG8_WAIT_L(0); PG8_MMA(0, 0, At, B0); PG8_BAR; PG8_SCHED;
            PG8_LDB(B1, 0, 1); PG8_STAGE(PG8_SB(0, 0), b2, voffB);
            PG8_BAR; PG8_WAIT_L(0); PG8_MMA(0, 1, At, B1); PG8_BAR;
            PG8_LDA(At, 0, 1); PG8_STAGE(PG8_SA(0, 0), a2, voffA);
            PG8_BAR; PG8_WAIT_L(0); PG8_MMA(1, 0, At, B0); PG8_BAR; PG8_SCHED;
            PG8_STAGE(PG8_SB(0, 1), b2 + hstep, voffB);
            PG8_WAIT_V(6); PG8_BAR; PG8_MMA(1, 1, At, B1); PG8_BAR;
            PG8_LDB(B0, 1, 0); PG8_SCHED; PG8_LDA(At, 1, 0); PG8_STAGE(PG8_SA(0, 1), a2 + hstep, voffA);
            PG8_WAIT_L(8); PG8_BAR; PG8_WAIT_L(0); PG8_MMA(0, 0, At, B0); PG8_BAR; PG8_SCHED;
            PG8_LDB(B1, 1, 1); PG8_STAGE(PG8_SB(1, 0), b3, voffB);
            PG8_BAR; PG8_WAIT_L(0); PG8_MMA(0, 1, At, B1); PG8_BAR;
            PG8_LDA(At, 1, 1); PG8_STAGE(PG8_SA(1, 0), a3, voffA);
            PG8_BAR; PG8_WAIT_L(0); PG8_MMA(1, 0, At, B0); PG8_BAR; PG8_SCHED;
            PG8_STAGE(PG8_SB(1, 1), b3 + hstep, voffB);
            PG8_WAIT_V(6); PG8_BAR; PG8_MMA(1, 1, At, B1); PG8_BAR;
            }
        }
        if constexpr (ALIGN_EPI) { if (wr == 0) PG8_BAR; }
        if constexpr (!Epi::AFTER_DRAIN) { E(acc, cur, wr, wc, fr, fq); S.done(cur); }
        if (!has_next) break;
#pragma unroll
        for (int a = 0; a < 2; ++a)
#pragma unroll
            for (int b = 0; b < 2; ++b)
#pragma unroll
                for (int m = 0; m < 4; ++m)
#pragma unroll
                    for (int n = 0; n < 2; ++n) acc[a][b][m][n] = (f32x4){0.f, 0.f, 0.f, 0.f};
        cur = nxt; cA = nA; cB = nB; ++ui;
        if constexpr (ALIGN_EPI) { if (wr == 1) PG8_BAR; }
    }
    PG8_WAIT_V(0);
    if constexpr (!ALIGN_EPI) { if (wr == 0) PG8_BAR; }
    PG8_BAR;
    if constexpr (Epi::AFTER_DRAIN) { E.fused(acc, cur, wr, wc, fr, fq, lds, wid, lane); S.done(cur); }
#undef PG8_SA
#undef PG8_SB
#undef PG8_STAGE
#undef PG8_LDA
#undef PG8_LDB
#undef PG8_MMA
#undef PG8_WAIT_V
#undef PG8_WAIT_L
#undef PG8_BAR
#undef PG8_SCHED
}
}

__device__ __forceinline__ u32x4 pack8(f32x4 a, f32x4 b) { u32x4 w; w.x = pg8::cvt_pk_bf16(a.x, a.y); w.y = pg8::cvt_pk_bf16(a.z, a.w); w.z = pg8::cvt_pk_bf16(b.x, b.y); w.w = pg8::cvt_pk_bf16(b.z, b.w); return w; }
__device__ __forceinline__ f32x4 ld4bf(const bf16_t* p) { const u32x2 w = *(const u32x2*)p; f32x4 r; r.x = __builtin_bit_cast(float, w.x << 16); r.y = __builtin_bit_cast(float, w.x & 0xffff0000u); r.z = __builtin_bit_cast(float, w.y << 16); r.w = __builtin_bit_cast(float, w.y & 0xffff0000u); return r; }
__device__ __forceinline__ f32x4 up4(u32x2 w) { f32x4 r; r.x = __builtin_bit_cast(float, w.x << 16); r.y = __builtin_bit_cast(float, w.x & 0xffff0000u); r.z = __builtin_bit_cast(float, w.y << 16); r.w = __builtin_bit_cast(float, w.y & 0xffff0000u); return r; }
__device__ __forceinline__ float sumsq4(f32x4 h) { return (h.x * h.x + h.y * h.y) + (h.z * h.z + h.w * h.w); }
struct EpiP {
    static constexpr bool PAIR = false;
    unsigned char* ws;
    __device__ __forceinline__ void begin() {}
    __device__ __forceinline__ void end(int) {}
    __device__ __forceinline__ void oct(int row, int pn, int c, f32x4 v0, f32x4 v1) {
        if (pn == 44) { float* d = (float*)(ws + WS_SM) + (size_t)row * 256 + c; *(f32x4*)d = v0; *(f32x4*)(d + 4) = v1; return; }
        bf16_t* base; int ld, col;
        if (pn < 8) { base = (bf16_t*)(ws + WS_Z); ld = 2048; col = pn * 256 + c; }
        else if (pn < 20) { base = (bf16_t*)(ws + WS_XBC); ld = 3072; col = (pn - 8) * 256 + c; }
        else if (pn < 44) {
            base = (bf16_t*)(ws + (pn < 28 ? WS_R : (pn < 36 ? WS_K : WS_V))); const int cs = ((pn - 20) & 7) * 256 + c, hd = cs >> 6;
            *(u32x4*)(base + ((size_t)((row / SEQ) * 32 + hd) * SEQ + (row % SEQ)) * 64 + (cs & 63)) = pack8(v0, v1); return; }
        else { base = (bf16_t*)(ws + WS_GD); ld = 256; col = c; }
        *(u32x4*)(base + (size_t)row * ld + col) = pack8(v0, v1);
    }
};
struct EpiOut {
    static constexpr bool PAIR = false;
    const float* x; bf16_t* h1b; float* rowss; float s;
    __device__ __forceinline__ void begin() { s = 0.f; }
    __device__ __forceinline__ void oct(int row, int pn, int c, f32x4 v0, f32x4 v1) {
        const size_t off = (size_t)row * DM + pn * 256 + c;
        const f32x4 a = *(const f32x4*)(x + off) + v0, b = *(const f32x4*)(x + off + 4) + v1;
        *(u32x4*)(h1b + off) = pack8(a, b);
        s += sumsq4(a) + sumsq4(b);
    }
    __device__ __forceinline__ void end(int row) { float t = s; t += __shfl_xor(t, 16); t += __shfl_xor(t, 32); if ((otid() & 63) < 16) atomicAdd(rowss + row, t); }
};
struct EpiGU {
    static constexpr bool PAIR = true;
    const float* rowss; bf16_t* act;
    __device__ __forceinline__ void begin() {}
    __device__ __forceinline__ void end(int) {}
    __device__ __forceinline__ void pair8(int row, int pn, int c, f32x4 g0, f32x4 g1, f32x4 u0, f32x4 u1) {
        const float rs = __builtin_amdgcn_rsqf(rowss[row] * (1.f / DM) + RMS_EPS);
        g0 = g0 * rs; g1 = g1 * rs; u0 = u0 * rs; u1 = u1 * rs;
        f32x4 a, b;
        a.x = siluf_(g0.x) * u0.x; a.y = siluf_(g0.y) * u0.y; a.z = siluf_(g0.z) * u0.z; a.w = siluf_(g0.w) * u0.w;
        b.x = siluf_(g1.x) * u1.x; b.y = siluf_(g1.y) * u1.y; b.z = siluf_(g1.z) * u1.z; b.w = siluf_(g1.w) * u1.w;
        *(u32x4*)(act + (size_t)row * D_FF + pn * 128 + c) = pack8(a, b);
    }
};
struct EpiDown {
    static constexpr bool PAIR = false;
    const bf16_t* h1b; bf16_t* h2b; float* rowss; float s;
    __device__ __forceinline__ void begin() { s = 0.f; }
    __device__ __forceinline__ void oct(int row, int pn, int c, f32x4 v0, f32x4 v1) {
        const size_t off = (size_t)row * DM + pn * 256 + c;
        const u32x4 hw = *(const u32x4*)(h1b + off);
        const f32x4 a = up4((u32x2){hw.x, hw.y}) + v0, b = up4((u32x2){hw.z, hw.w}) + v1;
        *(u32x4*)(h2b + off) = pack8(a, b);
        s += sumsq4(a) + sumsq4(b);
    }
    __device__ __forceinline__ void end(int row) { float t = s; t += __shfl_xor(t, 16); t += __shfl_xor(t, 32); if ((otid() & 63) < 16) atomicAdd(rowss + row, t); }
};
template <class F> __device__ __forceinline__ void run_gemm(LAS unsigned char* lds, const bf16_t* A, const bf16_t* Bt, int Mr, int N, int K, const F& f) {
    pg8::Gemm g{A, Bt, Mr, N, K}; pg8::StaticOrder S; S.init(Mr, N, (int)gridDim.x, (int)blockIdx.x);
    pg8::EpiAdapt<F> E{f};
    pg8::gemm_phase<pg8::EpiAdapt<F>, pg8::StaticOrder, true, true>(lds, g, S, E);
}

constexpr int SSD_XT = 0;
constexpr int SSD_B = 73728;
constexpr int SSD_C = SSD_B + 18432;
constexpr int SSD_CB = SSD_C + 17408;
constexpr int SSD_ACS = SSD_CB + 17408;
constexpr int SSD_DT = SSD_ACS + 2048;
constexpr int SSD_PART = SSD_DT + 2048;
constexpr size_t WS_CD = 128 * 1024;
__device__ __forceinline__ void unpack8(u32x4 w, float (&f)[8]) {
    f[0] = __builtin_bit_cast(float, w.x << 16); f[1] = __builtin_bit_cast(float, w.x & 0xffff0000u); f[2] = __builtin_bit_cast(float, w.y << 16); f[3] = __builtin_bit_cast(float, w.y & 0xffff0000u);
    f[4] = __builtin_bit_cast(float, w.z << 16); f[5] = __builtin_bit_cast(float, w.z & 0xffff0000u); f[6] = __builtin_bit_cast(float, w.w << 16); f[7] = __builtin_bit_cast(float, w.w & 0xffff0000u);
}
template <bool WITH_C, bool B_TR>
__device__ __forceinline__ void ssd_stage(const Params& p, LAS unsigned char* lds, int b, int c, int g) {
    const int tid = otid(); constexpr int NCG = WITH_C ? 96 : 80;
    if (tid < NCG * 4) {
        const int cg = tid >> 2, seg = tid & 3;
        const int kind = cg < 64 ? 0 : (cg < 80 ? 1 : 2);
        const int col0 = kind == 0 ? 512 * g + 8 * cg : (kind == 1 ? 2048 + 128 * g + 8 * (cg - 64) : 2560 + 128 * g + 8 * (cg - 80));
        const float* cw = p.in[I_CONVW] + col0; const float* cb = p.in[I_CONVB] + col0;
        float w0[8], w1[8], w2[8], w3[8], bs[8];
#pragma unroll
        for (int i = 0; i < 8; ++i) { w0[i] = cw[i]; w1[i] = cw[D_XBC + i]; w2[i] = cw[2 * D_XBC + i]; w3[i] = cw[3 * D_XBC + i]; bs[i] = cb[i]; }
        const int tb = 64 * c + 16 * seg;
        const bf16_t* src = (const bf16_t*)(p.ws + WS_XBC) + ((size_t)b * SEQ + tb) * D_XBC + col0;
        const u32x4 zz = {0u, 0u, 0u, 0u};
        u32x4 rows[19];
        rows[0] = tb >= 3 ? *(const u32x4*)(src - 3 * D_XBC) : zz; rows[1] = tb >= 2 ? *(const u32x4*)(src - 2 * D_XBC) : zz; rows[2] = tb >= 1 ? *(const u32x4*)(src - 1 * D_XBC) : zz;
#pragma unroll
        for (int tt = 0; tt < 16; ++tt) rows[3 + tt] = *(const u32x4*)(src + (size_t)tt * D_XBC);
        float u1[8], u2[8], u3[8];
        unpack8(rows[0], u3); unpack8(rows[1], u2); unpack8(rows[2], u1);
#pragma unroll
        for (int hb = 0; hb < 2; ++hb) {
            float y[8][8];
#pragma unroll
            for (int tt = 0; tt < 8; ++tt) {
                float u0[8]; unpack8(rows[3 + 8 * hb + tt], u0);
#pragma unroll
                for (int i = 0; i < 8; ++i) { const float a = w0[i] * u3[i] + w1[i] * u2[i] + w2[i] * u1[i] + w3[i] * u0[i] + bs[i]; y[tt][i] = a * __builtin_amdgcn_rcpf(1.f + __expf(-a)); u3[i] = u2[i]; u2[i] = u1[i]; u1[i] = u0[i]; }
            }
            const bool tr = (kind == 0) || (kind == 1 && B_TR);
            if (tr) {
                LAS unsigned char* img = lds + (kind == 0 ? SSD_XT : SSD_B);
                const int r0 = kind == 0 ? 8 * cg : 8 * (cg - 64);
#pragma unroll
                for (int i = 0; i < 8; ++i) { u32x4 w; w.x = pg8::cvt_pk_bf16(y[0][i], y[1][i]); w.y = pg8::cvt_pk_bf16(y[2][i], y[3][i]); w.z = pg8::cvt_pk_bf16(y[4][i], y[5][i]); w.w = pg8::cvt_pk_bf16(y[6][i], y[7][i]);
                    *(LAS u32x4*)(img + ((r0 + i) * 72 + 16 * seg + 8 * hb) * 2) = w; }
            } else {
                LAS unsigned char* img = lds + (kind == 1 ? SSD_B : SSD_C);
                const int c0 = kind == 1 ? 8 * (cg - 64) : 8 * (cg - 80);
#pragma unroll
                for (int tt = 0; tt < 8; ++tt) { u32x4 w; w.x = pg8::cvt_pk_bf16(y[tt][0], y[tt][1]); w.y = pg8::cvt_pk_bf16(y[tt][2], y[tt][3]); w.z = pg8::cvt_pk_bf16(y[tt][4], y[tt][5]); w.w = pg8::cvt_pk_bf16(y[tt][6], y[tt][7]);
                    *(LAS u32x4*)(img + ((16 * seg + 8 * hb + tt) * 136 + c0) * 2) = w; }
            }
        }
    }
}
__device__ __forceinline__ void ssd_dt(const Params& p, LAS unsigned char* lds, int b, int c, int g) {
    const int lane = otid() & 63, e = otid() >> 6, eg = 8 * g + e;
    const float* SM = (const float*)(p.ws + WS_SM);
    const float dt = softplusf_(SM[((size_t)b * SEQ + 64 * c + lane) * 256 + eg] + p.in[I_DTB][eg]);
    float a = dt * -__expf(p.in[I_ALOG][eg]);
#pragma unroll
    for (int o = 1; o < 64; o <<= 1) { const float t = __shfl_up(a, o); if (lane >= o) a += t; }
    ((LAS float*)(lds + SSD_ACS))[lane * 8 + e] = a; ((LAS float*)(lds + SSD_DT))[lane * 8 + e] = dt;
}
__device__ void phase_ssd1(const Params& p, LAS unsigned char* lds, int wg, int nwg) {
    const int tid = otid(), lane = tid & 63, e = tid >> 6, fr = lane & 15, fq = lane >> 4;
    bf16_t* S = (bf16_t*)p.out; float* CD = (float*)(p.ws + WS_CTL + WS_CD);
    for (int unit = wg; unit < BATCH * 128 * NGRP; unit += nwg) {
        const int g = unit & 3, c = (unit >> 2) & 127, b = unit >> 9, eg = 8 * g + e;
        __syncthreads();
        ssd_stage<false, true>(p, lds, b, c, g);
        ssd_dt(p, lds, b, c, g);
        __syncthreads();
        LAS const float* ACS = (LAS const float*)(lds + SSD_ACS); LAS const float* DT = (LAS const float*)(lds + SSD_DT);
        const float alast = ACS[63 * 8 + e];
        f32x4 acc[8][4];
#pragma unroll
        for (int nt = 0; nt < 8; ++nt)
#pragma unroll
            for (int pt = 0; pt < 4; ++pt) acc[nt][pt] = (f32x4){0.f, 0.f, 0.f, 0.f};
#pragma unroll
        for (int ks = 0; ks < 2; ++ks) {
            float wl[8];
#pragma unroll
            for (int j = 0; j < 8; ++j) { const int s = 32 * ks + 8 * fq + j; wl[j] = DT[s * 8 + e] * __expf(alast - ACS[s * 8 + e]); }
            bf16x8 xb[4];
#pragma unroll
            for (int pt = 0; pt < 4; ++pt) {
                float f[8]; unpack8(*(LAS const u32x4*)(lds + SSD_XT + ((64 * e + 16 * pt + fr) * 72 + 32 * ks + 8 * fq) * 2), f);
                u32x4 w; w.x = pg8::cvt_pk_bf16(f[0] * wl[0], f[1] * wl[1]); w.y = pg8::cvt_pk_bf16(f[2] * wl[2], f[3] * wl[3]); w.z = pg8::cvt_pk_bf16(f[4] * wl[4], f[5] * wl[5]); w.w = pg8::cvt_pk_bf16(f[6] * wl[6], f[7] * wl[7]);
                xb[pt] = __builtin_bit_cast(bf16x8, w);
            }
#pragma unroll
            for (int nt = 0; nt < 8; ++nt) {
                const bf16x8 bt = *(LAS const bf16x8*)(lds + SSD_B + ((16 * nt + fr) * 72 + 32 * ks + 8 * fq) * 2);
#pragma unroll
                for (int pt = 0; pt < 4; ++pt) acc[nt][pt] = __builtin_amdgcn_mfma_f32_16x16x32_bf16(bt, xb[pt], acc[nt][pt], 0, 0, 0);
            }
        }
        bf16_t* sb = S + ((((size_t)b * 128 + c) * 32 + eg) * 64) * 128;
#pragma unroll
        for (int pt = 0; pt < 4; ++pt)
#pragma unroll
            for (int nt = 0; nt < 8; ++nt) { u32x2 w; w.x = pg8::cvt_pk_bf16_c(acc[nt][pt].x, acc[nt][pt].y); w.y = pg8::cvt_pk_bf16_c(acc[nt][pt].z, acc[nt][pt].w); *(u32x2*)(sb + (size_t)(16 * pt + fr) * 128 + 16 * nt + 4 * fq) = w; }
        if (lane == 0) CD[(b * 128 + c) * 32 + eg] = __expf(alast);
    }
}
__device__ void phase_ssd2(const Params& p, int wg, int nwg) {
    bf16_t* S = (bf16_t*)p.out; const float* CD = (const float*)(p.ws + WS_CTL + WS_CD);
    for (int idx = wg * 512 + otid(); idx < BATCH * 32 * 64 * 32; idx += nwg * 512) {
        const int n4 = idx & 31, pp = (idx >> 5) & 63, eg = (idx >> 11) & 31, b = idx >> 16;
        bf16_t* base = S + ((((size_t)b * 128) * 32 + eg) * 64 + pp) * 128 + 4 * n4;
        const float* cd = CD + (b * 128) * 32 + eg;
        f32x4 h = {0.f, 0.f, 0.f, 0.f};
#pragma unroll 16
        for (int c = 0; c < 128; ++c) {
            bf16_t* q = base + (size_t)c * (32 * 64 * 128);
            const f32x4 s = ld4bf(q); const float d = cd[c * 32];
            u32x2 w; w.x = pg8::cvt_pk_bf16(h.x, h.y); w.y = pg8::cvt_pk_bf16(h.z, h.w); *(u32x2*)q = w;
            h = h * d + s;
        }
    }
}
__device__ void phase_ssd3(const Params& p, bf16_t* ymix, LAS unsigned char* lds, int wg, int nwg) {
    const int tid = otid(), lane = tid & 63, e = tid >> 6, fr = lane & 15, fq = lane >> 4;
    const bf16_t* S = (const bf16_t*)p.out; const bf16_t* Z = (const bf16_t*)(p.ws + WS_Z);
    for (int unit = wg; unit < BATCH * 128 * NGRP; unit += nwg) {
        const int g = unit & 3, c = (unit >> 2) & 127, b = unit >> 9, eg = 8 * g + e;
        const size_t m0 = (size_t)b * SEQ + 64 * c;
        __syncthreads();
        ssd_stage<true, false>(p, lds, b, c, g);
        ssd_dt(p, lds, b, c, g);
        const bf16_t* hb = S + ((((size_t)b * 128 + c) * 32 + eg) * 64) * 128;
        bf16x8 hfa[4][4];
#pragma unroll
        for (int ks = 0; ks < 4; ++ks)
#pragma unroll
            for (int pt = 0; pt < 4; ++pt) hfa[ks][pt] = *(const bf16x8*)(hb + (size_t)(16 * pt + fr) * 128 + 32 * ks + 8 * fq);
        __syncthreads();
        {
            const int st = e >> 1;
            f32x4 cbacc[2] = {(f32x4){0.f, 0.f, 0.f, 0.f}, (f32x4){0.f, 0.f, 0.f, 0.f}};
#pragma unroll
            for (int ks = 0; ks < 4; ++ks) {
                const bf16x8 bfr = *(LAS const bf16x8*)(lds + SSD_B + ((16 * st + fr) * 136 + 32 * ks + 8 * fq) * 2);
#pragma unroll
                for (int j = 0; j < 2; ++j) { const int lt = 2 * (e & 1) + j; const bf16x8 cfr = *(LAS const bf16x8*)(lds + SSD_C + ((16 * lt + fr) * 136 + 32 * ks + 8 * fq) * 2); cbacc[j] = __builtin_amdgcn_mfma_f32_16x16x32_bf16(bfr, cfr, cbacc[j], 0, 0, 0); }
            }
#pragma unroll
            for (int j = 0; j < 2; ++j) { const int lt = 2 * (e & 1) + j; *(LAS f32x4*)(lds + SSD_CB + ((16 * lt + fr) * 68 + 16 * st + 4 * fq) * 4) = cbacc[j]; }
        }
        __syncthreads();
        LAS const float* ACS = (LAS const float*)(lds + SSD_ACS); LAS const float* DT = (LAS const float*)(lds + SSD_DT);
        const float Dsk = p.in[I_SSDD][eg];
        f32x4 acc[4][4];
#pragma unroll
        for (int pt = 0; pt < 4; ++pt)
#pragma unroll
            for (int lt = 0; lt < 4; ++lt) acc[pt][lt] = (f32x4){0.f, 0.f, 0.f, 0.f};
#pragma unroll
        for (int ks = 0; ks < 4; ++ks) {
            bf16x8 hf[4], cf[4];
#pragma unroll
            for (int pt = 0; pt < 4; ++pt) hf[pt] = hfa[ks][pt];
#pragma unroll
            for (int lt = 0; lt < 4; ++lt) cf[lt] = *(LAS const bf16x8*)(lds + SSD_C + ((16 * lt + fr) * 136 + 32 * ks + 8 * fq) * 2);
#pragma unroll
            for (int pt = 0; pt < 4; ++pt)
#pragma unroll
                for (int lt = 0; lt < 4; ++lt) acc[pt][lt] = __builtin_amdgcn_mfma_f32_16x16x32_bf16(hf[pt], cf[lt], acc[pt][lt], 0, 0, 0);
        }
        u32x2 zr[4][4];
#pragma unroll
        for (int lt = 0; lt < 4; ++lt)
#pragma unroll
            for (int pt = 0; pt < 4; ++pt) zr[lt][pt] = *(const u32x2*)(Z + (m0 + 16 * lt + fr) * D_SSD + 64 * eg + 16 * pt + 4 * fq);
        float acl[4];
#pragma unroll
        for (int lt = 0; lt < 4; ++lt) { acl[lt] = ACS[(16 * lt + fr) * 8 + e]; const float sc = __expf(acl[lt]);
#pragma unroll
            for (int pt = 0; pt < 4; ++pt) acc[pt][lt] = acc[pt][lt] * sc; }
#pragma unroll
        for (int ks = 0; ks < 2; ++ks) {
            float as_[8], ds_[8];
#pragma unroll
            for (int j = 0; j < 8; ++j) { const int s = 32 * ks + 8 * fq + j; as_[j] = ACS[s * 8 + e]; ds_[j] = DT[s * 8 + e]; }
            bf16x8 xa[4];
#pragma unroll
            for (int pt = 0; pt < 4; ++pt) xa[pt] = *(LAS const bf16x8*)(lds + SSD_XT + ((64 * e + 16 * pt + fr) * 72 + 32 * ks + 8 * fq) * 2);
#pragma unroll
            for (int lt = 0; lt < 4; ++lt) {
                if (32 * ks > 16 * lt + 15) continue;
                const int l = 16 * lt + fr;
                const f32x4 c0 = *(LAS const f32x4*)(lds + SSD_CB + (l * 68 + 32 * ks + 8 * fq) * 4), c1 = *(LAS const f32x4*)(lds + SSD_CB + (l * 68 + 32 * ks + 8 * fq + 4) * 4);
                float mv[8];
#pragma unroll
                for (int j = 0; j < 8; ++j) { const int s = 32 * ks + 8 * fq + j; const float cbv = j < 4 ? c0[j] : c1[j - 4];
                    float v = cbv * __expf(fminf(acl[lt] - as_[j], 0.f)) * ds_[j]; v = (s <= l) ? v : 0.f; mv[j] = (s == l) ? v + Dsk : v; }
                u32x4 w; w.x = pg8::cvt_pk_bf16(mv[0], mv[1]); w.y = pg8::cvt_pk_bf16(mv[2], mv[3]); w.z = pg8::cvt_pk_bf16(mv[4], mv[5]); w.w = pg8::cvt_pk_bf16(mv[6], mv[7]);
                const bf16x8 mf = __builtin_bit_cast(bf16x8, w);
#pragma unroll
                for (int pt = 0; pt < 4; ++pt) acc[pt][lt] = __builtin_amdgcn_mfma_f32_16x16x32_bf16(xa[pt], mf, acc[pt][lt], 0, 0, 0);
            }
        }
        float ssq[4];
#pragma unroll
        for (int lt = 0; lt < 4; ++lt) {
            float s = 0.f;
#pragma unroll
            for (int pt = 0; pt < 4; ++pt) {
                const f32x4 z = up4(zr[lt][pt]);
                f32x4 y = acc[pt][lt];
                y.x *= siluf_(z.x); y.y *= siluf_(z.y); y.z *= siluf_(z.z); y.w *= siluf_(z.w);
                acc[pt][lt] = y; s += (y.x * y.x + y.y * y.y) + (y.z * y.z + y.w * y.w);
            }
            s += __shfl_xor(s, 16); s += __shfl_xor(s, 32); ssq[lt] = s;
            if (fq == 0) ((LAS float*)(lds + SSD_PART))[e * 64 + 16 * lt + fr] = s;
        }
        __syncthreads();
#pragma unroll
        for (int lt = 0; lt < 4; ++lt) {
            float tot = 0.f;
#pragma unroll
            for (int w = 0; w < 8; ++w) tot += ((LAS const float*)(lds + SSD_PART))[w * 64 + 16 * lt + fr];
            const float rstd = 1.f / sqrtf(tot * (1.f / 512.f) + GATED_EPS);
#pragma unroll
            for (int pt = 0; pt < 4; ++pt) {
                const int col = 64 * eg + 16 * pt + 4 * fq;
                const f32x4 ng = *(const f32x4*)(p.in[I_SSDNG] + col);
                const f32x4 o = acc[pt][lt] * rstd * ng;
                u32x2 w; w.x = pg8::cvt_pk_bf16(o.x, o.y); w.y = pg8::cvt_pk_bf16(o.z, o.w);
                *(u32x2*)(ymix + (m0 + 16 * lt + fr) * D_MIX + col) = w;
            }
        }
    }
}

constexpr size_t WS_AW = 1 * MiB;
constexpr size_t WS_AA = 5 * MiB;
constexpr size_t WS_AG = 504 * MiB;
constexpr size_t WS_BON = WS_GD;
constexpr size_t WS_YRAW = WS_FREE;
__device__ void phase_rwkv_pre(const Params& p, int wg, int nwg) {
    const int tid = otid(), lane = tid & 63, wave = tid >> 6;
    const float* SM = (const float*)(p.ws + WS_SM); const bf16_t* GD = (const bf16_t*)(p.ws + WS_GD); const float* mu = p.in[I_MU];
    bf16_t* AW = (bf16_t*)(p.ws + WS_AW); bf16_t* AA = (bf16_t*)(p.ws + WS_AA); bf16_t* AG = (bf16_t*)(p.ws + WS_AG);
#pragma unroll 4
    for (int m = wg * 8 + wave; m < M; m += nwg * 8) {
        const bool hp = (m % SEQ) > 0;
#pragma unroll
        for (int i = 0; i < 2; ++i) {
            const int j = lane + 64 * i;
            float vw = 0.f, va = 0.f;
            if (j < 96) {
                { const float cur = SM[(size_t)m * 256 + 32 + j], prev = hp ? SM[(size_t)(m - 1) * 256 + 32 + j] : 0.f; vw = tanhf(cur + (prev - cur) * mu[MU_WD + j]); }
                { const float cur = SM[(size_t)m * 256 + 128 + j], prev = hp ? SM[(size_t)(m - 1) * 256 + 128 + j] : 0.f; va = cur + (prev - cur) * mu[MU_AD + j]; }
            }
            AW[(size_t)m * 128 + j] = (bf16_t)f2bf(vw); AA[(size_t)m * 128 + j] = (bf16_t)f2bf(va);
        }
#pragma unroll
        for (int i = 0; i < 4; ++i) {
            const int j = lane + 64 * i;
            const float cur = bf2f(GD[(size_t)m * 256 + j]), prev = hp ? bf2f(GD[(size_t)(m - 1) * 256 + j]) : 0.f;
            AG[(size_t)m * 256 + j] = (bf16_t)f2bf(sigmoidf_(cur + (prev - cur) * mu[MU_GD + j]));
        }
    }
}

__device__ __forceinline__ float afma(float a, float b, float c) { float d; asm("v_fma_f32 %0, %1, %2, %3" : "=v"(d) : "v"(a), "v"(b), "v"(c)); return d; }
__device__ __forceinline__ float amul(float a, float b) { float d; asm("v_mul_f32 %0, %1, %2" : "=v"(d) : "v"(a), "v"(b)); return d; }
#define LDS_BARRIER() do { asm volatile("s_waitcnt lgkmcnt(0)" ::: "memory"); __builtin_amdgcn_s_barrier(); asm volatile("" ::: "memory"); } while (0)
template <int CTRL> __device__ __forceinline__ float dpp_f(float x) { return __builtin_bit_cast(float, __builtin_amdgcn_update_dpp(0, __builtin_bit_cast(int, x), CTRL, 0xf, 0xf, true)); }
__device__ __forceinline__ float red16(float x) { x += dpp_f<0xB1>(x); x += dpp_f<0x4E>(x); x += dpp_f<0x124>(x); x += dpp_f<0x128>(x); return x; }

constexpr int R2_T = 32, R2_RING = 5 * 8192 + 2304 + 256, R2_W2H = 2 * R2_RING + 4096 + 2048;
__device__ void phase_rwkv_scan(const Params& p, LAS unsigned char* lds, int wg, int nwg) {
    constexpr int T = R2_T, NCH = SEQ / T;
    const int tid = otid(), lane = tid & 63, wave = __builtin_amdgcn_readfirstlane(tid >> 6);
    LAS float* cst = (LAS float*)(lds + 2 * R2_RING + 4096);
    const bf16_t* R = (const bf16_t*)(p.ws + WS_R); const bf16_t* Kb = (const bf16_t*)(p.ws + WS_K); const bf16_t* V = (const bf16_t*)(p.ws + WS_V);
    const bf16_t* AW = (const bf16_t*)(p.ws + WS_AW); const bf16_t* AA = (const bf16_t*)(p.ws + WS_AA);
    float* BON = (float*)(p.ws + WS_BON); bf16_t* YRAW = (bf16_t*)(p.ws + WS_YRAW);
    for (int unit = wg; unit < 256; unit += nwg) {
        const int xcd = unit & 7, idx = unit >> 3, q = idx & 3, bh = xcd * 8 + (idx >> 2), b = bh >> 5, h = bh & 31;
        __syncthreads();
        { const int arr = tid >> 6, ch = tid & 63; const float* srcs[8] = {p.in[I_W0], p.in[I_A0], p.in[I_KK], p.in[I_KA], p.in[I_RK], p.in[I_MU] + MU_R, p.in[I_MU] + MU_K, p.in[I_MU] + MU_V};
          float v = 0.f;
#pragma unroll
          for (int a = 0; a < 8; ++a) if (arr == a) v = srcs[a][h * 64 + ch];
          cst[arr * 64 + ch] = v; }
        {
            LAS bf16_t* w2h = (LAS bf16_t*)(lds + R2_W2H); LAS bf16_t* a2h = (LAS bf16_t*)(lds + R2_W2H + 17408);
            for (int i = tid; i < 128 * 64; i += 512) { const int k = i >> 6, ch = i & 63; float w2v = 0.f, a2v = 0.f;
                if (k < 96) { w2v = p.in[I_W2][(size_t)k * D_RWKV + h * 64 + ch]; a2v = p.in[I_A2][(size_t)k * D_RWKV + h * 64 + ch]; }
                w2h[ch * 136 + k] = (bf16_t)f2bf(w2v); a2h[ch * 136 + k] = (bf16_t)f2bf(a2v); }
        }
        __syncthreads();
        if (wave >= 4) {
            const int pw = wave - 4, mt = pw & 1, half = pw >> 1, fr = lane & 15, fq = lane >> 4;
            bf16x8 nAW[4], nAA[4]; u32x2 nR[2][2], nK[2][2], nV[2];
            const int vnt = q - 2 * half;
            const auto rsAW = __builtin_amdgcn_make_buffer_rsrc((void*)AW, 0, (int)(M * 128 * 2), 0x00020000), rsAA = __builtin_amdgcn_make_buffer_rsrc((void*)AA, 0, (int)(M * 128 * 2), 0x00020000);
            const auto rsR = __builtin_amdgcn_make_buffer_rsrc((void*)R, 0, (int)(M * 2048 * 2), 0x00020000), rsK = __builtin_amdgcn_make_buffer_rsrc((void*)Kb, 0, (int)(M * 2048 * 2), 0x00020000), rsV = __builtin_amdgcn_make_buffer_rsrc((void*)V, 0, (int)(M * 2048 * 2), 0x00020000);
            const int voA = ((16 * mt + fr) * 128 + 8 * fq) * 2, voR = ((16 * mt + fr) * 2048 + h * 64 + 32 * half + 4 * fq) * 2;
#define R2_PREFETCH(cc) do { const int row0_ = b * SEQ + T * (cc); const bool hp_ = (T * (cc) + 16 * mt + fr) > 0; const int soA_ = row0_ * 256, soR_ = row0_ * 4096, soP_ = row0_ > 0 ? (row0_ - 1) * 4096 : 0, vaP_ = row0_ > 0 ? 0 : -4096;     \
                _Pragma("unroll") for (int ks = 0; ks < 4; ++ks) { nAW[ks] = __builtin_bit_cast(bf16x8, __builtin_amdgcn_raw_buffer_load_b128(rsAW, voA + 64 * ks, soA_, 0)); nAA[ks] = __builtin_bit_cast(bf16x8, __builtin_amdgcn_raw_buffer_load_b128(rsAA, voA + 64 * ks, soA_, 0)); } \
                _Pragma("unroll") for (int nt = 0; nt < 2; ++nt) { \
                    nR[nt][0] = __builtin_bit_cast(u32x2, __builtin_amdgcn_raw_buffer_load_b64(rsR, voR + 32 * nt, soR_, 0)); nK[nt][0] = __builtin_bit_cast(u32x2, __builtin_amdgcn_raw_buffer_load_b64(rsK, voR + 32 * nt, soR_, 0)); nR[nt][1] = (u32x2){0u, 0u}; nK[nt][1] = (u32x2){0u, 0u}; \
                    if (hp_) { nR[nt][1] = __builtin_bit_cast(u32x2, __builtin_amdgcn_raw_buffer_load_b64(rsR, voR + 32 * nt + vaP_, soP_, 0)); nK[nt][1] = __builtin_bit_cast(u32x2, __builtin_amdgcn_raw_buffer_load_b64(rsK, voR + 32 * nt + vaP_, soP_, 0)); } \
                    if (nt == vnt) { nV[0] = __builtin_bit_cast(u32x2, __builtin_amdgcn_raw_buffer_load_b64(rsV, voR + 32 * nt, soR_, 0)); nV[1] = (u32x2){0u, 0u}; if (hp_) nV[1] = __builtin_bit_cast(u32x2, __builtin_amdgcn_raw_buffer_load_b64(rsV, voR + 32 * nt + vaP_, soP_, 0)); } } } while (0)
            R2_PREFETCH(0);
            unsigned long long pacc = 0;
            for (int c = 0; c <= NCH + 1; ++c) {
                unsigned long long tq0 = 0; if (PROBE_PH == 12 && blockIdx.x == 0 && pw == 0) tq0 = __builtin_amdgcn_s_memrealtime();
                if (c >= 2 && pw == 0) {
                    LAS const float* yo = (LAS const float*)(lds + 2 * R2_RING + ((c - 2) & 1) * 2048);
                    const int tok = lane >> 1, hf = lane & 1;
                    const f32x4 y0 = *(LAS const f32x4*)(yo + tok * 16 + 8 * hf), y1 = *(LAS const f32x4*)(yo + tok * 16 + 8 * hf + 4);
                    *(u32x4*)(YRAW + ((size_t)b * SEQ + (size_t)T * (c - 2) + tok) * D_RWKV + h * 64 + 16 * q + 8 * hf) = pack8(y0, y1);
                }
                if (c < NCH) {
                    LAS float* rg = (LAS float*)(lds + (c & 1) * R2_RING);
                    LAS float* r_an = rg; LAS float* r_ww = rg + 2048; LAS float* r_bb = rg + 4096; LAS float* r_kp = rg + 6144; LAS float* r_rr = rg + 8192; LAS float* r_vv = rg + 10240; LAS float* r_ss = rg + 10240 + 576;
                    const int tok = 16 * mt + fr; const size_t m = (size_t)b * SEQ + T * c + tok;
                    f32x4 accw[2], acca[2];
#pragma unroll
                    for (int nt = 0; nt < 2; ++nt) { accw[nt] = (f32x4){0.f, 0.f, 0.f, 0.f}; acca[nt] = (f32x4){0.f, 0.f, 0.f, 0.f}; }
#pragma unroll
                    for (int ks = 0; ks < 4; ++ks)
#pragma unroll
                        for (int nt = 0; nt < 2; ++nt) { const int bo = R2_W2H + ((32 * half + 16 * nt + fr) * 136 + 32 * ks + 8 * fq) * 2;
                            accw[nt] = __builtin_amdgcn_mfma_f32_16x16x32_bf16(*(LAS const bf16x8*)(lds + bo), nAW[ks], accw[nt], 0, 0, 0); acca[nt] = __builtin_amdgcn_mfma_f32_16x16x32_bf16(*(LAS const bf16x8*)(lds + bo + 17408), nAA[ks], acca[nt], 0, 0, 0); }
                    f32x4 rc_[2], rp_[2], kc_[2], kq_[2];
#pragma unroll
                    for (int nt = 0; nt < 2; ++nt) { rc_[nt] = up4(nR[nt][0]); rp_[nt] = up4(nR[nt][1]); kc_[nt] = up4(nK[nt][0]); kq_[nt] = up4(nK[nt][1]); }
                    const f32x4 vc_ = up4(nV[0]), vp_ = up4(nV[1]);
                    asm volatile("" : "+v"(accw[0]), "+v"(accw[1]), "+v"(acca[0]), "+v"(acca[1]));
                    if (c + 1 < NCH) R2_PREFETCH(c + 1);
                    float ssp = 0.f, bop = 0.f;
#pragma unroll
                    for (int nt = 0; nt < 2; ++nt) {
                        const int ch0 = 32 * half + 16 * nt + 4 * fq;
                        const f32x4 w0 = *(LAS const f32x4*)(cst + 0 * 64 + ch0), a0 = *(LAS const f32x4*)(cst + 1 * 64 + ch0), kkc = *(LAS const f32x4*)(cst + 2 * 64 + ch0), kac = *(LAS const f32x4*)(cst + 3 * 64 + ch0),
                                    rkc = *(LAS const f32x4*)(cst + 4 * 64 + ch0), mur = *(LAS const f32x4*)(cst + 5 * 64 + ch0), muk = *(LAS const f32x4*)(cst + 6 * 64 + ch0);
                        const f32x4 r4 = rc_[nt] + (rp_[nt] - rc_[nt]) * mur, k4 = kc_[nt] + (kq_[nt] - kc_[nt]) * muk;
                        f32x4 wv, ag;
#pragma unroll
                        for (int i = 0; i < 4; ++i) { const float sg = __builtin_amdgcn_rcpf(1.f + __expf(-(w0[i] + accw[nt][i]))); wv[i] = __expf(-0.60653066f * sg); ag[i] = __builtin_amdgcn_rcpf(1.f + __expf(-(a0[i] + acca[nt][i]))); }
                        const f32x4 kk = k4 * kkc, kp4 = k4 * (1.f + (ag - 1.f) * kac), b4 = kk * ag;
                        ssp += (kk.x * kk.x + kk.y * kk.y) + (kk.z * kk.z + kk.w * kk.w);
                        const f32x4 bo4 = r4 * kp4 * rkc; bop += (bo4.x + bo4.y) + (bo4.z + bo4.w);
                        const int so = tok * 64 + (ch0 ^ ((tok & 7) << 2));
                        *(LAS f32x4*)(r_an + so) = kk; *(LAS f32x4*)(r_ww + so) = wv; *(LAS f32x4*)(r_bb + so) = b4; *(LAS f32x4*)(r_kp + so) = kp4; *(LAS f32x4*)(r_rr + so) = r4;
                        if (nt == vnt) {
                            const f32x4 muv = *(LAS const f32x4*)(cst + 7 * 64 + ch0);
                            const f32x4 vv4 = vc_ + (vp_ - vc_) * muv;
                            r_vv[(4 * fq + 0) * 36 + tok] = vv4.x; r_vv[(4 * fq + 1) * 36 + tok] = vv4.y; r_vv[(4 * fq + 2) * 36 + tok] = vv4.z; r_vv[(4 * fq + 3) * 36 + tok] = vv4.w;
                        }
                    }
                    ssp += __shfl_xor(ssp, 16); ssp += __shfl_xor(ssp, 32); bop += __shfl_xor(bop, 16); bop += __shfl_xor(bop, 32);
                    if (fq == 0) { r_ss[tok * 2 + half] = ssp; if (q == 0) BON[(m * 32 + h) * 2 + half] = bop; }
                }
                if (PROBE_PH == 12 && blockIdx.x == 0 && pw == 0) { asm volatile("s_waitcnt lgkmcnt(0)" ::: "memory"); pacc += __builtin_amdgcn_s_memrealtime() - tq0; }
                if (c <= NCH) LDS_BARRIER();
            }
            if (PROBE_PH == 12 && blockIdx.x == 0 && pw == 0 && lane == 0) *(LAS unsigned long long*)(lds + 163840 - 16) = pacc;
#undef R2_PREFETCH
        } else {
            __builtin_amdgcn_s_setprio(2);
            const int cw = wave, g = lane >> 4, l16 = lane & 15, row = 4 * cw + g;
            float S0 = 0.f, S1 = 0.f, S2 = 0.f, S3 = 0.f;
            float yrot = 0.f;
            unsigned long long pacc = 0;
            LDS_BARRIER();
            for (int c = 0; c < NCH; ++c) {
                LAS const float* rg = (LAS const float*)(lds + (c & 1) * R2_RING);
                LAS const float* r_vv = rg + 10240 + row * 36; LAS const float* r_ss = rg + 10240 + 576;
                LAS float* yo = (LAS float*)(lds + 2 * R2_RING + (c & 1) * 2048) + row + (15 - l16) * 16;
                f32x4 vq[8];
#pragma unroll
                for (int i = 0; i < 8; ++i) vq[i] = *(LAS const f32x4*)(r_vv + 4 * i);
                float cv; { const int tt = lane & 31; cv = -__builtin_amdgcn_rcpf(fmaxf(r_ss[2 * tt] + r_ss[2 * tt + 1], 1e-24f)); }
                constexpr int PF = 4;
                f32x4 qa[PF], qw[PF], qb[PF], qk[PF], qr[PF];
#pragma unroll
                for (int t = 0; t < PF; ++t) { qa[t] = *(LAS const f32x4*)(rg + (4 * (l16 ^ (t & 7))) + t * 64); qw[t] = *(LAS const f32x4*)(rg + (4 * (l16 ^ (t & 7))) + 2048 + t * 64); qb[t] = *(LAS const f32x4*)(rg + (4 * (l16 ^ (t & 7))) + 4096 + t * 64); qk[t] = *(LAS const f32x4*)(rg + (4 * (l16 ^ (t & 7))) + 6144 + t * 64); qr[t] = *(LAS const f32x4*)(rg + (4 * (l16 ^ (t & 7))) + 8192 + t * 64); }
                unsigned long long tq0 = 0; if (PROBE_PH == 11 && blockIdx.x == 0 && wave == 0) tq0 = __builtin_amdgcn_s_memrealtime(); if (PROBE_PH == 13 && blockIdx.x == 0 && wave == 0) tq0 = __builtin_amdgcn_s_memtime();
                float sa = red16(afma(S0, qa[0].x, amul(S1, qa[0].y)) + afma(S2, qa[0].z, amul(S3, qa[0].w))) * __builtin_bit_cast(float, __builtin_amdgcn_readlane(__builtin_bit_cast(int, cv), 0));
#pragma unroll
                for (int t = 0; t < T; ++t) {
                    const int sl = t % PF;
                    const f32x4 w4 = qw[sl], b4 = qb[sl], k4 = qk[sl], r4 = qr[sl]; const float vr = vq[t >> 2][t & 3];
                    const f32x4 an = qa[(t + 1) % PF];
                    if (t + PF < T) { const int u = t + PF; qa[sl] = *(LAS const f32x4*)(rg + (4 * (l16 ^ (u & 7))) + u * 64); qw[sl] = *(LAS const f32x4*)(rg + (4 * (l16 ^ (u & 7))) + 2048 + u * 64); qb[sl] = *(LAS const f32x4*)(rg + (4 * (l16 ^ (u & 7))) + 4096 + u * 64); qk[sl] = *(LAS const f32x4*)(rg + (4 * (l16 ^ (u & 7))) + 6144 + u * 64); qr[sl] = *(LAS const f32x4*)(rg + (4 * (l16 ^ (u & 7))) + 8192 + u * 64); }
                    float y, z, m0, m1, m2, m3;
                    asm("v_mul_f32 %[m0], %[vr], %[k0]\n\tv_mul_f32 %[m1], %[vr], %[k1]\n\tv_mul_f32 %[m2], %[vr], %[k2]\n\tv_mul_f32 %[m3], %[vr], %[k3]\n\t"
                        "v_fma_f32 %[m0], %[sa], %[b0], %[m0]\n\tv_fma_f32 %[m1], %[sa], %[b1], %[m1]\n\tv_fma_f32 %[m2], %[sa], %[b2], %[m2]\n\tv_fma_f32 %[m3], %[sa], %[b3], %[m3]\n\t"
                        "v_fma_f32 %[S0], %[S0], %[w0], %[m0]\n\tv_fma_f32 %[S1], %[S1], %[w1], %[m1]\n\tv_fma_f32 %[S2], %[S2], %[w2], %[m2]\n\tv_fma_f32 %[S3], %[S3], %[w3], %[m3]\n\t"
                        "v_mul_f32 %[m0], %[S1], %[r1]\n\tv_mul_f32 %[m1], %[S3], %[r3]\n\tv_mul_f32 %[m2], %[S1], %[a1]\n\tv_mul_f32 %[m3], %[S3], %[a3]\n\t"
                        "v_fma_f32 %[m0], %[S0], %[r0], %[m0]\n\tv_fma_f32 %[m1], %[S2], %[r2], %[m1]\n\tv_fma_f32 %[m2], %[S0], %[a0], %[m2]\n\tv_fma_f32 %[m3], %[S2], %[a2], %[m3]\n\t"
                        "v_add_f32 %[y], %[m0], %[m1]\n\tv_add_f32 %[z], %[m2], %[m3]"
                        : [S0] "+v"(S0), [S1] "+v"(S1), [S2] "+v"(S2), [S3] "+v"(S3), [y] "=&v"(y), [z] "=&v"(z), [m0] "=&v"(m0), [m1] "=&v"(m1), [m2] "=&v"(m2), [m3] "=&v"(m3)
                        : [sa] "v"(sa), [vr] "v"(vr), [k0] "v"(k4.x), [k1] "v"(k4.y), [k2] "v"(k4.z), [k3] "v"(k4.w), [b0] "v"(b4.x), [b1] "v"(b4.y), [b2] "v"(b4.z), [b3] "v"(b4.w),
                          [w0] "v"(w4.x), [w1] "v"(w4.y), [w2] "v"(w4.z), [w3] "v"(w4.w), [r0] "v"(r4.x), [r1] "v"(r4.y), [r2] "v"(r4.z), [r3] "v"(r4.w), [a0] "v"(an.x), [a1] "v"(an.y), [a2] "v"(an.z), [a3] "v"(an.w));
                    y += dpp_f<0xB1>(y); z += dpp_f<0xB1>(z); y += dpp_f<0x4E>(y); z += dpp_f<0x4E>(z); y += dpp_f<0x124>(y); z += dpp_f<0x124>(z); y += dpp_f<0x128>(y); z += dpp_f<0x128>(z);
                    sa = z * __builtin_bit_cast(float, __builtin_amdgcn_readlane(__builtin_bit_cast(int, cv), (t + 1) % T));
                    yrot = __builtin_bit_cast(float, __builtin_amdgcn_update_dpp(__builtin_bit_cast(int, y), __builtin_bit_cast(int, yrot), 0x111, 0xf, 0xf, false));
                    if ((t & 15) == 15) yo[(t - 15) * 16] = yrot;
                }
                if (PROBE_PH == 11 && blockIdx.x == 0 && wave == 0) { asm volatile("s_waitcnt lgkmcnt(0)" ::: "memory"); pacc += __builtin_amdgcn_s_memrealtime() - tq0; }
                if (PROBE_PH == 13 && blockIdx.x == 0 && wave == 0) { asm volatile("s_waitcnt lgkmcnt(0)" ::: "memory"); pacc += __builtin_amdgcn_s_memtime() - tq0; }
                LDS_BARRIER();
            }
            if (PROBE_PH == 11 && blockIdx.x == 0 && wave == 0 && lane == 0) *(LAS unsigned long long*)(lds + 163840 - 16) = pacc;
            if (PROBE_PH == 13 && blockIdx.x == 0 && wave == 0 && lane == 0) *(LAS unsigned long long*)(lds + 163840 - 16) = pacc / 100;
            __builtin_amdgcn_s_setprio(0);
        }
    }
}

typedef short bf16x4 __attribute__((ext_vector_type(4)));
__device__ __forceinline__ bf16x4 pk4(f32x4 v) { u32x2 w; w.x = pg8::cvt_pk_bf16_c(v.x, v.y); w.y = pg8::cvt_pk_bf16_c(v.z, v.w); return __builtin_bit_cast(bf16x4, w); }
__device__ __forceinline__ bf16x8 pk8(f32x4 a, f32x4 b) { u32x4 w; w.x = pg8::cvt_pk_bf16_c(a.x, a.y); w.y = pg8::cvt_pk_bf16_c(a.z, a.w); w.z = pg8::cvt_pk_bf16_c(b.x, b.y); w.w = pg8::cvt_pk_bf16_c(b.z, b.w); return __builtin_bit_cast(bf16x8, w); }
#define MFMA16(a, b, c) __builtin_amdgcn_mfma_f32_16x16x16bf16_1k(a, b, c, 0, 0, 0)
#define MFMA32(a, b, c) __builtin_amdgcn_mfma_f32_16x16x32_bf16(a, b, c, 0, 0, 0)
constexpr int RC_SL = 11008, RC_AT = 0, RC_RT = 2048, RC_BT = 4096, RC_KT = 6144, RC_MAK = 8192, RC_MRB = 8704, RC_MRK = 9216, RC_TI = 9728, RC_VT = 10240, RC_GL = 10752;
constexpr int RC_BLK = 6, RC_NCHK = SEQ / 16, RC_NB = (RC_NCHK + RC_BLK - 1) / RC_BLK;
constexpr int RC_W2H = 2 * RC_BLK * RC_SL, RC_A2H = RC_W2H + 13312, RC_CST = RC_A2H + 13312;
static_assert(RC_CST + 2048 <= 163840 - 64, "R2c LDS map");
static_assert((RC_NB + 1) * 12 >= 8 * 128, "SSD2 slices cover all 128 chunks of all 8 items per lane (256-workgroup grid)");
__device__ void phase_rwkv_chunked(const Params& p, LAS unsigned char* lds, int wg, int nwg) {
    const int tid = otid(), lane = tid & 63, wave = __builtin_amdgcn_readfirstlane(tid >> 6), r = lane & 15, q = lane >> 4;
    LAS float* cst = (LAS float*)(lds + RC_CST);
    const bf16_t* R = (const bf16_t*)(p.ws + WS_R); const bf16_t* Kb = (const bf16_t*)(p.ws + WS_K); const bf16_t* V = (const bf16_t*)(p.ws + WS_V);
    const bf16_t* AW = (const bf16_t*)(p.ws + WS_AW); const bf16_t* AA = (const bf16_t*)(p.ws + WS_AA);
    float* BON = (float*)(p.ws + WS_BON); bf16_t* YRAW = (bf16_t*)(p.ws + WS_YRAW);
    for (int unit = wg; unit < 256; unit += nwg) {
        const int xcd = unit & 7, idx = unit >> 3, qw = idx & 3, bh = xcd * 8 + (idx >> 2), b = bh >> 5, h = bh & 31;
        __syncthreads();
        { const int arr = tid >> 6, ch = tid & 63; const float* srcs[8] = {p.in[I_W0], p.in[I_A0], p.in[I_KK], p.in[I_KA], p.in[I_RK], p.in[I_MU] + MU_R, p.in[I_MU] + MU_K, p.in[I_MU] + MU_V};
          float v = 0.f;
#pragma unroll
          for (int a = 0; a < 8; ++a) if (arr == a) v = srcs[a][h * 64 + ch];
          cst[arr * 64 + ch] = v; }
        {   LAS bf16_t* w2h = (LAS bf16_t*)(lds + RC_W2H); LAS bf16_t* a2h = (LAS bf16_t*)(lds + RC_A2H);
            for (int i = tid; i < 96 * 64; i += 512) { const int k = i >> 6, ch = i & 63;
                w2h[ch * 104 + k] = (bf16_t)f2bf(p.in[I_W2][(size_t)k * D_RWKV + h * 64 + ch]); a2h[ch * 104 + k] = (bf16_t)f2bf(p.in[I_A2][(size_t)k * D_RWKV + h * 64 + ch]); } }
        __syncthreads();
        if (wave == 0) {
            __builtin_amdgcn_s_setprio(3);
            f32x4 Sacc[4];
#pragma unroll
            for (int ct = 0; ct < 4; ++ct) Sacc[ct] = (f32x4){0.f, 0.f, 0.f, 0.f};
            const f32x4 zero4 = {0.f, 0.f, 0.f, 0.f};
            unsigned long long pacc = 0;
            for (int blk = 0; blk <= RC_NB; ++blk) {
                unsigned long long tq0 = 0; if (PROBE_PH == 21 && blockIdx.x == 0) tq0 = __builtin_amdgcn_s_memrealtime();
                if (blk >= 1) {
                    for (int j = 0; j < RC_BLK; ++j) {
                        const int ci = (blk - 1) * RC_BLK + j; if (ci >= RC_NCHK) break;
                        LAS const unsigned char* sl = lds + (((blk - 1) & 1) * RC_BLK + j) * RC_SL;
                        const bf16x8 at0 = *(LAS const bf16x8*)(sl + RC_AT + lane * 16), at1 = *(LAS const bf16x8*)(sl + RC_AT + 1024 + lane * 16);
                        const bf16x8 rt0 = *(LAS const bf16x8*)(sl + RC_RT + lane * 16), rt1 = *(LAS const bf16x8*)(sl + RC_RT + 1024 + lane * 16);
                        const bf16x4 mak = *(LAS const bf16x4*)(sl + RC_MAK + lane * 8), mrb = *(LAS const bf16x4*)(sl + RC_MRB + lane * 8), mrk = *(LAS const bf16x4*)(sl + RC_MRK + lane * 8),
                                     ti = *(LAS const bf16x4*)(sl + RC_TI + lane * 8), vt = *(LAS const bf16x4*)(sl + RC_VT + lane * 8);
                        bf16x4 bt[4], kt[4]; f32x4 gl[4];
#pragma unroll
                        for (int ct = 0; ct < 4; ++ct) { bt[ct] = *(LAS const bf16x4*)(sl + RC_BT + (ct * 64 + lane) * 8); kt[ct] = *(LAS const bf16x4*)(sl + RC_KT + (ct * 64 + lane) * 8); gl[ct] = *(LAS const f32x4*)(sl + RC_GL + (16 * ct + 4 * q) * 4); }
                        const bf16x8 sop0 = pk8(Sacc[0], Sacc[1]), sop1 = pk8(Sacc[2], Sacc[3]);
                        f32x4 X = MFMA32(at0, sop0, zero4); X = MFMA32(at1, sop1, X); X = MFMA16(mak, vt, X);
                        const f32x4 U = MFMA16(ti, pk4(X), zero4);
                        const bf16x4 up = pk4(U);
                        f32x4 Y = MFMA32(rt0, sop0, zero4); Y = MFMA32(rt1, sop1, Y); Y = MFMA16(mrb, up, Y); Y = MFMA16(mrk, vt, Y);
#pragma unroll
                        for (int ct = 0; ct < 4; ++ct) { Sacc[ct] = MFMA16(bt[ct], up, Sacc[ct]); Sacc[ct] = MFMA16(kt[ct], vt, Sacc[ct]); Sacc[ct] = Sacc[ct] * gl[ct]; }
                        bf16_t* yo = YRAW + ((size_t)b * SEQ + 16 * ci + 4 * q) * D_RWKV + h * 64 + 16 * qw + r;
                        yo[0] = (bf16_t)f2bf(Y.x); yo[D_RWKV] = (bf16_t)f2bf(Y.y); yo[2 * D_RWKV] = (bf16_t)f2bf(Y.z); yo[3 * D_RWKV] = (bf16_t)f2bf(Y.w);
                    }
                }
                if (PROBE_PH == 21 && blockIdx.x == 0) { asm volatile("s_waitcnt lgkmcnt(0)" ::: "memory"); pacc += __builtin_amdgcn_s_memrealtime() - tq0; }
                LDS_BARRIER();
            }
            __builtin_amdgcn_s_setprio(0);
            if (PROBE_PH == 21 && blockIdx.x == 0 && lane == 0) *(LAS unsigned long long*)(lds + 163840 - 16) = pacc;
        } else if (wave != 4) {
            const int pw = wave < 4 ? wave - 1 : wave - 2;
            const auto rsAW = __builtin_amdgcn_make_buffer_rsrc((void*)AW, 0, (int)(M * 128 * 2), 0x00020000), rsAA = __builtin_amdgcn_make_buffer_rsrc((void*)AA, 0, (int)(M * 128 * 2), 0x00020000);
            const auto rsR = __builtin_amdgcn_make_buffer_rsrc((void*)R, 0, (int)(M * 2048 * 2), 0x00020000), rsK = __builtin_amdgcn_make_buffer_rsrc((void*)Kb, 0, (int)(M * 2048 * 2), 0x00020000), rsV = __builtin_amdgcn_make_buffer_rsrc((void*)V, 0, (int)(M * 2048 * 2), 0x00020000);
            const int voA = (r * 128 + 8 * q) * 2, voR = (r * 2048 + h * 64 + 4 * q) * 2;
            bf16x8 nAW[3], nAA[3]; u32x2 nR[4][2], nK[4][2], nV[2];
#define RC_PREFETCH_A(cc) do { const int soA_ = (b * SEQ + 16 * (cc)) * 256; \
                _Pragma("unroll") for (int ks = 0; ks < 3; ++ks) { nAW[ks] = __builtin_bit_cast(bf16x8, __builtin_amdgcn_raw_buffer_load_b128(rsAW, voA + 64 * ks, soA_, 0)); nAA[ks] = __builtin_bit_cast(bf16x8, __builtin_amdgcn_raw_buffer_load_b128(rsAA, voA + 64 * ks, soA_, 0)); } } while (0)
#define RC_PREFETCH_R(cc) do { const int row0_ = b * SEQ + 16 * (cc); const int soR_ = row0_ * 4096, soP_ = row0_ > 0 ? (row0_ - 1) * 4096 : 0, vaP_ = row0_ > 0 ? 0 : -4096; \
                _Pragma("unroll") for (int nt = 0; nt < 4; ++nt) { \
                    nR[nt][0] = __builtin_bit_cast(u32x2, __builtin_amdgcn_raw_buffer_load_b64(rsR, voR + 32 * nt, soR_, 0)); nK[nt][0] = __builtin_bit_cast(u32x2, __builtin_amdgcn_raw_buffer_load_b64(rsK, voR + 32 * nt, soR_, 0)); \
                    nR[nt][1] = __builtin_bit_cast(u32x2, __builtin_amdgcn_raw_buffer_load_b64(rsR, voR + 32 * nt + vaP_, soP_, 0)); nK[nt][1] = __builtin_bit_cast(u32x2, __builtin_amdgcn_raw_buffer_load_b64(rsK, voR + 32 * nt + vaP_, soP_, 0)); } \
                nV[0] = __builtin_bit_cast(u32x2, __builtin_amdgcn_raw_buffer_load_b64(rsV, voR + 32 * qw, soR_, 0)); nV[1] = __builtin_bit_cast(u32x2, __builtin_amdgcn_raw_buffer_load_b64(rsV, voR + 32 * qw + vaP_, soP_, 0)); } while (0)
            RC_PREFETCH_A(pw); RC_PREFETCH_R(pw);
            LAS const unsigned char* wb = lds + RC_W2H + (r * 104 + 8 * q) * 2;
            LAS const float* cq = cst + 4 * q;
            asm volatile("" : "+v"(wb), "+v"(cq));
            bf16x4 ident; { u32x2 w; w.x = ((4 * q + 0 == r) ? 0x3F80u : 0u) | ((4 * q + 1 == r) ? 0x3F800000u : 0u); w.y = ((4 * q + 2 == r) ? 0x3F80u : 0u) | ((4 * q + 3 == r) ? 0x3F800000u : 0u); ident = __builtin_bit_cast(bf16x4, w); }
            const f32x4 zero4 = {0.f, 0.f, 0.f, 0.f};
            unsigned long long pacc = 0;
            for (int blk = 0; blk <= RC_NB; ++blk) {
                unsigned long long tq0 = 0; if (PROBE_PH == 22 && blockIdx.x == 0 && pw == 0) tq0 = __builtin_amdgcn_s_memrealtime();
                const int ci = blk * RC_BLK + pw;
                if (blk < RC_NB && ci < RC_NCHK) {
                    LAS unsigned char* sl = lds + ((blk & 1) * RC_BLK + pw) * RC_SL;
                    LAS unsigned char* sl16 = sl + lane * 16; LAS unsigned char* sl8 = sl + lane * 8; LAS unsigned char* slg = sl + RC_GL + 16 * q;
                    asm volatile("" : "+v"(sl16), "+v"(sl8), "+v"(slg));
                    const size_t m = (size_t)b * SEQ + 16 * ci + r; const bool first = (16 * ci + r) == 0;
                    f32x4 accw[4], acca[4];
#pragma unroll
                    for (int nt = 0; nt < 4; ++nt) { accw[nt] = zero4; acca[nt] = zero4; }
#pragma unroll
                    for (int ks = 0; ks < 3; ++ks)
#pragma unroll
                        for (int nt = 0; nt < 4; ++nt) { const int bo = (16 * nt * 104 + 32 * ks) * 2;
                            accw[nt] = MFMA32(*(LAS const bf16x8*)(wb + bo), nAW[ks], accw[nt]); acca[nt] = MFMA32(*(LAS const bf16x8*)(wb + 13312 + bo), nAA[ks], acca[nt]); }
                    __builtin_amdgcn_sched_barrier(0);
                    if (ci + RC_BLK < RC_NCHK) RC_PREFETCH_A(ci + RC_BLK);
                    float ss = 0.f, bo = 0.f;
#pragma unroll
                    for (int nt = 0; nt < 4; ++nt) { const f32x4 muk = *(LAS const f32x4*)(cq + 6 * 64 + 16 * nt), kkc = *(LAS const f32x4*)(cq + 2 * 64 + 16 * nt);
                        const f32x4 kc = up4(nK[nt][0]); f32x4 kq = up4(nK[nt][1]); if (first) kq = zero4; const f32x4 kkv = (kc + (kq - kc) * muk) * kkc; ss += sumsq4(kkv); }
                    ss += __shfl_xor(ss, 16); ss += __shfl_xor(ss, 32);
                    const float rn = __builtin_amdgcn_rsqf(fmaxf(ss, 1e-24f));
                    bf16x4 qa[4], qb[4], qk[4], qr[4];
#pragma unroll
                    for (int nt = 0; nt < 4; ++nt) {
                        const f32x4 w0 = *(LAS const f32x4*)(cq + 0 * 64 + 16 * nt), a0 = *(LAS const f32x4*)(cq + 1 * 64 + 16 * nt);
                        f32x4 lw, ag;
#pragma unroll
                        for (int i = 0; i < 4; ++i) { lw[i] = -0.60653066f * __builtin_amdgcn_rcpf(1.f + __expf(-(w0[i] + accw[nt][i]))); ag[i] = __builtin_amdgcn_rcpf(1.f + __expf(-(a0[i] + acca[nt][i]))); }
                        const f32x4 mur = *(LAS const f32x4*)(cq + 5 * 64 + 16 * nt), muk = *(LAS const f32x4*)(cq + 6 * 64 + 16 * nt), kkc = *(LAS const f32x4*)(cq + 2 * 64 + 16 * nt), kac = *(LAS const f32x4*)(cq + 3 * 64 + 16 * nt), rkc = *(LAS const f32x4*)(cq + 4 * 64 + 16 * nt);
                        const f32x4 rc = up4(nR[nt][0]), kc = up4(nK[nt][0]); f32x4 rp = up4(nR[nt][1]), kq = up4(nK[nt][1]); if (first) { rp = zero4; kq = zero4; }
                        const f32x4 r4 = rc + (rp - rc) * mur, k4 = kc + (kq - kc) * muk;
                        const f32x4 kn = k4 * kkc * rn, kp = k4 * (1.f + (ag - 1.f) * kac);
                        const f32x4 b4_ = r4 * kp * rkc; bo += (b4_.x + b4_.y) + (b4_.z + b4_.w);
                        f32x4 G = lw;
#pragma unroll
                        for (int i = 0; i < 4; ++i) { float g = G[i]; g += dpp_f<0x111>(g); g += dpp_f<0x112>(g); g += dpp_f<0x114>(g); g += dpp_f<0x118>(g); G[i] = g; }
                        f32x4 eG, eGx, eI;
#pragma unroll
                        for (int i = 0; i < 4; ++i) { eG[i] = __expf(G[i]); eGx[i] = __builtin_bit_cast(float, __builtin_amdgcn_update_dpp(0x3F800000, __builtin_bit_cast(int, eG[i]), 0x111, 0xf, 0xf, false)); eI[i] = __builtin_amdgcn_rcpf(eG[i]); }
                        qa[nt] = pk4((zero4 - kn) * eGx); qb[nt] = pk4(kn * ag * eI); qk[nt] = pk4(kp * eI); qr[nt] = pk4(r4 * eG);
                        if (r == 15) *(LAS f32x4*)(slg + 64 * nt) = eG;
                        const f32x4 d1 = MFMA16(qb[nt], ident, zero4), d2 = MFMA16(qk[nt], ident, zero4);
                        *(LAS bf16x4*)(sl8 + RC_BT + nt * 512) = pk4(d1); *(LAS bf16x4*)(sl8 + RC_KT + nt * 512) = pk4(d2);
                    }
                    bo += __shfl_xor(bo, 16); bo += __shfl_xor(bo, 32);
                    if (qw == 0 && q == 0) { BON[(m * 32 + h) * 2] = bo; BON[(m * 32 + h) * 2 + 1] = 0.f; }
                    f32x4 v4; { const f32x4 muv = *(LAS const f32x4*)(cq + 7 * 64 + 16 * qw); const f32x4 vc = up4(nV[0]); f32x4 vp = up4(nV[1]); if (first) vp = zero4; v4 = vc + (vp - vc) * muv; }
                    __builtin_amdgcn_sched_barrier(0);
                    if (ci + RC_BLK < RC_NCHK) RC_PREFETCH_R(ci + RC_BLK);
                    __builtin_amdgcn_sched_barrier(0);
                    { const f32x4 d3 = MFMA16(pk4(v4), ident, zero4); *(LAS bf16x4*)(sl8 + RC_VT) = pk4(d3); }
#define CAT8(lo, hi) __builtin_shufflevector(lo, hi, 0, 1, 2, 3, 4, 5, 6, 7)
                    const bf16x8 pa0 = CAT8(qa[0], qa[1]), pa1 = CAT8(qa[2], qa[3]), pr0 = CAT8(qr[0], qr[1]), pr1 = CAT8(qr[2], qr[3]), pb0 = CAT8(qb[0], qb[1]), pb1 = CAT8(qb[2], qb[3]), pk0 = CAT8(qk[0], qk[1]), pk1 = CAT8(qk[2], qk[3]);
#undef CAT8
                    *(LAS bf16x8*)(sl16 + RC_AT) = pa0; *(LAS bf16x8*)(sl16 + RC_AT + 1024) = pa1; *(LAS bf16x8*)(sl16 + RC_RT) = pr0; *(LAS bf16x8*)(sl16 + RC_RT + 1024) = pr1;
                    __builtin_amdgcn_sched_barrier(0);
                    f32x4 mab = MFMA32(pb0, pa0, zero4); mab = MFMA32(pb1, pa1, mab);
                    f32x4 mak = MFMA32(pk0, pa0, zero4); mak = MFMA32(pk1, pa1, mak);
                    f32x4 mrb = MFMA32(pb0, pr0, zero4); mrb = MFMA32(pb1, pr1, mrb);
                    f32x4 mrk = MFMA32(pk0, pr0, zero4); mrk = MFMA32(pk1, pr1, mrk);
#pragma unroll
                    for (int t = 0; t < 4; ++t) { const int j = 4 * q + t; if (!(j < r)) { mab[t] = 0.f; mak[t] = 0.f; } if (!(j <= r)) { mrb[t] = 0.f; mrk[t] = 0.f; } }
                    *(LAS bf16x4*)(sl8 + RC_MAK) = pk4(mak); *(LAS bf16x4*)(sl8 + RC_MRB) = pk4(mrb); *(LAS bf16x4*)(sl8 + RC_MRK) = pk4(mrk);
                    __builtin_amdgcn_sched_barrier(0);
                    {
                        const bf16x4 nA = pk4(mab);
                        const bf16x4 nB = pk4(MFMA16(nA, ident, zero4));
                        f32x4 s;
#pragma unroll
                        for (int t = 0; t < 4; ++t) s[t] = mab[t] + ((4 * q + t == r) ? 1.f : 0.f);
                        const bf16x4 z2a = pk4(MFMA16(nA, nB, zero4)), z2b = pk4(MFMA16(nB, nA, zero4));
                        s = MFMA16(z2a, pk4(s), s);
                        const bf16x4 z4a = pk4(MFMA16(z2b, z2a, zero4)), z4b = pk4(MFMA16(z2a, z2b, zero4));
                        s = MFMA16(z4a, pk4(s), s);
                        const bf16x4 z8a = pk4(MFMA16(z4b, z4a, zero4));
                        s = MFMA16(z8a, pk4(s), s);
                        *(LAS bf16x4*)(sl8 + RC_TI) = pk4(s);
                    }
                }
                if (PROBE_PH == 22 && blockIdx.x == 0 && pw == 0) { asm volatile("s_waitcnt lgkmcnt(0)" ::: "memory"); pacc += __builtin_amdgcn_s_memrealtime() - tq0; }
                LDS_BARRIER();
            }
            if (PROBE_PH == 22 && blockIdx.x == 0 && pw == 0 && lane == 0) *(LAS unsigned long long*)(lds + 163840 - 16) = pacc;
#undef RC_PREFETCH_A
#undef RC_PREFETCH_R
        } else {
            bf16_t* SS = (bf16_t*)p.out; const float* CD = (const float*)(p.ws + WS_CTL + WS_CD);
            const int nitem = (BATCH * 32 * 64 * 32 + nwg * 64 - 1) / (nwg * 64), nstep = nitem * 128;
            constexpr int PER = 12;
            int s = (unit == wg) ? 0 : nstep; f32x4 hh = {0.f, 0.f, 0.f, 0.f};
            for (int blk = 0; blk <= RC_NB; ++blk) {
                u32x2 raw[PER]; float dd[PER]; bf16_t* qq[PER]; bool ok[PER];
#pragma unroll
                for (int k = 0; k < PER; ++k) { const int ss = s + k, item = ss >> 7, cc = ss & 127, idx = item * (nwg * 64) + wg * 64 + lane; ok[k] = ss < nstep && idx < BATCH * 32 * 64 * 32;
                    const int n4 = idx & 31, pp = (idx >> 5) & 63, eg = (idx >> 11) & 31, bb = idx >> 16;
                    qq[k] = SS + ((((size_t)bb * 128 + cc) * 32 + eg) * 64 + pp) * 128 + 4 * n4; raw[k] = (u32x2){0u, 0u}; dd[k] = 0.f;
                    if (ok[k]) { raw[k] = *(const u32x2*)qq[k]; dd[k] = CD[(bb * 128 + cc) * 32 + eg]; } }
#pragma unroll
                for (int k = 0; k < PER; ++k) { if (((s + k) & 127) == 0) hh = (f32x4){0.f, 0.f, 0.f, 0.f};
                    if (ok[k]) { u32x2 w; w.x = pg8::cvt_pk_bf16(hh.x, hh.y); w.y = pg8::cvt_pk_bf16(hh.z, hh.w); *(u32x2*)qq[k] = w; hh = hh * dd[k] + up4(raw[k]); } }
                s += PER;
                LDS_BARRIER();
            }
            for (; s < nstep; ++s) {
                const int item = s >> 7, cc = s & 127, idx = item * (nwg * 64) + wg * 64 + lane; if ((s & 127) == 0) hh = (f32x4){0.f, 0.f, 0.f, 0.f};
                if (idx < BATCH * 32 * 64 * 32) { const int n4 = idx & 31, pp = (idx >> 5) & 63, eg = (idx >> 11) & 31, bb = idx >> 16;
                    bf16_t* q1 = SS + ((((size_t)bb * 128 + cc) * 32 + eg) * 64 + pp) * 128 + 4 * n4; const f32x4 sv = ld4bf(q1); const float d1 = CD[(bb * 128 + cc) * 32 + eg];
                    u32x2 w; w.x = pg8::cvt_pk_bf16(hh.x, hh.y); w.y = pg8::cvt_pk_bf16(hh.z, hh.w); *(u32x2*)q1 = w; hh = hh * d1 + sv; } }
        }
    }
}

constexpr int RD_NG = 56;
constexpr int RD_NL = 12;
constexpr int RD_SLOTG = 10496;
constexpr int RD_BK = 4096, RD_MM = 8192;
constexpr size_t WS_RING = 9 * MiB;
constexpr size_t CTL_READY = 256 * 1024, CTL_DONE = 512 * 1024, CTL_ERR = 192 * 1024;
static_assert(WS_RING + (size_t)64 * RD_NG * RD_SLOTG <= 47 * MiB, "ring fits the dead WIN' region");
constexpr int RD_FLAGS = RC_CST + 2048;
static_assert(RD_FLAGS + 64 <= 163840, "R2d LDS map");
#define RD_SPIN_MAX (1u << 19)
__device__ void phase_rwkv_dist(const Params& p, LAS unsigned char* lds, int wg, int nwg) {
    const int tid = otid(), lane = tid & 63, wave = __builtin_amdgcn_readfirstlane(tid >> 6), r = lane & 15, q = lane >> 4;
    LAS float* cst = (LAS float*)(lds + RC_CST);
    volatile LAS unsigned* lflag = (volatile LAS unsigned*)(lds + RD_FLAGS);
    float* BON = (float*)(p.ws + WS_BON); bf16_t* YRAW = (bf16_t*)(p.ws + WS_YRAW);
    unsigned* READY = (unsigned*)(p.ws + WS_CTL + CTL_READY); unsigned* DONE = (unsigned*)(p.ws + WS_CTL + CTL_DONE); unsigned* ERR = (unsigned*)(p.ws + WS_CTL + CTL_ERR);
    const auto rsWS = __builtin_amdgcn_make_buffer_rsrc((void*)p.ws, 0, (int)WS_END, 0x00020000);
    for (int unit = wg; unit < 256; unit += nwg) {
        const int xcd = unit & 7, idx = unit >> 3, qw = idx & 3, bh = xcd * 8 + (idx >> 2), b = bh >> 5, h = bh & 31;
        __syncthreads();
        { const int arr = tid >> 6, ch = tid & 63; const float* srcs[8] = {p.in[I_W0], p.in[I_A0], p.in[I_KK], p.in[I_KA], p.in[I_RK], p.in[I_MU] + MU_R, p.in[I_MU] + MU_K, p.in[I_MU] + MU_V};
          float v = 0.f;
#pragma unroll
          for (int a = 0; a < 8; ++a) if (arr == a) v = srcs[a][h * 64 + ch];
          cst[arr * 64 + ch] = v; }
        {   LAS bf16_t* w2h = (LAS bf16_t*)(lds + RC_W2H); LAS bf16_t* a2h = (LAS bf16_t*)(lds + RC_A2H);
            for (int i = tid; i < 96 * 64; i += 512) { const int k = i >> 6, ch = i & 63;
                w2h[ch * 104 + k] = (bf16_t)f2bf(p.in[I_W2][(size_t)k * D_RWKV + h * 64 + ch]); a2h[ch * 104 + k] = (bf16_t)f2bf(p.in[I_A2][(size_t)k * D_RWKV + h * 64 + ch]); } }
        if (tid < 13) lflag[tid] = 0u;
        __syncthreads();
        const f32x4 zero4 = {0.f, 0.f, 0.f, 0.f};
        bf16x4 ident; { u32x2 w; w.x = ((4 * q + 0 == r) ? 0x3F80u : 0u) | ((4 * q + 1 == r) ? 0x3F800000u : 0u); w.y = ((4 * q + 2 == r) ? 0x3F80u : 0u) | ((4 * q + 3 == r) ? 0x3F800000u : 0u); ident = __builtin_bit_cast(bf16x4, w); }
        const int ringbase = (int)WS_RING + bh * (RD_NG * RD_SLOTG);
        bool dead = false;
        if (wave == 0) {
            __builtin_amdgcn_s_setprio(3);
            f32x4 Sacc[4];
#pragma unroll
            for (int ct = 0; ct < 4; ++ct) Sacc[ct] = zero4;
            for (int ci = 0; ci < RC_NCHK; ++ci) {
                { unsigned sp = 0; while (!dead && lflag[ci % RD_NL] != (unsigned)(ci + 1)) { __builtin_amdgcn_s_sleep(1); if (++sp > RD_SPIN_MAX) { if (lane == 0) atomicAdd(ERR, 1u); dead = true; } } }
                asm volatile("" ::: "memory");
                LAS const unsigned char* sl = lds + (ci % RD_NL) * RC_SL;
                const bf16x8 at0 = *(LAS const bf16x8*)(sl + RC_AT + lane * 16), at1 = *(LAS const bf16x8*)(sl + RC_AT + 1024 + lane * 16);
                const bf16x8 rt0 = *(LAS const bf16x8*)(sl + RC_RT + lane * 16), rt1 = *(LAS const bf16x8*)(sl + RC_RT + 1024 + lane * 16);
                const bf16x8 mm0 = *(LAS const bf16x8*)(sl + RD_MM + lane * 32), mm1 = *(LAS const bf16x8*)(sl + RD_MM + lane * 32 + 16);
                const bf16x4 vt = *(LAS const bf16x4*)(sl + RC_VT + lane * 8);
                bf16x8 bk[4]; f32x4 gl[4];
#pragma unroll
                for (int ct = 0; ct < 4; ++ct) { bk[ct] = *(LAS const bf16x8*)(sl + RD_BK + (ct * 64 + lane) * 16); gl[ct] = *(LAS const f32x4*)(sl + RC_GL + (16 * ct + 4 * q) * 4); }
                asm volatile("s_waitcnt lgkmcnt(0)" ::: "memory");
                lflag[12] = (unsigned)(ci + 1);
                const bf16x4 mak = __builtin_shufflevector(mm0, mm0, 0, 1, 2, 3), mrb = __builtin_shufflevector(mm0, mm0, 4, 5, 6, 7), mrk = __builtin_shufflevector(mm1, mm1, 0, 1, 2, 3), ti = __builtin_shufflevector(mm1, mm1, 4, 5, 6, 7);
                const bf16x8 sop0 = pk8(Sacc[0], Sacc[1]), sop1 = pk8(Sacc[2], Sacc[3]);
                f32x4 X = MFMA32(at0, sop0, zero4); X = MFMA32(at1, sop1, X); X = MFMA16(mak, vt, X);
                const f32x4 U = MFMA16(ti, pk4(X), zero4);
                const bf16x4 up = pk4(U);
                f32x4 Y = MFMA32(rt0, sop0, zero4); Y = MFMA32(rt1, sop1, Y); Y = MFMA16(mrb, up, Y); Y = MFMA16(mrk, vt, Y);
#pragma unroll
                for (int ct = 0; ct < 4; ++ct) { const bf16x4 btc = __builtin_shufflevector(bk[ct], bk[ct], 0, 1, 2, 3), ktc = __builtin_shufflevector(bk[ct], bk[ct], 4, 5, 6, 7);
                    Sacc[ct] = MFMA16(btc, up, Sacc[ct]); Sacc[ct] = MFMA16(ktc, vt, Sacc[ct]); Sacc[ct] = Sacc[ct] * gl[ct]; }
                const f32x4 Yt = MFMA16(pk4(Y), ident, zero4);
                *(u32x2*)(YRAW + ((size_t)bh * SEQ + 16 * ci + r) * 64 + 16 * qw + 4 * q) = __builtin_bit_cast(u32x2, pk4(Yt));
            }
            __builtin_amdgcn_s_setprio(0);
        } else if (wave >= 4) {
            const int fw = wave - 4;
            __builtin_amdgcn_s_setprio(2);
            const int voV = (r * 64 + 16 * qw + 4 * q) * 2;
            const f32x4 muv = *(LAS const f32x4*)(cst + 7 * 64 + 16 * qw + 4 * q);
            u32x4 fa[2][10]; u32x4 fg[2]; u32x2 fv[2][2];
#define RD_PEEK(cc) __hip_atomic_load(READY + bh * 512 + (cc), __ATOMIC_RELAXED, __HIP_MEMORY_SCOPE_AGENT)
#define RD_ISSUE(cc, s_, pre_) do { const int c_ = (cc); unsigned sp_ = 0; \
                    if (__builtin_amdgcn_readfirstlane(pre_) == 0u) while (!dead && __hip_atomic_load(READY + bh * 512 + c_, __ATOMIC_RELAXED, __HIP_MEMORY_SCOPE_AGENT) == 0u) { __builtin_amdgcn_s_sleep(1); if (++sp_ > RD_SPIN_MAX) { if (lane == 0) atomicAdd(ERR, 1u); dead = true; } } \
                    const int so_ = ringbase + (c_ % RD_NG) * RD_SLOTG; \
                    _Pragma("unroll") for (int j_ = 0; j_ < 10; ++j_) fa[s_][j_] = __builtin_bit_cast(u32x4, __builtin_amdgcn_raw_buffer_load_b128(rsWS, lane * 16 + 1024 * (j_ & 3), so_ + 4096 * (j_ >> 2), 16));     \
                    fg[s_] = __builtin_bit_cast(u32x4, __builtin_amdgcn_raw_buffer_load_b128(rsWS, (lane & 15) * 16, so_ + 10240, 16)); \
                    { const int soR_ = (bh * SEQ + 16 * c_) * 128, soP_ = soR_ > 0 ? soR_ - 128 : 0, vaP_ = soR_ > 0 ? 0 : -128; \
                      fv[s_][0] = __builtin_bit_cast(u32x2, __builtin_amdgcn_raw_buffer_load_b64(rsWS, voV, (int)WS_V + soR_, 0)); fv[s_][1] = __builtin_bit_cast(u32x2, __builtin_amdgcn_raw_buffer_load_b64(rsWS, voV + vaP_, (int)WS_V + soP_, 0)); } } while (0)
#define RD_STAGE(cc, s_) do { const int c_ = (cc); { unsigned sp_ = 0; while (!dead && (int)lflag[12] < c_ - RD_NL + 1) { __builtin_amdgcn_s_sleep(1); if (++sp_ > RD_SPIN_MAX) { if (lane == 0) atomicAdd(ERR, 1u); dead = true; } } } \
                    LAS unsigned char* sl_ = lds + (c_ % RD_NL) * RC_SL; \
                    f32x4 vc_ = up4(fv[s_][0]), vp_ = up4(fv[s_][1]); if (16 * c_ + r == 0) vp_ = zero4; const f32x4 v4_ = vc_ + (vp_ - vc_) * muv; \
                    const f32x4 d3_ = MFMA16(pk4(v4_), ident, zero4); \
                    _Pragma("unroll") for (int j_ = 0; j_ < 10; ++j_) *(LAS u32x4*)(sl_ + lane * 16 + 1024 * j_) = fa[s_][j_]; \
                    *(LAS u32x4*)(sl_ + RC_GL + (lane & 15) * 16) = fg[s_]; \
                    *(LAS bf16x4*)(sl_ + RC_VT + lane * 8) = pk4(d3_); \
                    asm volatile("s_waitcnt lgkmcnt(0)" ::: "memory"); \
                    lflag[c_ % RD_NL] = (unsigned)(c_ + 1); __hip_atomic_fetch_add(DONE + bh * 512 + c_, 1u, __ATOMIC_RELAXED, __HIP_MEMORY_SCOPE_AGENT); } while (0)
            bf16_t* SS = (bf16_t*)p.out; const float* CD = (const float*)(p.ws + WS_CTL + WS_CD);
            const int nitem = (BATCH * 32 * 64 * 32 + nwg * 64 - 1) / (nwg * 64), nstep = ((nitem + 3) / 4) * 128;
            const int per = (nitem + 3) / 4;
            int s2 = (unit == wg) ? 0 : nstep; f32x4 hh = zero4;
            RD_ISSUE(fw, 0, 0u);
            for (int c2 = fw; c2 < RC_NCHK; c2 += 8) {
                const unsigned pr1 = RD_PEEK(c2 + 4), pr0 = (c2 + 8 < RC_NCHK) ? RD_PEEK(c2 + 8) : 0u;
                u32x2 raw[4]; float dd[4]; bf16_t* qq[4]; bool ok[4];
#pragma unroll
                for (int k = 0; k < 4; ++k) { const int ss = s2 + k, item = fw * per + (ss >> 7), cc = ss & 127, idx = item * (nwg * 64) + wg * 64 + lane; ok[k] = ss < nstep && (ss >> 7) < per && item < nitem && idx < BATCH * 32 * 64 * 32;
                    const int n4 = idx & 31, pp = (idx >> 5) & 63, eg = (idx >> 11) & 31, bb = idx >> 16;
                    qq[k] = SS + ((((size_t)bb * 128 + cc) * 32 + eg) * 64 + pp) * 128 + 4 * n4; raw[k] = (u32x2){0u, 0u}; dd[k] = 0.f;
                    if (ok[k]) { raw[k] = *(const u32x2*)qq[k]; dd[k] = CD[(bb * 128 + cc) * 32 + eg]; } }
                RD_ISSUE(c2 + 4, 1, pr1);
                RD_STAGE(c2, 0);
                if (c2 + 8 < RC_NCHK) RD_ISSUE(c2 + 8, 0, pr0);
                RD_STAGE(c2 + 4, 1);
#pragma unroll
                for (int k = 0; k < 4; ++k) { if (((s2 + k) & 127) == 0) hh = zero4;
                    if (ok[k]) { u32x2 w; w.x = pg8::cvt_pk_bf16(hh.x, hh.y); w.y = pg8::cvt_pk_bf16(hh.z, hh.w); *(u32x2*)qq[k] = w; hh = hh * dd[k] + up4(raw[k]); } }
                s2 += 4;
            }
            for (; s2 < nstep; ++s2) {
                const int item = fw * per + (s2 >> 7), cc = s2 & 127, idx = item * (nwg * 64) + wg * 64 + lane; if ((s2 & 127) == 0) hh = zero4;
                if (item < nitem && idx < BATCH * 32 * 64 * 32) { const int n4 = idx & 31, pp = (idx >> 5) & 63, eg = (idx >> 11) & 31, bb = idx >> 16;
                    bf16_t* q1 = SS + ((((size_t)bb * 128 + cc) * 32 + eg) * 64 + pp) * 128 + 4 * n4; const f32x4 sv = ld4bf(q1); const float d1 = CD[(bb * 128 + cc) * 32 + eg];
                    u32x2 w; w.x = pg8::cvt_pk_bf16(hh.x, hh.y); w.y = pg8::cvt_pk_bf16(hh.z, hh.w); *(u32x2*)q1 = w; hh = hh * d1 + sv; } }
#undef RD_ISSUE
#undef RD_PEEK
#undef RD_STAGE
            __builtin_amdgcn_s_setprio(0);
        } else {
            const int pw = wave - 1;
            const bf16_t* dummy = nullptr; (void)dummy;
            const int voA = (r * 128 + 8 * q) * 2, voR = (r * 64 + 4 * q) * 2;
            bf16x8 nAW[3], nAA[3]; u32x2 nX[8][2];
#define RD_PREFETCH_A(cc) do { const int soA_ = (b * SEQ + 16 * (cc)) * 256; \
                _Pragma("unroll") for (int ks = 0; ks < 3; ++ks) { nAW[ks] = __builtin_bit_cast(bf16x8, __builtin_amdgcn_raw_buffer_load_b128(rsWS, voA + 64 * ks, (int)WS_AW + soA_, 0)); nAA[ks] = __builtin_bit_cast(bf16x8, __builtin_amdgcn_raw_buffer_load_b128(rsWS, voA + 64 * ks, (int)WS_AA + soA_, 0)); } } while (0)
#define RD_PREFETCH_R(cc) do { const int soR_ = (bh * SEQ + 16 * (cc)) * 128, soP_ = soR_ > 0 ? soR_ - 128 : 0, vaP_ = soR_ > 0 ? 0 : -128; \
                _Pragma("unroll") for (int xi = 0; xi < 8; ++xi) { const int base_ = xi < 4 ? (int)WS_R : (int)WS_K, vo_ = voR + 32 * (xi & 3); \
                    nX[xi][0] = __builtin_bit_cast(u32x2, __builtin_amdgcn_raw_buffer_load_b64(rsWS, vo_, base_ + soR_, 0)); nX[xi][1] = __builtin_bit_cast(u32x2, __builtin_amdgcn_raw_buffer_load_b64(rsWS, vo_ + vaP_, base_ + soP_, 0)); } } while (0)
            LAS const unsigned char* wb = lds + RC_W2H + (r * 104 + 8 * q) * 2;
            LAS const float* cq = cst + 4 * q;
            asm volatile("" : "+v"(wb), "+v"(cq));
            { const int c0 = 6 * qw + pw; if (c0 < RC_NCHK) { RD_PREFETCH_A(c0); } }
            for (int cj = 0; cj < 2 * ((RC_NCHK + 23) / 24); ++cj) {
                const int ci = 24 * (cj >> 1) + 6 * qw + pw + 3 * (cj & 1); if (ci >= RC_NCHK) continue;
                const int cn = 24 * ((cj + 1) >> 1) + 6 * qw + pw + 3 * ((cj + 1) & 1);
                RD_PREFETCH_R(ci);
                const size_t m = (size_t)b * SEQ + 16 * ci + r; const bool first = (16 * ci + r) == 0;
                f32x4 accw[4], acca[4];
#pragma unroll
                for (int nt = 0; nt < 4; ++nt) { accw[nt] = zero4; acca[nt] = zero4; }
#pragma unroll
                for (int ks = 0; ks < 3; ++ks)
#pragma unroll
                    for (int nt = 0; nt < 4; ++nt) { const int bo = (16 * nt * 104 + 32 * ks) * 2;
                        accw[nt] = MFMA32(*(LAS const bf16x8*)(wb + bo), nAW[ks], accw[nt]); acca[nt] = MFMA32(*(LAS const bf16x8*)(wb + 13312 + bo), nAA[ks], acca[nt]); }
                __builtin_amdgcn_sched_barrier(0);
                if (cn < RC_NCHK) RD_PREFETCH_A(cn);
                float ss = 0.f, bo = 0.f;
#pragma unroll
                for (int nt = 0; nt < 4; ++nt) { const f32x4 muk = *(LAS const f32x4*)(cq + 6 * 64 + 16 * nt), kkc = *(LAS const f32x4*)(cq + 2 * 64 + 16 * nt);
                    const f32x4 kc = up4(nX[4 + nt][0]); f32x4 kq = up4(nX[4 + nt][1]); if (first) kq = zero4; const f32x4 kkv = (kc + (kq - kc) * muk) * kkc; ss += sumsq4(kkv); }
                ss += __shfl_xor(ss, 16); ss += __shfl_xor(ss, 32);
                const float rn = __builtin_amdgcn_rsqf(fmaxf(ss, 1e-24f));
                if (ci >= RD_NG) { unsigned sp = 0; while (!dead && __hip_atomic_load(DONE + bh * 512 + (ci - RD_NG), __ATOMIC_RELAXED, __HIP_MEMORY_SCOPE_AGENT) < 256u) { __builtin_amdgcn_s_sleep(2); if (++sp > RD_SPIN_MAX) { if (lane == 0) atomicAdd(ERR, 1u); dead = true; } } }
                const int so = ringbase + (ci % RD_NG) * RD_SLOTG;
                bf16x4 qa[4], qb[4], qk[4], qr[4];
#pragma unroll
                for (int nt = 0; nt < 4; ++nt) {
                    const f32x4 w0 = *(LAS const f32x4*)(cq + 0 * 64 + 16 * nt), a0 = *(LAS const f32x4*)(cq + 1 * 64 + 16 * nt);
                    f32x4 lw, ag;
#pragma unroll
                    for (int i = 0; i < 4; ++i) { lw[i] = -0.60653066f * __builtin_amdgcn_rcpf(1.f + __expf(-(w0[i] + accw[nt][i]))); ag[i] = __builtin_amdgcn_rcpf(1.f + __expf(-(a0[i] + acca[nt][i]))); }
                    const f32x4 mur = *(LAS const f32x4*)(cq + 5 * 64 + 16 * nt), muk = *(LAS const f32x4*)(cq + 6 * 64 + 16 * nt), kkc = *(LAS const f32x4*)(cq + 2 * 64 + 16 * nt), kac = *(LAS const f32x4*)(cq + 3 * 64 + 16 * nt), rkc = *(LAS const f32x4*)(cq + 4 * 64 + 16 * nt);
                    const f32x4 rc = up4(nX[nt][0]), kc = up4(nX[4 + nt][0]); f32x4 rp = up4(nX[nt][1]), kq = up4(nX[4 + nt][1]); if (first) { rp = zero4; kq = zero4; }
                    const f32x4 r4 = rc + (rp - rc) * mur, k4 = kc + (kq - kc) * muk;
                    const f32x4 kn = k4 * kkc * rn, kp = k4 * (1.f + (ag - 1.f) * kac);
                    const f32x4 b4_ = r4 * kp * rkc; bo += (b4_.x + b4_.y) + (b4_.z + b4_.w);
                    f32x4 G = lw;
#pragma unroll
                    for (int i = 0; i < 4; ++i) { float g = G[i]; g += dpp_f<0x111>(g); g += dpp_f<0x112>(g); g += dpp_f<0x114>(g); g += dpp_f<0x118>(g); G[i] = g; }
                    f32x4 eG, eGx, eI;
#pragma unroll
                    for (int i = 0; i < 4; ++i) { eG[i] = __expf(G[i]); eGx[i] = __builtin_bit_cast(float, __builtin_amdgcn_update_dpp(0x3F800000, __builtin_bit_cast(int, eG[i]), 0x111, 0xf, 0xf, false)); eI[i] = __builtin_amdgcn_rcpf(eG[i]); }
                    qa[nt] = pk4((zero4 - kn) * eGx); qb[nt] = pk4(kn * ag * eI); qk[nt] = pk4(kp * eI); qr[nt] = pk4(r4 * eG);
                    if (r == 15) __builtin_amdgcn_raw_buffer_store_b128(__builtin_bit_cast(u32x4, eG), rsWS, (16 * nt + 4 * q) * 4, so + 10240, 16);
                    const f32x4 d1 = MFMA16(qb[nt], ident, zero4), d2 = MFMA16(qk[nt], ident, zero4);
                    { const bf16x4 e1 = pk4(d1), e2 = pk4(d2); __builtin_amdgcn_raw_buffer_store_b128(__builtin_bit_cast(u32x4, __builtin_shufflevector(e1, e2, 0, 1, 2, 3, 4, 5, 6, 7)), rsWS, lane * 16 + 1024 * nt, so + RD_BK, 16); }
                }
                bo += __shfl_xor(bo, 16); bo += __shfl_xor(bo, 32);
                if (q == 0) { BON[(m * 32 + h) * 2] = bo; BON[(m * 32 + h) * 2 + 1] = 0.f; }
#define CAT8(lo, hi) __builtin_shufflevector(lo, hi, 0, 1, 2, 3, 4, 5, 6, 7)
                const bf16x8 pa0 = CAT8(qa[0], qa[1]), pa1 = CAT8(qa[2], qa[3]), pr0 = CAT8(qr[0], qr[1]), pr1 = CAT8(qr[2], qr[3]), pb0 = CAT8(qb[0], qb[1]), pb1 = CAT8(qb[2], qb[3]), pk0 = CAT8(qk[0], qk[1]), pk1 = CAT8(qk[2], qk[3]);
#undef CAT8
                __builtin_amdgcn_raw_buffer_store_b128(__builtin_bit_cast(u32x4, pa0), rsWS, lane * 16, so + RC_AT, 16); __builtin_amdgcn_raw_buffer_store_b128(__builtin_bit_cast(u32x4, pa1), rsWS, lane * 16 + 1024, so + RC_AT, 16);
                __builtin_amdgcn_raw_buffer_store_b128(__builtin_bit_cast(u32x4, pr0), rsWS, lane * 16, so + RC_RT, 16); __builtin_amdgcn_raw_buffer_store_b128(__builtin_bit_cast(u32x4, pr1), rsWS, lane * 16 + 1024, so + RC_RT, 16);
                __builtin_amdgcn_sched_barrier(0);
                f32x4 mab = MFMA32(pb0, pa0, zero4); mab = MFMA32(pb1, pa1, mab);
                f32x4 mak = MFMA32(pk0, pa0, zero4); mak = MFMA32(pk1, pa1, mak);
                f32x4 mrb = MFMA32(pb0, pr0, zero4); mrb = MFMA32(pb1, pr1, mrb);
                f32x4 mrk = MFMA32(pk0, pr0, zero4); mrk = MFMA32(pk1, pr1, mrk);
#pragma unroll
                for (int t = 0; t < 4; ++t) { const int j = 4 * q + t; if (!(j < r)) { mab[t] = 0.f; mak[t] = 0.f; } if (!(j <= r)) { mrb[t] = 0.f; mrk[t] = 0.f; } }
                { const bf16x4 e1 = pk4(mak), e2 = pk4(mrb); __builtin_amdgcn_raw_buffer_store_b128(__builtin_bit_cast(u32x4, __builtin_shufflevector(e1, e2, 0, 1, 2, 3, 4, 5, 6, 7)), rsWS, lane * 32, so + RD_MM, 16); }
                const bf16x4 mrkp = pk4(mrk);
                __builtin_amdgcn_sched_barrier(0);
                {   const bf16x4 nA = pk4(mab);
                    const bf16x4 nB = pk4(MFMA16(nA, ident, zero4));
                    f32x4 s;
#pragma unroll
                    for (int t = 0; t < 4; ++t) s[t] = mab[t] + ((4 * q + t == r) ? 1.f : 0.f);
                    const bf16x4 z2a = pk4(MFMA16(nA, nB, zero4)), z2b = pk4(MFMA16(nB, nA, zero4));
                    s = MFMA16(z2a, pk4(s), s);
                    const bf16x4 z4a = pk4(MFMA16(z2b, z2a, zero4)), z4b = pk4(MFMA16(z2a, z2b, zero4));
                    s = MFMA16(z4a, pk4(s), s);
                    const bf16x4 z8a = pk4(MFMA16(z4b, z4a, zero4));
                    s = MFMA16(z8a, pk4(s), s);
                    { const bf16x4 e2 = pk4(s); __builtin_amdgcn_raw_buffer_store_b128(__builtin_bit_cast(u32x4, __builtin_shufflevector(mrkp, e2, 0, 1, 2, 3, 4, 5, 6, 7)), rsWS, lane * 32 + 16, so + RD_MM, 16); }
                }
                asm volatile("s_waitcnt vmcnt(0)" ::: "memory");
                __hip_atomic_store(READY + bh * 512 + ci, 1u, __ATOMIC_RELAXED, __HIP_MEMORY_SCOPE_AGENT);
            }
#undef RD_PREFETCH_A
#undef RD_PREFETCH_R
        }
    }
}

__device__ void phase_rwkv_post(const Params& p, bf16_t* ymix, LAS unsigned char* lds, int wg, int nwg) {
    const int tid = otid(), lane = tid & 63, wave = tid >> 6, fr = lane & 15, fq = lane >> 4;
    const bf16_t* AG = (const bf16_t*)(p.ws + WS_AG); const bf16_t* G2 = (const bf16_t*)(p.ws + WS_G2); const bf16_t* YRAW = (const bf16_t*)(p.ws + WS_YRAW); const bf16_t* V = (const bf16_t*)(p.ws + WS_V);
    const float* BON = (const float*)(p.ws + WS_BON); const float* mu = p.in[I_MU];
    for (int item = wg; item < 8 * 32; item += nwg) {
        const int hg = item >> 5, rng = item & 31;
        __syncthreads();
        for (int i = tid; i < 4 * 64 * 32; i += 512) { const int ch = i >> 5, c16 = i & 31; *(LAS u32x4*)(lds + (ch * 264 + c16 * 8) * 2) = *(const u32x4*)(G2 + (size_t)(hg * 256 + ch) * 256 + c16 * 8); }
        __syncthreads();
        for (int it = 0; it < 4; ++it) {
            const int mt = rng * 32 + it * 8 + wave;
            const size_t m = (size_t)mt * 16 + fr; const bool hp = (m % SEQ) > 0;
            bf16x8 af[8];
#pragma unroll
            for (int ks = 0; ks < 8; ++ks) af[ks] = *(const bf16x8*)(AG + m * 256 + 32 * ks + 8 * fq);
            for (int hh = 0; hh < 4; ++hh) {
                const int h = hg * 4 + hh;
                f32x4 y[4], vc[4], vp[4];
#pragma unroll
                for (int nt = 0; nt < 4; ++nt) { const size_t e = ((size_t)((int)(m / SEQ) * 32 + h) * SEQ + (m % SEQ)) * 64 + 16 * nt + 4 * fq;
                    y[nt] = ld4bf(YRAW + e); vc[nt] = ld4bf(V + e); vp[nt] = (f32x4){0.f, 0.f, 0.f, 0.f}; if (hp) vp[nt] = ld4bf(V + e - 64); }
                const float bon = BON[(m * 32 + h) * 2] + BON[(m * 32 + h) * 2 + 1];
                f32x4 acc[4];
#pragma unroll
                for (int nt = 0; nt < 4; ++nt) acc[nt] = (f32x4){0.f, 0.f, 0.f, 0.f};
#pragma unroll
                for (int ks = 0; ks < 8; ++ks)
#pragma unroll
                    for (int nt = 0; nt < 4; ++nt) acc[nt] = __builtin_amdgcn_mfma_f32_16x16x32_bf16(*(LAS const bf16x8*)(lds + ((64 * hh + 16 * nt + fr) * 264 + 32 * ks + 8 * fq) * 2), af[ks], acc[nt], 0, 0, 0);
                float s1 = 0.f;
#pragma unroll
                for (int nt = 0; nt < 4; ++nt) s1 += (y[nt].x + y[nt].y) + (y[nt].z + y[nt].w);
                s1 += __shfl_xor(s1, 16); s1 += __shfl_xor(s1, 32);
                const float mean = s1 * (1.f / 64.f); float s2 = 0.f;
#pragma unroll
                for (int nt = 0; nt < 4; ++nt) { y[nt] = y[nt] - mean; s2 += sumsq4(y[nt]); }
                s2 += __shfl_xor(s2, 16); s2 += __shfl_xor(s2, 32);
                const float rstd = __builtin_amdgcn_rsqf(s2 * (1.f / 64.f) + GN_EPS);
#pragma unroll
                for (int nt = 0; nt < 4; ++nt) {
                    const int c = h * 64 + 16 * nt + 4 * fq;
                    const f32x4 muv = *(const f32x4*)(mu + MU_V + c), gw = *(const f32x4*)(p.in[I_GNW] + c), gb = *(const f32x4*)(p.in[I_GNB] + c);
                    const f32x4 v4 = vc[nt] + (vp[nt] - vc[nt]) * muv;
                    const f32x4 o = (y[nt] * rstd * gw + gb + v4 * bon) * acc[nt];
                    u32x2 w; w.x = pg8::cvt_pk_bf16_c(o.x, o.y); w.y = pg8::cvt_pk_bf16_c(o.z, o.w);
                    *(u32x2*)(ymix + m * D_MIX + 2048 + c) = w;
                }
            }
        }
    }
}

__device__ void phase_final(const Params& p, int wg, int nwg) {
    const int tid = otid(), lane = tid & 63, wave = tid >> 6;
    const float* rowss2 = (const float*)(p.ws + WS_CTL) + M; const float* gf = p.in[I_NFG]; const bf16_t* H2B = (const bf16_t*)(p.ws + WS_H2B);
    for (int m = wg * 8 + wave; m < M; m += nwg * 8) {
        const float rstd = 1.f / sqrtf(rowss2[m] * (1.f / DM) + RMS_EPS);
        u32x4 hw[4];
#pragma unroll
        for (int j = 0; j < 4; ++j) hw[j] = *(const u32x4*)(H2B + (size_t)m * DM + (64 * j + lane) * 8);
#pragma unroll
        for (int j = 0; j < 4; ++j) { const int c = (64 * j + lane) * 8;
            const f32x4 g0 = *(const f32x4*)(gf + c), g1 = *(const f32x4*)(gf + c + 4);
            *(f32x4*)(p.out + (size_t)m * DM + c) = up4((u32x2){hw[j].x, hw[j].y}) * rstd * g0; *(f32x4*)(p.out + (size_t)m * DM + c + 4) = up4((u32x2){hw[j].z, hw[j].w}) * rstd * g1; }
    }
}

#define XB_TMO      128
#define XB_XCNT(j)  (256  + 64 * (j))
#define XB_XSUB(j)  (1280 + 64 * (j))
#define XB_XGEN(j)  (2304 + 64 * (j))
#define XB_TOP      3328
#define XB_TOPGEN   3392
#define XCD_BAR_WORDS 3456
#define XB_SPIN_CAP (1u << 18)

__device__ __forceinline__ unsigned xb_ld(unsigned* p)              { return __hip_atomic_load(p, __ATOMIC_RELAXED, __HIP_MEMORY_SCOPE_AGENT); }
__device__ __forceinline__ unsigned xb_add(unsigned* p, unsigned v) { return __hip_atomic_fetch_add(p, v, __ATOMIC_RELAXED, __HIP_MEMORY_SCOPE_AGENT); }
__device__ __forceinline__ unsigned xb_xcc_id() { return (unsigned)__builtin_amdgcn_s_getreg((3 << 11) | 20) & 0xFu; }
#define XB_SPIN(cond, bar) do { unsigned _sp = 0; while (cond) { __builtin_amdgcn_s_sleep(1); \
    if ((++_sp & 255u) == 0u) { if (xb_ld(&(bar)[XB_TMO])) break; if (_sp > XB_SPIN_CAP) { atomicAdd(&(bar)[XB_TMO], 1u); break; } } } } while (0)

struct XcdBarrier {
    unsigned* bar; unsigned x;
    volatile LAS unsigned* st;
};

__device__ __forceinline__ XcdBarrier xcd_barrier_post(unsigned* bar, volatile LAS unsigned* st) {
    XcdBarrier b; b.bar = bar; b.x = xb_xcc_id(); b.st = st;
    if (threadIdx.x == 0) (void)xb_add(&bar[XB_XCNT(b.x)], 1u);
    return b;
}
__device__ __forceinline__ void xcd_barrier_complete(unsigned* bar, unsigned x, unsigned& nloc, unsigned& nx) {
    const unsigned G = gridDim.x * gridDim.y * gridDim.z;
    unsigned sum, cnt, mine, sp = 0u;
    for (;;) {
        sum = 0u; cnt = 0u; mine = 0u;
#pragma unroll
        for (unsigned j = 0; j < 16; ++j) { const unsigned c = xb_ld(&bar[XB_XCNT(j)]); sum += c; cnt += (c > 0u) ? 1u : 0u; mine = (j == x) ? c : mine; }
        if (sum == G) break;
        __builtin_amdgcn_s_sleep(1);
        if ((++sp & 255u) == 0u) { if (xb_ld(&bar[XB_TMO])) break; if (sp > XB_SPIN_CAP) { atomicAdd(&bar[XB_TMO], 1u); break; } }
    }
    nloc = mine > 0u ? mine : 1u; nx = cnt > 0u ? cnt : 1u;
}

__device__ __forceinline__ void xcd_barrier(const XcdBarrier& b) {
    asm volatile("s_waitcnt vmcnt(0)" ::: "memory");
    __syncthreads();
    if (threadIdx.x == 0) {
        unsigned* bar = b.bar;
        __builtin_amdgcn_s_waitcnt(0);
        unsigned nloc = b.st[0], nx = b.st[1];
        if (nloc == 0u) { xcd_barrier_complete(bar, b.x, nloc, nx); b.st[0] = nloc; b.st[1] = nx; }
        const unsigned old = xb_add(&bar[XB_XSUB(b.x)], 1u);
        const unsigned gen = old / nloc;
        if (old + 1u == (gen + 1u) * nloc) {
            __builtin_amdgcn_fence(__ATOMIC_RELEASE, "agent");
            asm volatile("s_waitcnt vmcnt(0)" ::: "memory");
            const unsigned og = xb_add(&bar[XB_TOP], 1u);
            const unsigned tg = og / nx;
            if (og + 1u == (tg + 1u) * nx) xb_add(&bar[XB_TOPGEN], 1u);
            else XB_SPIN(xb_ld(&bar[XB_TOPGEN]) == tg, bar);
            __builtin_amdgcn_fence(__ATOMIC_ACQUIRE, "agent");
            xb_add(&bar[XB_XGEN(b.x)], 1u);
            asm volatile("s_waitcnt vmcnt(0)" ::: "memory");
        } else {
            XB_SPIN(xb_ld(&bar[XB_XGEN(b.x)]) == gen, bar);
            __builtin_amdgcn_fence(__ATOMIC_ACQUIRE, "agent");
            asm volatile("s_waitcnt vmcnt(0)" ::: "memory");
        }
    }
    __syncthreads();
}

constexpr size_t CTL_XBAR = 704 * 1024;
static_assert(CTL_XBAR + XCD_BAR_WORDS * 4 <= CTL_BYTES, "barrier words inside the memset");
#define PH_BEGIN(k) do { if (PROBE_PH == (k) && blockIdx.x == 0 && threadIdx.x == 0) pt0 = __builtin_amdgcn_s_memrealtime(); } while (0)
#define PH_END(k) do { if (PROBE_PH == (k) && blockIdx.x == 0 && threadIdx.x == 0) pt1 = __builtin_amdgcn_s_memrealtime(); } while (0)
__global__ void __launch_bounds__(512, 2) k_mega(Params p) {
    extern __shared__ __attribute__((aligned(16))) unsigned char lds_raw[];
    LAS unsigned char* lds = (LAS unsigned char*)lds_raw;
    cg::grid_group grid = cg::this_grid();
    const int wg = blockIdx.x, nwg = gridDim.x;
    bf16_t* ymix = (bf16_t*)(p.ws + WS_R);
    float* rowss1 = (float*)(p.ws + WS_CTL); float* rowss2 = rowss1 + M;
    unsigned long long pt0 = 0, pt1 = 0;
    volatile LAS unsigned* xbst = (volatile LAS unsigned*)(lds + LDS_BYTES_C - 64);
    if (threadIdx.x < 2) xbst[threadIdx.x] = 0u;
    __syncthreads();
    const XcdBarrier xbar = xcd_barrier_post((unsigned*)(p.ws + WS_CTL + CTL_XBAR), xbst);
    grid.sync();
    PH_BEGIN(1);
    phase_p0a(p, lds, wg, nwg);
    xcd_barrier(xbar);
    PH_END(1); PH_BEGIN(2);
    run_gemm(lds, (const bf16_t*)p.out, (const bf16_t*)(p.ws + WS_WIN), M, NP, DM, EpiP{p.ws});
    xcd_barrier(xbar);
    PH_END(2); PH_BEGIN(3);
    phase_rwkv_pre(p, wg, nwg);
    phase_ssd1(p, lds, wg, nwg);
    xcd_barrier(xbar);
    PH_END(3); PH_BEGIN(4); PH_BEGIN(10);
#if RWKV_CHUNKED == 0
    phase_ssd2(p, wg, nwg);
#endif
    PH_END(10);
#if RWKV_CHUNKED == 2
    phase_rwkv_dist(p, lds, wg, nwg);
#elif RWKV_CHUNKED == 1
    phase_rwkv_chunked(p, lds, wg, nwg);
#else
    phase_rwkv_scan(p, lds, wg, nwg);
#endif
    if (PROBE_PH == 12 || PROBE_PH == 22 || PROBE_PH == 21) __syncthreads();
    if ((PROBE_PH == 11 || PROBE_PH == 12 || PROBE_PH == 13 || PROBE_PH == 21 || PROBE_PH == 22) && blockIdx.x == 0 && threadIdx.x == 0) { pt0 = 0; pt1 = *(LAS unsigned long long*)(lds + 163840 - 16); }
    xcd_barrier(xbar);
    PH_END(4); PH_BEGIN(5); PH_BEGIN(14);
    phase_ssd3(p, ymix, lds, wg, nwg);
    if (PROBE_PH == 14) { asm volatile("s_waitcnt vmcnt(0)" ::: "memory"); } PH_END(14);
    phase_rwkv_post(p, ymix, lds, wg, nwg);
    xcd_barrier(xbar);
    PH_END(5); PH_BEGIN(6); PH_BEGIN(15);
    phase_p0b(p, lds, wg, nwg);
    if (PROBE_PH == 15) { asm volatile("s_waitcnt vmcnt(0)" ::: "memory"); } PH_END(15);
    __syncthreads();
    run_gemm(lds, ymix, (const bf16_t*)(p.ws + WS_WOUT), M, DM, D_MIX, EpiOut{p.in[I_X], (bf16_t*)(p.ws + WS_H1B), rowss1, 0.f});
    xcd_barrier(xbar);
    PH_END(6); PH_BEGIN(7);
    run_gemm(lds, (const bf16_t*)(p.ws + WS_H1B), (const bf16_t*)(p.ws + WS_WGU), M, NGU, DM, EpiGU{rowss1, (bf16_t*)(p.ws + WS_ACT)});
    xcd_barrier(xbar);
    PH_END(7); PH_BEGIN(8);
    run_gemm(lds, (const bf16_t*)(p.ws + WS_ACT), (const bf16_t*)(p.ws + WS_WDN), M, DM, D_FF, EpiDown{(const bf16_t*)(p.ws + WS_H1B), (bf16_t*)(p.ws + WS_H2B), rowss2, 0.f});
    xcd_barrier(xbar);
    PH_END(8); PH_BEGIN(9);
    phase_final(p, wg, nwg);
    PH_END(9);
    if (PROBE_PH != 0 && blockIdx.x == 0 && threadIdx.x == 0) { const unsigned long long t0 = __builtin_amdgcn_s_memrealtime(), d = pt1 - pt0; while (__builtin_amdgcn_s_memrealtime() - t0 < d) __builtin_amdgcn_s_sleep(8); }
}

constexpr int LDS_BYTES = 163840;
extern "C" void kernel_launch(void* const* d_in, const int* in_sizes, int n_in, void* d_out, int out_size, void* d_ws, size_t ws_size, hipStream_t stream) {
    static int grid = 0;
    if (grid == 0) {
        if (n_in != 26 || ws_size < WS_END) { fprintf(stderr, "kernel_launch: unexpected n_in %d / ws_size %zu\n", n_in, ws_size); grid = -1; return; }
        int dev = 0, cus = 0, per_cu = 0;
        (void)hipGetDevice(&dev);
        (void)hipDeviceGetAttribute(&cus, hipDeviceAttributeMultiprocessorCount, dev);
        (void)hipFuncSetAttribute((const void*)k_mega, hipFuncAttributeMaxDynamicSharedMemorySize, LDS_BYTES);
        (void)hipOccupancyMaxActiveBlocksPerMultiprocessor(&per_cu, (const void*)k_mega, 512, LDS_BYTES);
        if (per_cu < 1) { fprintf(stderr, "kernel_launch: occupancy query says %d blocks/CU\n", per_cu); grid = -1; return; }
        grid = cus;
        fprintf(stderr, "kernel_launch: cus %d per_cu %d grid %d ws %zu\n", cus, per_cu, grid, ws_size);
    }
    if (grid < 0) return;
    Params p{};
    for (int i = 0; i < 26; ++i) p.in[i] = (const float*)d_in[i];
    p.out = (float*)d_out; p.ws = (unsigned char*)d_ws;
    (void)hipMemsetAsync((char*)d_ws + WS_CTL, 0, CTL_BYTES, stream);
    void* args[] = {&p};
    hipError_t e = hipLaunchCooperativeKernel((const void*)k_mega, dim3(grid), dim3(512), args, LDS_BYTES, stream);
    if (e != hipSuccess) fprintf(stderr, "cooperative launch failed: %s (grid %d)\n", hipGetErrorString(e), grid);
}
```

```cpp
#include <hip/hip_runtime.h>
#include <hip/hip_cooperative_groups.h>
#include <cstdio>
#include <cstdint>

#ifndef RWKV_CHUNKED
#define RWKV_CHUNKED 2
#endif
#ifndef PROBE_PH
#define PROBE_PH 0
#endif
#define LAS __attribute__((address_space(3)))
#define LDS_BARRIER() do { asm volatile("s_waitcnt lgkmcnt(0)" ::: "memory"); __builtin_amdgcn_s_barrier(); asm volatile("" ::: "memory"); } while (0)
constexpr int LDS_BYTES_C = 163840;
namespace cg = cooperative_groups;
typedef unsigned short bf16_t;
typedef short bf16x8 __attribute__((ext_vector_type(8)));
typedef float f32x4 __attribute__((ext_vector_type(4)));
typedef unsigned u32x4 __attribute__((ext_vector_type(4)));
typedef unsigned u32x2 __attribute__((ext_vector_type(2)));
typedef float f32x2 __attribute__((ext_vector_type(2)));

constexpr int BATCH = 2, SEQ = 8192, DM = 2048, M = BATCH * SEQ;
constexpr int D_SSD = 2048, D_RWKV = 2048, D_MIX = 4096, NHEAD = 32, HD = 64, NGRP = 4, NSTATE = 128;
constexpr int D_XBC = 3072, D_IN = 11744, NP = 11776  , D_FF = 5632, NGU = 11264;
constexpr int LW = 96, LG = 256;
constexpr float RMS_EPS = 1e-6f, GATED_EPS = 1e-5f, GN_EPS = 64e-5f;
constexpr int O_Z = 0, O_XBC = 2048, O_DT = 5120, O_R = 5152, O_K = 7200, O_V = 9248, O_WD = 11296, O_AD = 11392, O_GD = 11488;
constexpr int MU_R = 0, MU_K = 2048, MU_V = 4096, MU_WD = 6144, MU_AD = 6240, MU_GD = 6336;

constexpr size_t MiB = 1u << 20;
constexpr size_t WS_CTL = 0, CTL_BYTES = 1 * MiB;
constexpr size_t WS_WIN = 1 * MiB;
constexpr size_t WS_WOUT = 47 * MiB;
constexpr size_t WS_G2 = 63 * MiB;
constexpr size_t WS_Z = 64 * MiB;
constexpr size_t WS_XBC = 128 * MiB;
constexpr size_t WS_V = 224 * MiB;
constexpr size_t WS_SM = 288 * MiB;
constexpr size_t WS_GD = 304 * MiB;
constexpr size_t WS_R = 312 * MiB;
constexpr size_t WS_K = 376 * MiB;
constexpr size_t WS_FREE = 440 * MiB;
constexpr size_t WS_H2B = 64 * MiB;
constexpr size_t WS_H1B = 192 * MiB;
constexpr size_t WS_ACT = 256 * MiB;
constexpr size_t WS_WGU = 440 * MiB;
constexpr size_t WS_WDN = 484 * MiB;
constexpr size_t WS_END = 512 * MiB;
static_assert(WS_WDN + (size_t)2048 * 5632 * 2 <= WS_END, "ws map");

struct Params {
    const float* in[26];
    float* out;
    unsigned char* ws;
};
enum { I_X = 0, I_N1G, I_WIN, I_CONVW, I_CONVB, I_DTB, I_ALOG, I_SSDD, I_SSDNG, I_MU, I_W0, I_W2, I_A0, I_A2, I_G2, I_KK, I_KA, I_RK, I_GNW, I_GNB, I_WOUT, I_N2G, I_WGATE, I_WUP, I_WDOWN, I_NFG };

__device__ __forceinline__ unsigned f2bf(float f) { unsigned u = __builtin_bit_cast(unsigned, f); return (u + 0x7fffu + ((u >> 16) & 1u)) >> 16; }
__device__ __forceinline__ unsigned pk2(float lo, float hi) { return f2bf(lo) | (f2bf(hi) << 16); }
__device__ __forceinline__ float bf2f(bf16_t v) { return __builtin_bit_cast(float, (unsigned)v << 16); }
__device__ __forceinline__ float wave_sum(float v) {
#pragma unroll
    for (int o = 1; o < 64; o <<= 1) v += __shfl_xor(v, o);
    return v;
}
__device__ __forceinline__ int otid() { int t = threadIdx.x; asm volatile("" : "+v"(t)); return t; }
__device__ __forceinline__ float sigmoidf_(float x) { return __builtin_amdgcn_rcpf(1.f + __expf(-x)); }
__device__ __forceinline__ float siluf_(float x) { return x * __builtin_amdgcn_rcpf(1.f + __expf(-x)); }
__device__ __forceinline__ float softplusf_(float x) { return fmaxf(x, 0.f) + log1pf(__expf(-fabsf(x))); }

__device__ __forceinline__ void transpose_item(const float* W, int ldw, int K, bf16_t* WT, int n_dst0, int src_col0, const float* kscale, LAS float* scr, int kb, int nb, int lane) {
    const int k0 = 64 * kb, n0 = 32 * nb;
    const int r8 = lane >> 3, n4 = lane & 7;
    f32x4 v[8];
#pragma unroll
    for (int i = 0; i < 8; ++i) v[i] = __builtin_nontemporal_load((const f32x4*)(W + (size_t)(k0 + 8 * i + r8) * ldw + src_col0 + n0 + 4 * n4));
#pragma unroll
    for (int i = 0; i < 8; ++i) { const int kk = 8 * i + r8; f32x4 x = v[i]; if (kscale) x = x * kscale[k0 + kk];
        LAS float* d = scr + kk * 33 + 4 * n4; d[0] = x.x; d[1] = x.y; d[2] = x.z; d[3] = x.w; }
    asm volatile("s_waitcnt lgkmcnt(0)" ::: "memory");
    const int c = lane & 7;
#pragma unroll
    for (int j = 0; j < 4; ++j) { const int n = (lane >> 3) + 8 * j; const LAS float* s = scr + (8 * c) * 33 + n;
        u32x4 o; o.x = pk2(s[0 * 33], s[1 * 33]); o.y = pk2(s[2 * 33], s[3 * 33]); o.z = pk2(s[4 * 33], s[5 * 33]); o.w = pk2(s[6 * 33], s[7 * 33]);
        *(u32x4*)(WT + (size_t)(n_dst0 + n0 + n) * K + k0 + 8 * c) = o; }
    asm volatile("s_waitcnt lgkmcnt(0)" ::: "memory");
}
__device__ __forceinline__ void convert_seg(const float* W, int ldw, int K, bf16_t* WT, int n_dst0, int count, int src_col0, const float* kscale, LAS float* scr, int gw, int ngw, int lane) {
    const int nblk = count / 32, nit = (K / 64) * nblk;
    for (int it = gw; it < nit; it += ngw) transpose_item(W, ldw, K, WT, n_dst0, src_col0, kscale, scr, it / nblk, it % nblk, lane);
}
__device__ __forceinline__ void zero_rows(bf16_t* WT, int K, int n0, int count, int gw, int ngw, int lane) {
    const int chunks = count * K / 8;
    u32x4 z = {0u, 0u, 0u, 0u};
    for (int i = gw * 64 + lane; i < chunks; i += ngw * 64) *(u32x4*)(WT + (size_t)n0 * K + (size_t)i * 8) = z;
}

__device__ void phase_p0a(const Params& p, LAS unsigned char* lds, int wg, int nwg) {
    const int tid = otid(), lane = tid & 63, wave = tid >> 6;
    LAS float* scr = (LAS float*)(lds + wave * 16384);
    const int gw = wg * 8 + wave, ngw = nwg * 8;
    bf16_t* WIN = (bf16_t*)(p.ws + WS_WIN); bf16_t* WOUT = (bf16_t*)(p.ws + WS_WOUT);
    const float* w_in = p.in[I_WIN];
    convert_seg(w_in, D_IN, DM, WIN, 0, 2048, O_Z, nullptr, scr, gw, ngw, lane);
    convert_seg(w_in, D_IN, DM, WIN, 2048, 3072, O_XBC, nullptr, scr, gw, ngw, lane);
    convert_seg(w_in, D_IN, DM, WIN, 5120, 2048, O_R, nullptr, scr, gw, ngw, lane);
    convert_seg(w_in, D_IN, DM, WIN, 7168, 2048, O_K, nullptr, scr, gw, ngw, lane);
    convert_seg(w_in, D_IN, DM, WIN, 9216, 2048, O_V, nullptr, scr, gw, ngw, lane);
    convert_seg(w_in, D_IN, DM, WIN, 11264, 32, O_DT, nullptr, scr, gw, ngw, lane);
    convert_seg(w_in, D_IN, DM, WIN, 11296, 96, O_WD, nullptr, scr, gw, ngw, lane);
    convert_seg(w_in, D_IN, DM, WIN, 11392, 96, O_AD, nullptr, scr, gw, ngw, lane);
    zero_rows(WIN, DM, 11488, 32, gw, ngw, lane);
    convert_seg(w_in, D_IN, DM, WIN, 11520, 256, O_GD, nullptr, scr, gw, ngw, lane);
    convert_seg(p.in[I_WOUT], DM, D_MIX, WOUT, 0, 2048, 0, nullptr, scr, gw, ngw, lane);
    convert_seg(p.in[I_G2], D_RWKV, LG, (bf16_t*)(p.ws + WS_G2), 0, 2048, 0, nullptr, scr, gw, ngw, lane);
    bf16_t* U = (bf16_t*)p.out; const float* x = p.in[I_X]; const float* g1 = p.in[I_N1G];
    for (int m = gw; m < M; m += ngw) {
        const f32x4* xr = (const f32x4*)(x + (size_t)m * DM) + lane; f32x4 v[8]; float s = 0.f;
#pragma unroll
        for (int j = 0; j < 8; ++j) { v[j] = __builtin_nontemporal_load(&xr[64 * j]); s += (v[j].x * v[j].x + v[j].y * v[j].y) + (v[j].z * v[j].z + v[j].w * v[j].w); }
        const float rstd = 1.f / sqrtf(wave_sum(s) * (1.f / DM) + RMS_EPS);
        u32x2* o = (u32x2*)(U + (size_t)m * DM) + lane;
#pragma unroll
        for (int j = 0; j < 8; ++j) { const f32x4 g = ((const f32x4*)g1)[64 * j + lane]; u32x2 w; w.x = pk2(v[j].x * rstd * g.x, v[j].y * rstd * g.y); w.y = pk2(v[j].z * rstd * g.z, v[j].w * rstd * g.w); o[64 * j] = w; }
    }
}
__device__ void phase_p0b(const Params& p, LAS unsigned char* lds, int wg, int nwg) {
    const int tid = otid(), lane = tid & 63, wave = tid >> 6;
    LAS float* scr = (LAS float*)(lds + wave * 16384);
    const int gw = wg * 8 + wave, ngw = nwg * 8;
    bf16_t* WGU = (bf16_t*)(p.ws + WS_WGU); bf16_t* WDN = (bf16_t*)(p.ws + WS_WDN);
    const int nblk = 4, per_half = (DM / 64) * nblk, nit = (D_FF / 128) * 2 * per_half;
    for (int it = gw; it < nit; it += ngw) {
        const int th = it / per_half, r = it % per_half, tile = th >> 1, half = th & 1;
        transpose_item(half ? p.in[I_WUP] : p.in[I_WGATE], D_FF, DM, WGU, 256 * tile + 128 * half, 128 * tile, p.in[I_N2G], scr, r / nblk, r % nblk, lane);
    }
    convert_seg(p.in[I_WDOWN], DM, D_FF, WDN, 0, 2048, 0, nullptr, scr, gw, ngw, lane);
}

namespace pg8 {
#define PG8_LAS __attribute__((address_space(3)))
typedef unsigned short bf16_t;
typedef short bf16x8 __attribute__((ext_vector_type(8)));
typedef float f32x4 __attribute__((ext_vector_type(4)));
typedef unsigned u32x4 __attribute__((ext_vector_type(4)));
constexpr int BM = 256, BK = 64, HALF = 128, HTB = HALF * BK * 2  , STAGE_BYTES = 8 * HTB, NXCD = 8, WGM = 8;

__host__ __device__ __forceinline__ int lds_byte(int r, int c) { const int st = (r >> 4) * 2 + (c >> 5), rr = r & 15, cc = c & 31, ob = rr * 64 + cc * 2; return st * 1024 + (ob ^ (((ob >> 9) & 1) << 5)); }
__host__ __device__ __forceinline__ void stage_rc(int b, int& R, int& C) { const int st = b / 1024, sb = b % 1024, swz = sb ^ (((sb >> 9) & 1) << 5); R = (st >> 1) * 16 + swz / 64; C = (st & 1) * 32 + (swz % 64) / 2; }
__host__ __device__ __forceinline__ int perm32(int rho) { const int n = rho >> 4, i = rho & 15; return 8 * (i >> 2) + 4 * n + (i & 3); }

struct Unit { int pm, pn; };
struct Gemm { const bf16_t* A; const bf16_t* Bt; int M, N, K; };

struct StaticOrder {
    int nM, nN, nwg, G, c;
    __host__ __device__ void init(int M, int N, int G_, int c_) { nM = M / BM; nN = N / BM; nwg = nM * nN; G = G_; c = c_; }
    __host__ __device__ bool next(int i, Unit& u) const {
        const long L = (long)i * G + c; if (L >= nwg) return false;
        int wgid = (int)L; { const int q = nwg / NXCD, r = nwg % NXCD, xcd = wgid % NXCD, off = wgid / NXCD; wgid = (xcd < r ? xcd * (q + 1) : r * (q + 1) + (xcd - r) * q) + off; }
        const int nig = WGM * nN, gid = wgid / nig, fm = gid * WGM, gsz = (nM - fm) < WGM ? (nM - fm) : WGM;
        u.pm = fm + ((wgid % nig) % gsz); u.pn = (wgid % nig) / gsz; return true;
    }
    __device__ __forceinline__ void a_ready(const Unit&) const {}
    __device__ __forceinline__ void done(const Unit&) const {}
};

typedef float f32x2_ __attribute__((ext_vector_type(2))); typedef __bf16 bf16v2_ __attribute__((ext_vector_type(2)));
__device__ __forceinline__ unsigned cvt_pk_bf16(float lo, float hi) { unsigned r; asm volatile("v_cvt_pk_bf16_f32 %0, %1, %2" : "=v"(r) : "v"(lo), "v"(hi)); return r; }
__device__ __forceinline__ unsigned cvt_pk_bf16_c(float lo, float hi) { const f32x2_ v = {lo, hi}; return __builtin_bit_cast(unsigned, __builtin_convertvector(v, bf16v2_)); }

template <class F> struct EpiAdapt {
    static constexpr bool PERM = true, AFTER_DRAIN = false;
    F f;
    __device__ __forceinline__ void operator()(const f32x4 (&acc)[2][2][4][2], const Unit& u, int wr, int wc, int fr, int fq) const {
        F g = f;
        if constexpr (F::PAIR) {
            float rs[2][4];
#pragma unroll
            for (int ai = 0; ai < 2; ++ai)
#pragma unroll
                for (int m = 0; m < 4; ++m) rs[ai][m] = g.rowscale(u.pm * BM + ai * HALF + wr * 64 + m * 16 + fr);
#pragma unroll
            for (int ai = 0; ai < 2; ++ai)
#pragma unroll
                for (int m = 0; m < 4; ++m) {
                    const int row = u.pm * BM + ai * HALF + wr * 64 + m * 16 + fr;
                    g.begin();
                    g.pair8(row, u.pn, wc * 32 + 8 * fq, acc[ai][0][m][0], acc[ai][0][m][1], acc[ai][1][m][0], acc[ai][1][m][1], rs[ai][m]);
                    g.end(row);
                }
        } else if constexpr (F::PRE_N > 0) {
#pragma unroll
            for (int ai = 0; ai < 2; ++ai) {
                typename F::PreT pre[4][2][F::PRE_N];
#pragma unroll
                for (int m = 0; m < 4; ++m)
#pragma unroll
                    for (int bj = 0; bj < 2; ++bj) g.pre(u.pm * BM + ai * HALF + wr * 64 + m * 16 + fr, u.pn, bj * HALF + wc * 32 + 8 * fq, pre[m][bj]);
#pragma unroll
                for (int m = 0; m < 4; ++m) {
                    const int row = u.pm * BM + ai * HALF + wr * 64 + m * 16 + fr;
                    g.begin();
#pragma unroll
                    for (int bj = 0; bj < 2; ++bj) g.octp(row, u.pn, bj * HALF + wc * 32 + 8 * fq, acc[ai][bj][m][0], acc[ai][bj][m][1], pre[m][bj]);
                    g.end(row);
                }
            }
        } else {
#pragma unroll
            for (int ai = 0; ai < 2; ++ai)
#pragma unroll
                for (int m = 0; m < 4; ++m) {
                    const int row = u.pm * BM + ai * HALF + wr * 64 + m * 16 + fr;
                    g.begin();
#pragma unroll
                    for (int bj = 0; bj < 2; ++bj) g.oct(row, u.pn, bj * HALF + wc * 32 + 8 * fq, acc[ai][bj][m][0], acc[ai][bj][m][1]);
                    g.end(row);
                }
        }
    }
};
template <class Epi, class Sched, bool ALIGN_EPI = false, bool SP2 = false>
__device__ __forceinline__ void gemm_phase(PG8_LAS unsigned char* lds, const Gemm g, const Sched& S, const Epi& E) {
    int tid_ = threadIdx.x; asm volatile("" : "+v"(tid_));
    const int tid = tid_, wid = __builtin_amdgcn_readfirstlane(tid >> 6), lane = tid & 63, wr = wid >> 2, wc = wid & 3, fr = lane & 15, fq = lane >> 4;
    const int K = g.K, nt = K / BK;
    unsigned voffA[2], voffB[2];
#pragma unroll
    for (int i = 0; i < 2; ++i) { int R, C; stage_rc(tid * 16 + i * 8192, R, C); const int Rb = Epi::PERM ? ((R & ~31) + perm32(R & 31)) : R;
        voffA[i] = (unsigned)(R * K + C) * 2u; voffB[i] = (unsigned)(Rb * K + C) * 2u; }
    const size_t kstep = (size_t)(BK * 2);
    const size_t hstep = (size_t)HALF * K * 2;
    const size_t tstep = 2 * hstep;
    const unsigned ldsw = (unsigned)wid * 1024u;
    const int aoff = lds_byte(wr * 64 + fr, fq * 8), boff = lds_byte(wc * 32 + fr, fq * 8);
#define PG8_SA(b, h) (((b) * 2 + (h)) * HTB)
#define PG8_SB(b, h) ((4 + (b) * 2 + (h)) * HTB)
    const auto rsA_ = __builtin_amdgcn_make_buffer_rsrc((void*)g.A, 0, 0x7ffffffe, 0x00020000);
    const auto rsB_ = __builtin_amdgcn_make_buffer_rsrc((void*)g.Bt, 0, 0x7ffffffe, 0x00020000);
#define PG8_STAGE_A(bufoff, gbase, voff) do { const int so_ = (int)((const char*)(gbase) - (const char*)g.A); _Pragma("unroll") for (int _i = 0; _i < 2; ++_i) \
        __builtin_amdgcn_raw_ptr_buffer_load_lds(rsA_, (PG8_LAS unsigned*)(lds + (bufoff) + ldsw + _i * 8192), 16, (int)(voff)[_i], so_, 0, 0); } while (0)
#define PG8_STAGE_B(bufoff, gbase, voff) do { const int so_ = (int)((const char*)(gbase) - (const char*)g.Bt); _Pragma("unroll") for (int _i = 0; _i < 2; ++_i) \
        __builtin_amdgcn_raw_ptr_buffer_load_lds(rsB_, (PG8_LAS unsigned*)(lds + (bufoff) + ldsw + _i * 8192), 16, (int)(voff)[_i], so_, 0, 0); } while (0)
#define PG8_LDA(dst, b, h) do { _Pragma("unroll") for (int m = 0; m < 4; ++m) _Pragma("unroll") for (int k = 0; k < 2; ++k) dst[m][k] = *(const PG8_LAS bf16x8*)(lds + PG8_SA(b, h) + aoff + m * 2048 + k * 1024); } while (0)
#define PG8_LDB(dst, b, h) do { _Pragma("unroll") for (int n = 0; n < 2; ++n) _Pragma("unroll") for (int k = 0; k < 2; ++k) dst[n][k] = *(const PG8_LAS bf16x8*)(lds + PG8_SB(b, h) + boff + n * 2048 + k * 1024); } while (0)
#define PG8_MMA(ai, bj, At, Bt) do { __builtin_amdgcn_s_setprio(1); _Pragma("unroll") for (int m = 0; m < 4; ++m) _Pragma("unroll") for (int n = 0; n < 2; ++n) _Pragma("unroll") for (int k = 0; k < 2; ++k) \
        acc[ai][bj][m][n] = __builtin_amdgcn_mfma_f32_16x16x32_bf16(Bt[n][k], At[m][k], acc[ai][bj][m][n], 0, 0, 0); __builtin_amdgcn_s_setprio(0); } while (0)
#define PG8_WAIT_V(n) asm volatile("s_waitcnt vmcnt(" #n ")" ::: "memory")
#define PG8_WAIT_L(n) asm volatile("s_waitcnt lgkmcnt(" #n ")" ::: "memory")
#define PG8_BAR __builtin_amdgcn_s_barrier()
#define PG8_SCHED __builtin_amdgcn_sched_barrier(0)
    Unit cur, nxt; int ui = 0;
    if (!S.next(0, cur)) return;
    f32x4 acc[2][2][4][2];
#pragma unroll
    for (int a = 0; a < 2; ++a)
#pragma unroll
        for (int b = 0; b < 2; ++b)
#pragma unroll
            for (int m = 0; m < 4; ++m)
#pragma unroll
                for (int n = 0; n < 2; ++n) acc[a][b][m][n] = (f32x4){0.f, 0.f, 0.f, 0.f};
    bf16x8 At[4][2], B0[2][2], B1[2][2];
    const char* cA = (const char*)g.A + (size_t)cur.pm * tstep; const char* cB = (const char*)g.Bt + (size_t)cur.pn * tstep;
    S.a_ready(cur);
    if constexpr (SP2) {
        PG8_STAGE_B(PG8_SB(0, 0), cB, voffB); PG8_STAGE_B(PG8_SB(0, 1), cB + hstep, voffB); PG8_STAGE_A(PG8_SA(0, 0), cA, voffA); PG8_STAGE_A(PG8_SA(0, 1), cA + hstep, voffA);
        if (wr == 1) PG8_BAR;
        PG8_WAIT_V(2); PG8_BAR;
        PG8_STAGE_B(PG8_SB(1, 0), cB + kstep, voffB); PG8_STAGE_A(PG8_SA(1, 0), cA + kstep, voffA); PG8_STAGE_B(PG8_SB(1, 1), cB + hstep + kstep, voffB);
        PG8_WAIT_V(6); PG8_BAR;
    } else {
        PG8_STAGE_B(PG8_SB(0, 0), cB, voffB); PG8_STAGE_A(PG8_SA(0, 0), cA, voffA); PG8_STAGE_B(PG8_SB(0, 1), cB + hstep, voffB); PG8_STAGE_A(PG8_SA(0, 1), cA + hstep, voffA);
        if (wr == 1) PG8_BAR;
        PG8_WAIT_V(4); PG8_BAR;
        PG8_STAGE_B(PG8_SB(1, 0), cB + kstep, voffB); PG8_STAGE_A(PG8_SA(1, 0), cA + kstep, voffA); PG8_STAGE_B(PG8_SB(1, 1), cB + hstep + kstep, voffB);
        PG8_WAIT_V(6); PG8_BAR;
    }
    for (;;) {
        const bool has_next = S.next(ui + 1, nxt);
        const char* nA = has_next ? (const char*)g.A + (size_t)nxt.pm * tstep : cA; const char* nB = has_next ? (const char*)g.Bt + (size_t)nxt.pn * tstep : cB;
        for (int t = 0; t < nt; t += 2) {
            const bool last = (t == nt - 2);
            const char* a1 = cA + (size_t)(t + 1) * kstep;
            const char* a2 = last ? nA : cA + (size_t)(t + 2) * kstep; const char* b2 = last ? nB : cB + (size_t)(t + 2) * kstep;
            const char* a3 = a2 + kstep; const char* b3 = b2 + kstep;
            if (last && has_next) S.a_ready(nxt);
            if constexpr (SP2) {
            PG8_LDB(B0, 0, 0); PG8_LDB(B1, 0, 1); PG8_SCHED; PG8_LDA(At, 0, 0); PG8_STAGE_A(PG8_SA(1, 1), a1 + hstep, voffA);
            PG8_WAIT_V(8); PG8_WAIT_L(0); PG8_BAR; PG8_MMA(0, 0, At, B0); PG8_MMA(0, 1, At, B1); PG8_BAR; PG8_SCHED;
            PG8_LDA(At, 0, 1); PG8_STAGE_B(PG8_SB(0, 0), b2, voffB); PG8_STAGE_B(PG8_SB(0, 1), b2 + hstep, voffB); PG8_STAGE_A(PG8_SA(0, 0), a2, voffA);
            PG8_WAIT_V(8); PG8_WAIT_L(0); PG8_BAR; PG8_MMA(1, 0, At, B0); PG8_MMA(1, 1, At, B1); PG8_BAR; PG8_SCHED;
            PG8_LDB(B0, 1, 0); PG8_LDB(B1, 1, 1); PG8_SCHED; PG8_LDA(At, 1, 0); PG8_STAGE_A(PG8_SA(0, 1), a2 + hstep, voffA);
            PG8_WAIT_V(8); PG8_WAIT_L(0); PG8_BAR; PG8_MMA(0, 0, At, B0); PG8_MMA(0, 1, At, B1); PG8_BAR; PG8_SCHED;
            PG8_LDA(At, 1, 1); PG8_STAGE_B(PG8_SB(1, 0), b3, voffB); PG8_STAGE_B(PG8_SB(1, 1), b3 + hstep, voffB); PG8_STAGE_A(PG8_SA(1, 0), a3, voffA);
            PG8_WAIT_V(8); PG8_WAIT_L(0); PG8_BAR; PG8_MMA(1, 0, At, B0); PG8_MMA(1, 1, At, B1); PG8_BAR; PG8_SCHED;
            } else {
            PG8_LDB(B0, 0, 0); PG8_SCHED; PG8_LDA(At, 0, 0); PG8_STAGE_A(PG8_SA(1, 1), a1 + hstep, voffA);
            PG8_WAIT_L(8); PG8_BAR; PG8_WAIT_L(0); PG8_MMA(0, 0, At, B0); PG8_BAR; PG8_SCHED;
            PG8_LDB(B1, 0, 1); PG8_STAGE_B(PG8_SB(0, 0), b2, voffB);
            PG8_BAR; PG8_WAIT_L(0); PG8_MMA(0, 1, At, B1); PG8_BAR;
            PG8_LDA(At, 0, 1); PG8_STAGE_A(PG8_SA(0, 0), a2, voffA);
            PG8_BAR; PG8_WAIT_L(0); PG8_MMA(1, 0, At, B0); PG8_BAR; PG8_SCHED;
            PG8_STAGE_B(PG8_SB(0, 1), b2 + hstep, voffB);
            PG8_WAIT_V(6); PG8_BAR; PG8_MMA(1, 1, At, B1); PG8_BAR;
            PG8_LDB(B0, 1, 0); PG8_SCHED; PG8_LDA(At, 1, 0); PG8_STAGE_A(PG8_SA(0, 1), a2 + hstep, voffA);
            PG8_WAIT_L(8); PG8_BAR; PG8_WAIT_L(0); PG8_MMA(0, 0, At, B0); PG8_BAR; PG8_SCHED;
            PG8_LDB(B1, 1, 1); PG8_STAGE_B(PG8_SB(1, 0), b3, voffB);
            PG8_BAR; PG8_WAIT_L(0); PG8_MMA(0, 1, At, B1); PG8_BAR;
            PG8_LDA(At, 1, 1); PG8_STAGE_A(PG8_SA(1, 0), a3, voffA);
            PG8_BAR; PG8_WAIT_L(0); PG8_MMA(1, 0, At, B0); PG8_BAR; PG8_SCHED;
            PG8_STAGE_B(PG8_SB(1, 1), b3 + hstep, voffB);
            PG8_WAIT_V(6); PG8_BAR; PG8_MMA(1, 1, At, B1); PG8_BAR;
            }
        }
        if constexpr (ALIGN_EPI) { if (wr == 0) PG8_BAR; }
        if constexpr (!Epi::AFTER_DRAIN) { E(acc, cur, wr, wc, fr, fq); S.done(cur); }
        if (!has_next) break;
#pragma unroll
        for (int a = 0; a < 2; ++a)
#pragma unroll
            for (int b = 0; b < 2; ++b)
#pragma unroll
                for (int m = 0; m < 4; ++m)
#pragma unroll
                    for (int n = 0; n < 2; ++n) acc[a][b][m][n] = (f32x4){0.f, 0.f, 0.f, 0.f};
        cur = nxt; cA = nA; cB = nB; ++ui;
        if constexpr (ALIGN_EPI) { if (wr == 1) PG8_BAR; }
    }
    PG8_WAIT_V(0);
    if constexpr (!ALIGN_EPI) { if (wr == 0) PG8_BAR; }
    PG8_BAR;
    if constexpr (Epi::AFTER_DRAIN) { E.fused(acc, cur, wr, wc, fr, fq, lds, wid, lane); S.done(cur); }
#undef PG8_SA
#undef PG8_SB
#undef PG8_STAGE_A
#undef PG8_STAGE_B
#undef PG8_LDA
#undef PG8_LDB
#undef PG8_MMA
#undef PG8_WAIT_V
#undef PG8_WAIT_L
#undef PG8_BAR
#undef PG8_SCHED
}
}

__device__ __forceinline__ u32x4 pack8(f32x4 a, f32x4 b) { u32x4 w; w.x = pg8::cvt_pk_bf16(a.x, a.y); w.y = pg8::cvt_pk_bf16(a.z, a.w); w.z = pg8::cvt_pk_bf16(b.x, b.y); w.w = pg8::cvt_pk_bf16(b.z, b.w); return w; }
__device__ __forceinline__ f32x4 ld4bf(const bf16_t* p) { const u32x2 w = *(const u32x2*)p; f32x4 r; r.x = __builtin_bit_cast(float, w.x << 16); r.y = __builtin_bit_cast(float, w.x & 0xffff0000u); r.z = __builtin_bit_cast(float, w.y << 16); r.w = __builtin_bit_cast(float, w.y & 0xffff0000u); return r; }
__device__ __forceinline__ f32x4 up4(u32x2 w) { f32x4 r; r.x = __builtin_bit_cast(float, w.x << 16); r.y = __builtin_bit_cast(float, w.x & 0xffff0000u); r.z = __builtin_bit_cast(float, w.y << 16); r.w = __builtin_bit_cast(float, w.y & 0xffff0000u); return r; }
__device__ __forceinline__ float sumsq4(f32x4 h) { return (h.x * h.x + h.y * h.y) + (h.z * h.z + h.w * h.w); }
struct EpiP {
    static constexpr bool PAIR = false; static constexpr int PRE_N = 0;
    unsigned char* ws;
    __device__ __forceinline__ void begin() {}
    __device__ __forceinline__ void end(int) {}
    __device__ __forceinline__ void oct(int row, int pn, int c, f32x4 v0, f32x4 v1) {
        if (pn == 44) { float* d = (float*)(ws + WS_SM) + (size_t)row * 256 + c; *(f32x4*)d = v0; *(f32x4*)(d + 4) = v1; return; }
        bf16_t* base; int ld, col;
        if (pn < 8) { base = (bf16_t*)(ws + WS_Z); ld = 2048; col = pn * 256 + c; }
        else if (pn < 20) { base = (bf16_t*)(ws + WS_XBC); ld = 3072; col = (pn - 8) * 256 + c; }
        else if (pn < 44) {
            base = (bf16_t*)(ws + (pn < 28 ? WS_R : (pn < 36 ? WS_K : WS_V))); const int cs = ((pn - 20) & 7) * 256 + c, hd = cs >> 6;
            *(u32x4*)(base + ((size_t)((row / SEQ) * 32 + hd) * SEQ + (row % SEQ)) * 64 + (cs & 63)) = pack8(v0, v1); return; }
        else { base = (bf16_t*)(ws + WS_GD); ld = 256; col = c; }
        *(u32x4*)(base + (size_t)row * ld + col) = pack8(v0, v1);
    }
};
struct EpiOut {
    static constexpr bool PAIR = false; static constexpr int PRE_N = 2; typedef f32x4 PreT;
    const float* x; bf16_t* h1b; float* rowss; float s;
    __device__ __forceinline__ void begin() { s = 0.f; }
    __device__ __forceinline__ void pre(int row, int pn, int c, f32x4 (&q)[2]) const { const size_t off = (size_t)row * DM + pn * 256 + c; q[0] = *(const f32x4*)(x + off); q[1] = *(const f32x4*)(x + off + 4); }
    __device__ __forceinline__ void octp(int row, int pn, int c, f32x4 v0, f32x4 v1, const f32x4 (&q)[2]) {
        const size_t off = (size_t)row * DM + pn * 256 + c;
        const f32x4 a = q[0] + v0, b = q[1] + v1;
        *(u32x4*)(h1b + off) = pack8(a, b);
        s += sumsq4(a) + sumsq4(b);
    }
    __device__ __forceinline__ void end(int row) { float t = s; t += __shfl_xor(t, 16); t += __shfl_xor(t, 32); if ((otid() & 63) < 16) atomicAdd(rowss + row, t); }
};
struct EpiGU {
    static constexpr bool PAIR = true; static constexpr int PRE_N = 0;
    const float* rowss; bf16_t* act;
    __device__ __forceinline__ void begin() {}
    __device__ __forceinline__ void end(int) {}
    __device__ __forceinline__ float rowscale(int row) const { return rowss[row]; }
    __device__ __forceinline__ void pair8(int row, int pn, int c, f32x4 g0, f32x4 g1, f32x4 u0, f32x4 u1, float ss) {
        const float rs = __builtin_amdgcn_rsqf(ss * (1.f / DM) + RMS_EPS);
        g0 = g0 * rs; g1 = g1 * rs; u0 = u0 * rs; u1 = u1 * rs;
        f32x4 a, b;
        a.x = siluf_(g0.x) * u0.x; a.y = siluf_(g0.y) * u0.y; a.z = siluf_(g0.z) * u0.z; a.w = siluf_(g0.w) * u0.w;
        b.x = siluf_(g1.x) * u1.x; b.y = siluf_(g1.y) * u1.y; b.z = siluf_(g1.z) * u1.z; b.w = siluf_(g1.w) * u1.w;
        *(u32x4*)(act + (size_t)row * D_FF + pn * 128 + c) = pack8(a, b);
    }
};
struct EpiDown {
    static constexpr bool PAIR = false; static constexpr int PRE_N = 1; typedef u32x4 PreT;
    const bf16_t* h1b; bf16_t* h2b; float* rowss; float s;
    __device__ __forceinline__ void begin() { s = 0.f; }
    __device__ __forceinline__ void pre(int row, int pn, int c, u32x4 (&q)[1]) const { q[0] = *(const u32x4*)(h1b + (size_t)row * DM + pn * 256 + c); }
    __device__ __forceinline__ void octp(int row, int pn, int c, f32x4 v0, f32x4 v1, const u32x4 (&q)[1]) {
        const size_t off = (size_t)row * DM + pn * 256 + c;
        const u32x4 hw = q[0];
        const f32x4 a = up4((u32x2){hw.x, hw.y}) + v0, b = up4((u32x2){hw.z, hw.w}) + v1;
        *(u32x4*)(h2b + off) = pack8(a, b);
        s += sumsq4(a) + sumsq4(b);
    }
    __device__ __forceinline__ void end(int row) { float t = s; t += __shfl_xor(t, 16); t += __shfl_xor(t, 32); if ((otid() & 63) < 16) atomicAdd(rowss + row, t); }
};
template <class F> __device__ __forceinline__ void run_gemm(LAS unsigned char* lds, const bf16_t* A, const bf16_t* Bt, int Mr, int N, int K, const F& f) {
    pg8::Gemm g{A, Bt, Mr, N, K}; pg8::StaticOrder S; S.init(Mr, N, (int)gridDim.x, (int)blockIdx.x);
    pg8::EpiAdapt<F> E{f};
    pg8::gemm_phase<pg8::EpiAdapt<F>, pg8::StaticOrder, true, true>(lds, g, S, E);
}

constexpr int SSD_XT = 0;
constexpr int SSD_B = 73728;
constexpr int SSD_C = SSD_B + 18432;
constexpr int SSD_CB = SSD_C + 17408;
constexpr int SSD_ACS = SSD_CB + 17408;
constexpr int SSD_DT = SSD_ACS + 2048;
constexpr int SSD_PART = SSD_DT + 2048;
constexpr size_t WS_CD = 128 * 1024;
__device__ __forceinline__ void unpack8(u32x4 w, float (&f)[8]) {
    f[0] = __builtin_bit_cast(float, w.x << 16); f[1] = __builtin_bit_cast(float, w.x & 0xffff0000u); f[2] = __builtin_bit_cast(float, w.y << 16); f[3] = __builtin_bit_cast(float, w.y & 0xffff0000u);
    f[4] = __builtin_bit_cast(float, w.z << 16); f[5] = __builtin_bit_cast(float, w.z & 0xffff0000u); f[6] = __builtin_bit_cast(float, w.w << 16); f[7] = __builtin_bit_cast(float, w.w & 0xffff0000u);
}
template <bool WITH_C, bool B_TR>
__device__ __forceinline__ void ssd_stage(const Params& p, LAS unsigned char* lds, int b, int c, int g) {
    const int tid = otid(); constexpr int NCG = WITH_C ? 96 : 80;
    if (tid < NCG * 4) {
        const int cg = tid >> 2, seg = tid & 3;
        const int kind = cg < 64 ? 0 : (cg < 80 ? 1 : 2);
        const int col0 = kind == 0 ? 512 * g + 8 * cg : (kind == 1 ? 2048 + 128 * g + 8 * (cg - 64) : 2560 + 128 * g + 8 * (cg - 80));
        const float* cw = p.in[I_CONVW] + col0; const float* cb = p.in[I_CONVB] + col0;
        float w0[8], w1[8], w2[8], w3[8], bs[8];
#pragma unroll
        for (int i = 0; i < 8; ++i) { w0[i] = cw[i]; w1[i] = cw[D_XBC + i]; w2[i] = cw[2 * D_XBC + i]; w3[i] = cw[3 * D_XBC + i]; bs[i] = cb[i]; }
        const int tb = 64 * c + 16 * seg;
        const bf16_t* src = (const bf16_t*)(p.ws + WS_XBC) + ((size_t)b * SEQ + tb) * D_XBC + col0;
        const u32x4 zz = {0u, 0u, 0u, 0u};
        u32x4 rows[19];
        rows[0] = tb >= 3 ? *(const u32x4*)(src - 3 * D_XBC) : zz; rows[1] = tb >= 2 ? *(const u32x4*)(src - 2 * D_XBC) : zz; rows[2] = tb >= 1 ? *(const u32x4*)(src - 1 * D_XBC) : zz;
#pragma unroll
        for (int tt = 0; tt < 16; ++tt) rows[3 + tt] = *(const u32x4*)(src + (size_t)tt * D_XBC);
        float u1[8], u2[8], u3[8];
        unpack8(rows[0], u3); unpack8(rows[1], u2); unpack8(rows[2], u1);
#pragma unroll
        for (int hb = 0; hb < 2; ++hb) {
            float y[8][8];
#pragma unroll
            for (int tt = 0; tt < 8; ++tt) {
                float u0[8]; unpack8(rows[3 + 8 * hb + tt], u0);
#pragma unroll
                for (int i = 0; i < 8; ++i) { const float a = w0[i] * u3[i] + w1[i] * u2[i] + w2[i] * u1[i] + w3[i] * u0[i] + bs[i]; y[tt][i] = a * __builtin_amdgcn_rcpf(1.f + __expf(-a)); u3[i] = u2[i]; u2[i] = u1[i]; u1[i] = u0[i]; }
            }
            const bool tr = (kind == 0) || (kind == 1 && B_TR);
            if (tr) {
                LAS unsigned char* img = lds + (kind == 0 ? SSD_XT : SSD_B);
                const int r0 = kind == 0 ? 8 * cg : 8 * (cg - 64);
#pragma unroll
                for (int i = 0; i < 8; ++i) { u32x4 w; w.x = pg8::cvt_pk_bf16(y[0][i], y[1][i]); w.y = pg8::cvt_pk_bf16(y[2][i], y[3][i]); w.z = pg8::cvt_pk_bf16(y[4][i], y[5][i]); w.w = pg8::cvt_pk_bf16(y[6][i], y[7][i]);
                    *(LAS u32x4*)(img + ((r0 + i) * 72 + 16 * seg + 8 * hb) * 2) = w; }
            } else {
                LAS unsigned char* img = lds + (kind == 1 ? SSD_B : SSD_C);
                const int c0 = kind == 1 ? 8 * (cg - 64) : 8 * (cg - 80);
#pragma unroll
                for (int tt = 0; tt < 8; ++tt) { u32x4 w; w.x = pg8::cvt_pk_bf16(y[tt][0], y[tt][1]); w.y = pg8::cvt_pk_bf16(y[tt][2], y[tt][3]); w.z = pg8::cvt_pk_bf16(y[tt][4], y[tt][5]); w.w = pg8::cvt_pk_bf16(y[tt][6], y[tt][7]);
                    *(LAS u32x4*)(img + ((16 * seg + 8 * hb + tt) * 136 + c0) * 2) = w; }
            }
        }
    }
}
__device__ __forceinline__ void ssd_dt(const Params& p, LAS unsigned char* lds, int b, int c, int g) {
    const int lane = otid() & 63, e = otid() >> 6, eg = 8 * g + e;
    const float* SM = (const float*)(p.ws + WS_SM);
    const float dt = softplusf_(SM[((size_t)b * SEQ + 64 * c + lane) * 256 + eg] + p.in[I_DTB][eg]);
    float a = dt * -__expf(p.in[I_ALOG][eg]);
#pragma unroll
    for (int o = 1; o < 64; o <<= 1) { const float t = __shfl_up(a, o); if (lane >= o) a += t; }
    ((LAS float*)(lds + SSD_ACS))[lane * 8 + e] = a; ((LAS float*)(lds + SSD_DT))[lane * 8 + e] = dt;
}
__device__ void phase_ssd1(const Params& p, LAS unsigned char* lds, int wg, int nwg) {
    const int tid = otid(), lane = tid & 63, e = tid >> 6, fr = lane & 15, fq = lane >> 4;
    bf16_t* S = (bf16_t*)p.out; float* CD = (float*)(p.ws + WS_CTL + WS_CD);
    for (int unit = wg; unit < BATCH * 128 * NGRP; unit += nwg) {
        const int g = unit & 3, c = (unit >> 2) & 127, b = unit >> 9, eg = 8 * g + e;
        LDS_BARRIER();
        ssd_stage<false, true>(p, lds, b, c, g);
        ssd_dt(p, lds, b, c, g);
        LDS_BARRIER();
        LAS const float* ACS = (LAS const float*)(lds + SSD_ACS); LAS const float* DT = (LAS const float*)(lds + SSD_DT);
        const float alast = ACS[63 * 8 + e];
        f32x4 acc[8][4];
#pragma unroll
        for (int nt = 0; nt < 8; ++nt)
#pragma unroll
            for (int pt = 0; pt < 4; ++pt) acc[nt][pt] = (f32x4){0.f, 0.f, 0.f, 0.f};
#pragma unroll
        for (int ks = 0; ks < 2; ++ks) {
            float wl[8];
#pragma unroll
            for (int j = 0; j < 8; ++j) { const int s = 32 * ks + 8 * fq + j; wl[j] = DT[s * 8 + e] * __expf(alast - ACS[s * 8 + e]); }
            bf16x8 xb[4];
#pragma unroll
            for (int pt = 0; pt < 4; ++pt) {
                float f[8]; unpack8(*(LAS const u32x4*)(lds + SSD_XT + ((64 * e + 16 * pt + fr) * 72 + 32 * ks + 8 * fq) * 2), f);
                u32x4 w; w.x = pg8::cvt_pk_bf16(f[0] * wl[0], f[1] * wl[1]); w.y = pg8::cvt_pk_bf16(f[2] * wl[2], f[3] * wl[3]); w.z = pg8::cvt_pk_bf16(f[4] * wl[4], f[5] * wl[5]); w.w = pg8::cvt_pk_bf16(f[6] * wl[6], f[7] * wl[7]);
                xb[pt] = __builtin_bit_cast(bf16x8, w);
            }
#pragma unroll
            for (int nt = 0; nt < 8; ++nt) {
                const bf16x8 bt = *(LAS const bf16x8*)(lds + SSD_B + ((16 * nt + fr) * 72 + 32 * ks + 8 * fq) * 2);
#pragma unroll
                for (int pt = 0; pt < 4; ++pt) acc[nt][pt] = __builtin_amdgcn_mfma_f32_16x16x32_bf16(bt, xb[pt], acc[nt][pt], 0, 0, 0);
            }
        }
        bf16_t* sb = S + ((((size_t)b * 128 + c) * 32 + eg) * 64) * 128;
#pragma unroll
        for (int pt = 0; pt < 4; ++pt)
#pragma unroll
            for (int nt = 0; nt < 8; ++nt) { u32x2 w; w.x = pg8::cvt_pk_bf16_c(acc[nt][pt].x, acc[nt][pt].y); w.y = pg8::cvt_pk_bf16_c(acc[nt][pt].z, acc[nt][pt].w); *(u32x2*)(sb + (size_t)(16 * pt + fr) * 128 + 16 * nt + 4 * fq) = w; }
        if (lane == 0) CD[(b * 128 + c) * 32 + eg] = __expf(alast);
    }
}
__device__ void phase_ssd2(const Params& p, int wg, int nwg) {
    bf16_t* S = (bf16_t*)p.out; const float* CD = (const float*)(p.ws + WS_CTL + WS_CD);
    for (int idx = wg * 512 + otid(); idx < BATCH * 32 * 64 * 32; idx += nwg * 512) {
        const int n4 = idx & 31, pp = (idx >> 5) & 63, eg = (idx >> 11) & 31, b = idx >> 16;
        bf16_t* base = S + ((((size_t)b * 128) * 32 + eg) * 64 + pp) * 128 + 4 * n4;
        const float* cd = CD + (b * 128) * 32 + eg;
        f32x4 h = {0.f, 0.f, 0.f, 0.f};
#pragma unroll 16
        for (int c = 0; c < 128; ++c) {
            bf16_t* q = base + (size_t)c * (32 * 64 * 128);
            const f32x4 s = ld4bf(q); const float d = cd[c * 32];
            u32x2 w; w.x = pg8::cvt_pk_bf16(h.x, h.y); w.y = pg8::cvt_pk_bf16(h.z, h.w); *(u32x2*)q = w;
            h = h * d + s;
        }
    }
}
__device__ void phase_ssd3(const Params& p, bf16_t* ymix, LAS unsigned char* lds, int wg, int nwg) {
    const int tid = otid(), lane = tid & 63, e = tid >> 6, fr = lane & 15, fq = lane >> 4;
    const bf16_t* S = (const bf16_t*)p.out; const bf16_t* Z = (const bf16_t*)(p.ws + WS_Z);
    for (int unit = wg; unit < BATCH * 128 * NGRP; unit += nwg) {
        const int g = unit & 3, c = (unit >> 2) & 127, b = unit >> 9, eg = 8 * g + e;
        const size_t m0 = (size_t)b * SEQ + 64 * c;
        LDS_BARRIER();
        ssd_stage<true, false>(p, lds, b, c, g);
        ssd_dt(p, lds, b, c, g);
        const bf16_t* hb = S + ((((size_t)b * 128 + c) * 32 + eg) * 64) * 128;
        bf16x8 hfa[4][4];
#pragma unroll
        for (int ks = 0; ks < 4; ++ks)
#pragma unroll
            for (int pt = 0; pt < 4; ++pt) hfa[ks][pt] = *(const bf16x8*)(hb + (size_t)(16 * pt + fr) * 128 + 32 * ks + 8 * fq);
        LDS_BARRIER();
        {
            const int st = e >> 1;
            f32x4 cbacc[2] = {(f32x4){0.f, 0.f, 0.f, 0.f}, (f32x4){0.f, 0.f, 0.f, 0.f}};
#pragma unroll
            for (int ks = 0; ks < 4; ++ks) {
                const bf16x8 bfr = *(LAS const bf16x8*)(lds + SSD_B + ((16 * st + fr) * 136 + 32 * ks + 8 * fq) * 2);
#pragma unroll
                for (int j = 0; j < 2; ++j) { const int lt = 2 * (e & 1) + j; const bf16x8 cfr = *(LAS const bf16x8*)(lds + SSD_C + ((16 * lt + fr) * 136 + 32 * ks + 8 * fq) * 2); cbacc[j] = __builtin_amdgcn_mfma_f32_16x16x32_bf16(bfr, cfr, cbacc[j], 0, 0, 0); }
            }
#pragma unroll
            for (int j = 0; j < 2; ++j) { const int lt = 2 * (e & 1) + j; *(LAS f32x4*)(lds + SSD_CB + ((16 * lt + fr) * 68 + 16 * st + 4 * fq) * 4) = cbacc[j]; }
        }
        LDS_BARRIER();
        LAS const float* ACS = (LAS const float*)(lds + SSD_ACS); LAS const float* DT = (LAS const float*)(lds + SSD_DT);
        const float Dsk = p.in[I_SSDD][eg];
        f32x4 acc[4][4];
#pragma unroll
        for (int pt = 0; pt < 4; ++pt)
#pragma unroll
            for (int lt = 0; lt < 4; ++lt) acc[pt][lt] = (f32x4){0.f, 0.f, 0.f, 0.f};
#pragma unroll
        for (int ks = 0; ks < 4; ++ks) {
            bf16x8 hf[4], cf[4];
#pragma unroll
            for (int pt = 0; pt < 4; ++pt) hf[pt] = hfa[ks][pt];
#pragma unroll
            for (int lt = 0; lt < 4; ++lt) cf[lt] = *(LAS const bf16x8*)(lds + SSD_C + ((16 * lt + fr) * 136 + 32 * ks + 8 * fq) * 2);
#pragma unroll
            for (int pt = 0; pt < 4; ++pt)
#pragma unroll
                for (int lt = 0; lt < 4; ++lt) acc[pt][lt] = __builtin_amdgcn_mfma_f32_16x16x32_bf16(hf[pt], cf[lt], acc[pt][lt], 0, 0, 0);
        }
        u32x2 zr[4][4];
#pragma unroll
        for (int lt = 0; lt < 4; ++lt)
#pragma unroll
            for (int pt = 0; pt < 4; ++pt) zr[lt][pt] = *(const u32x2*)(Z + (m0 + 16 * lt + fr) * D_SSD + 64 * eg + 16 * pt + 4 * fq);
        float acl[4];
#pragma unroll
        for (int lt = 0; lt < 4; ++lt) { acl[lt] = ACS[(16 * lt + fr) * 8 + e]; const float sc = __expf(acl[lt]);
#pragma unroll
            for (int pt = 0; pt < 4; ++pt) acc[pt][lt] = acc[pt][lt] * sc; }
#pragma unroll
        for (int ks = 0; ks < 2; ++ks) {
            float as_[8], ds_[8];
#pragma unroll
            for (int j = 0; j < 8; ++j) { const int s = 32 * ks + 8 * fq + j; as_[j] = ACS[s * 8 + e]; ds_[j] = DT[s * 8 + e]; }
            bf16x8 xa[4];
#pragma unroll
            for (int pt = 0; pt < 4; ++pt) xa[pt] = *(LAS const bf16x8*)(lds + SSD_XT + ((64 * e + 16 * pt + fr) * 72 + 32 * ks + 8 * fq) * 2);
#pragma unroll
            for (int lt = 0; lt < 4; ++lt) {
                if (32 * ks > 16 * lt + 15) continue;
                const int l = 16 * lt + fr;
                const f32x4 c0 = *(LAS const f32x4*)(lds + SSD_CB + (l * 68 + 32 * ks + 8 * fq) * 4), c1 = *(LAS const f32x4*)(lds + SSD_CB + (l * 68 + 32 * ks + 8 * fq + 4) * 4);
                float mv[8];
#pragma unroll
                for (int j = 0; j < 8; ++j) { const int s = 32 * ks + 8 * fq + j; const float cbv = j < 4 ? c0[j] : c1[j - 4];
                    float v = cbv * __expf(fminf(acl[lt] - as_[j], 0.f)) * ds_[j]; v = (s <= l) ? v : 0.f; mv[j] = (s == l) ? v + Dsk : v; }
                u32x4 w; w.x = pg8::cvt_pk_bf16(mv[0], mv[1]); w.y = pg8::cvt_pk_bf16(mv[2], mv[3]); w.z = pg8::cvt_pk_bf16(mv[4], mv[5]); w.w = pg8::cvt_pk_bf16(mv[6], mv[7]);
                const bf16x8 mf = __builtin_bit_cast(bf16x8, w);
#pragma unroll
                for (int pt = 0; pt < 4; ++pt) acc[pt][lt] = __builtin_amdgcn_mfma_f32_16x16x32_bf16(xa[pt], mf, acc[pt][lt], 0, 0, 0);
            }
        }
        float ssq[4];
#pragma unroll
        for (int lt = 0; lt < 4; ++lt) {
            float s = 0.f;
#pragma unroll
            for (int pt = 0; pt < 4; ++pt) {
                const f32x4 z = up4(zr[lt][pt]);
                f32x4 y = acc[pt][lt];
                y.x *= siluf_(z.x); y.y *= siluf_(z.y); y.z *= siluf_(z.z); y.w *= siluf_(z.w);
                acc[pt][lt] = y; s += (y.x * y.x + y.y * y.y) + (y.z * y.z + y.w * y.w);
            }
            s += __shfl_xor(s, 16); s += __shfl_xor(s, 32); ssq[lt] = s;
            if (fq == 0) ((LAS float*)(lds + SSD_PART))[e * 64 + 16 * lt + fr] = s;
        }
        f32x4 ngv[4];
#pragma unroll
        for (int pt = 0; pt < 4; ++pt) ngv[pt] = *(const f32x4*)(p.in[I_SSDNG] + 64 * eg + 16 * pt + 4 * fq);
        LDS_BARRIER();
#pragma unroll
        for (int lt = 0; lt < 4; ++lt) {
            float tot = 0.f;
#pragma unroll
            for (int w = 0; w < 8; ++w) tot += ((LAS const float*)(lds + SSD_PART))[w * 64 + 16 * lt + fr];
            const float rstd = 1.f / sqrtf(tot * (1.f / 512.f) + GATED_EPS);
#pragma unroll
            for (int pt = 0; pt < 4; ++pt) {
                const int col = 64 * eg + 16 * pt + 4 * fq;
                const f32x4 o = acc[pt][lt] * rstd * ngv[pt];
                u32x2 w; w.x = pg8::cvt_pk_bf16(o.x, o.y); w.y = pg8::cvt_pk_bf16(o.z, o.w);
                *(u32x2*)(ymix + (m0 + 16 * lt + fr) * D_MIX + col) = w;
            }
        }
    }
}

constexpr size_t WS_AW = 1 * MiB;
constexpr size_t WS_AA = 5 * MiB;
constexpr size_t WS_AG = 504 * MiB;
constexpr size_t WS_BON = WS_GD;
constexpr size_t WS_YRAW = WS_FREE;
__device__ void phase_rwkv_pre(const Params& p, int wg, int nwg) {
    const int tid = otid(), lane = tid & 63, wave = tid >> 6;
    const float* SM = (const float*)(p.ws + WS_SM); const bf16_t* GD = (const bf16_t*)(p.ws + WS_GD); const float* mu = p.in[I_MU];
    bf16_t* AW = (bf16_t*)(p.ws + WS_AW); bf16_t* AA = (bf16_t*)(p.ws + WS_AA); bf16_t* AG = (bf16_t*)(p.ws + WS_AG);
    const bool isw = lane < 24, isa = lane >= 24 && lane < 48;
    const int js = isw ? 4 * lane : 4 * (lane - 24);
    const int smc = (isw ? 32 : 128) + js;
    const f32x4 z4 = {0.f, 0.f, 0.f, 0.f};
    const f32x4 mus = (isw || isa) ? *(const f32x4*)(mu + (isw ? MU_WD : MU_AD) + js) : z4;
    const f32x4 mug = *(const f32x4*)(mu + MU_GD + 4 * lane);
#pragma unroll 2
    for (int m = wg * 8 + wave; m < M; m += nwg * 8) {
        const bool hp = (m % SEQ) > 0;
        f32x4 sc = z4, sp = z4;
        if (isw || isa) { sc = *(const f32x4*)(SM + (size_t)m * 256 + smc); if (hp) sp = *(const f32x4*)(SM + (size_t)(m - 1) * 256 + smc); }
        const u32x2 gcw = *(const u32x2*)(GD + (size_t)m * 256 + 4 * lane); u32x2 gpw = {0u, 0u}; if (hp) gpw = *(const u32x2*)(GD + (size_t)(m - 1) * 256 + 4 * lane);
        const f32x4 sv = sc + (sp - sc) * mus;
        if (isw) { u32x2 w; w.x = pk2(tanhf(sv.x), tanhf(sv.y)); w.y = pk2(tanhf(sv.z), tanhf(sv.w)); *(u32x2*)(AW + (size_t)m * 128 + js) = w; }
        else if (isa) { u32x2 w; w.x = pk2(sv.x, sv.y); w.y = pk2(sv.z, sv.w); *(u32x2*)(AA + (size_t)m * 128 + js) = w; }
        else if (lane < 56) { const u32x2 zz = {0u, 0u}; const int jz = 96 + 4 * (lane - 48); *(u32x2*)(AW + (size_t)m * 128 + jz) = zz; *(u32x2*)(AA + (size_t)m * 128 + jz) = zz; }
        const f32x4 gc = up4(gcw), gp = up4(gpw); const f32x4 gv = gc + (gp - gc) * mug;
        u32x2 w; w.x = pk2(sigmoidf_(gv.x), sigmoidf_(gv.y)); w.y = pk2(sigmoidf_(gv.z), sigmoidf_(gv.w));
        *(u32x2*)(AG + (size_t)m * 256 + 4 * lane) = w;
    }
}

__device__ __forceinline__ float afma(float a, float b, float c) { float d; asm("v_fma_f32 %0, %1, %2, %3" : "=v"(d) : "v"(a), "v"(b), "v"(c)); return d; }
__device__ __forceinline__ float amul(float a, float b) { float d; asm("v_mul_f32 %0, %1, %2" : "=v"(d) : "v"(a), "v"(b)); return d; }
template <int CTRL> __device__ __forceinline__ float dpp_f(float x) { return __builtin_bit_cast(float, __builtin_amdgcn_update_dpp(0, __builtin_bit_cast(int, x), CTRL, 0xf, 0xf, true)); }
__device__ __forceinline__ float red16(float x) { x += dpp_f<0xB1>(x); x += dpp_f<0x4E>(x); x += dpp_f<0x124>(x); x += dpp_f<0x128>(x); return x; }

constexpr int R2_T = 32, R2_RING = 5 * 8192 + 2304 + 256, R2_W2H = 2 * R2_RING + 4096 + 2048;
__device__ void phase_rwkv_scan(const Params& p, LAS unsigned char* lds, int wg, int nwg) {
    constexpr int T = R2_T, NCH = SEQ / T;
    const int tid = otid(), lane = tid & 63, wave = __builtin_amdgcn_readfirstlane(tid >> 6);
    LAS float* cst = (LAS float*)(lds + 2 * R2_RING + 4096);
    const bf16_t* R = (const bf16_t*)(p.ws + WS_R); const bf16_t* Kb = (const bf16_t*)(p.ws + WS_K); const bf16_t* V = (const bf16_t*)(p.ws + WS_V);
    const bf16_t* AW = (const bf16_t*)(p.ws + WS_AW); const bf16_t* AA = (const bf16_t*)(p.ws + WS_AA);
    float* BON = (float*)(p.ws + WS_BON); bf16_t* YRAW = (bf16_t*)(p.ws + WS_YRAW);
    for (int unit = wg; unit < 256; unit += nwg) {
        const int xcd = unit & 7, idx = unit >> 3, q = idx & 3, bh = xcd * 8 + (idx >> 2), b = bh >> 5, h = bh & 31;
        __syncthreads();
        { const int arr = tid >> 6, ch = tid & 63; const float* srcs[8] = {p.in[I_W0], p.in[I_A0], p.in[I_KK], p.in[I_KA], p.in[I_RK], p.in[I_MU] + MU_R, p.in[I_MU] + MU_K, p.in[I_MU] + MU_V};
          float v = 0.f;
#pragma unroll
          for (int a = 0; a < 8; ++a) if (arr == a) v = srcs[a][h * 64 + ch];
          cst[arr * 64 + ch] = v; }
        {
            LAS bf16_t* w2h = (LAS bf16_t*)(lds + R2_W2H); LAS bf16_t* a2h = (LAS bf16_t*)(lds + R2_W2H + 17408);
            for (int i = tid; i < 128 * 64; i += 512) { const int k = i >> 6, ch = i & 63; float w2v = 0.f, a2v = 0.f;
                if (k < 96) { w2v = p.in[I_W2][(size_t)k * D_RWKV + h * 64 + ch]; a2v = p.in[I_A2][(size_t)k * D_RWKV + h * 64 + ch]; }
                w2h[ch * 136 + k] = (bf16_t)f2bf(w2v); a2h[ch * 136 + k] = (bf16_t)f2bf(a2v); }
        }
        __syncthreads();
        if (wave >= 4) {
            const int pw = wave - 4, mt = pw & 1, half = pw >> 1, fr = lane & 15, fq = lane >> 4;
            bf16x8 nAW[4], nAA[4]; u32x2 nR[2][2], nK[2][2], nV[2];
            const int vnt = q - 2 * half;
            const auto rsAW = __builtin_amdgcn_make_buffer_rsrc((void*)AW, 0, (int)(M * 128 * 2), 0x00020000), rsAA = __builtin_amdgcn_make_buffer_rsrc((void*)AA, 0, (int)(M * 128 * 2), 0x00020000);
            const auto rsR = __builtin_amdgcn_make_buffer_rsrc((void*)R, 0, (int)(M * 2048 * 2), 0x00020000), rsK = __builtin_amdgcn_make_buffer_rsrc((void*)Kb, 0, (int)(M * 2048 * 2), 0x00020000), rsV = __builtin_amdgcn_make_buffer_rsrc((void*)V, 0, (int)(M * 2048 * 2), 0x00020000);
            const int voA = ((16 * mt + fr) * 128 + 8 * fq) * 2, voR = ((16 * mt + fr) * 2048 + h * 64 + 32 * half + 4 * fq) * 2;
#define R2_PREFETCH(cc) do { const int row0_ = b * SEQ + T * (cc); const bool hp_ = (T * (cc) + 16 * mt + fr) > 0; const int soA_ = row0_ * 256, soR_ = row0_ * 4096, soP_ = row0_ > 0 ? (row0_ - 1) * 4096 : 0, vaP_ = row0_ > 0 ? 0 : -4096;     \
                _Pragma("unroll") for (int ks = 0; ks < 4; ++ks) { nAW[ks] = __builtin_bit_cast(bf16x8, __builtin_amdgcn_raw_buffer_load_b128(rsAW, voA + 64 * ks, soA_, 0)); nAA[ks] = __builtin_bit_cast(bf16x8, __builtin_amdgcn_raw_buffer_load_b128(rsAA, voA + 64 * ks, soA_, 0)); } \
                _Pragma("unroll") for (int nt = 0; nt < 2; ++nt) { \
                    nR[nt][0] = __builtin_bit_cast(u32x2, __builtin_amdgcn_raw_buffer_load_b64(rsR, voR + 32 * nt, soR_, 0)); nK[nt][0] = __builtin_bit_cast(u32x2, __builtin_amdgcn_raw_buffer_load_b64(rsK, voR + 32 * nt, soR_, 0)); nR[nt][1] = (u32x2){0u, 0u}; nK[nt][1] = (u32x2){0u, 0u}; \
                    if (hp_) { nR[nt][1] = __builtin_bit_cast(u32x2, __builtin_amdgcn_raw_buffer_load_b64(rsR, voR + 32 * nt + vaP_, soP_, 0)); nK[nt][1] = __builtin_bit_cast(u32x2, __builtin_amdgcn_raw_buffer_load_b64(rsK, voR + 32 * nt + vaP_, soP_, 0)); } \
                    if (nt == vnt) { nV[0] = __builtin_bit_cast(u32x2, __builtin_amdgcn_raw_buffer_load_b64(rsV, voR + 32 * nt, soR_, 0)); nV[1] = (u32x2){0u, 0u}; if (hp_) nV[1] = __builtin_bit_cast(u32x2, __builtin_amdgcn_raw_buffer_load_b64(rsV, voR + 32 * nt + vaP_, soP_, 0)); } } } while (0)
            R2_PREFETCH(0);
            unsigned long long pacc = 0;
            for (int c = 0; c <= NCH + 1; ++c) {
                unsigned long long tq0 = 0; if (PROBE_PH == 12 && blockIdx.x == 0 && pw == 0) tq0 = __builtin_amdgcn_s_memrealtime();
                if (c >= 2 && pw == 0) {
                    LAS const float* yo = (LAS const float*)(lds + 2 * R2_RING + ((c - 2) & 1) * 2048);
                    const int tok = lane >> 1, hf = lane & 1;
                    const f32x4 y0 = *(LAS const f32x4*)(yo + tok * 16 + 8 * hf), y1 = *(LAS const f32x4*)(yo + tok * 16 + 8 * hf + 4);
                    *(u32x4*)(YRAW + ((size_t)b * SEQ + (size_t)T * (c - 2) + tok) * D_RWKV + h * 64 + 16 * q + 8 * hf) = pack8(y0, y1);
                }
                if (c < NCH) {
                    LAS float* rg = (LAS float*)(lds + (c & 1) * R2_RING);
                    LAS float* r_an = rg; LAS float* r_ww = rg + 2048; LAS float* r_bb = rg + 4096; LAS float* r_kp = rg + 6144; LAS float* r_rr = rg + 8192; LAS float* r_vv = rg + 10240; LAS float* r_ss = rg + 10240 + 576;
                    const int tok = 16 * mt + fr; const size_t m = (size_t)b * SEQ + T * c + tok;
                    f32x4 accw[2], acca[2];
#pragma unroll
                    for (int nt = 0; nt < 2; ++nt) { accw[nt] = (f32x4){0.f, 0.f, 0.f, 0.f}; acca[nt] = (f32x4){0.f, 0.f, 0.f, 0.f}; }
#pragma unroll
                    for (int ks = 0; ks < 4; ++ks)
#pragma unroll
                        for (int nt = 0; nt < 2; ++nt) { const int bo = R2_W2H + ((32 * half + 16 * nt + fr) * 136 + 32 * ks + 8 * fq) * 2;
                            accw[nt] = __builtin_amdgcn_mfma_f32_16x16x32_bf16(*(LAS const bf16x8*)(lds + bo), nAW[ks], accw[nt], 0, 0, 0); acca[nt] = __builtin_amdgcn_mfma_f32_16x16x32_bf16(*(LAS const bf16x8*)(lds + bo + 17408), nAA[ks], acca[nt], 0, 0, 0); }
                    f32x4 rc_[2], rp_[2], kc_[2], kq_[2];
#pragma unroll
                    for (int nt = 0; nt < 2; ++nt) { rc_[nt] = up4(nR[nt][0]); rp_[nt] = up4(nR[nt][1]); kc_[nt] = up4(nK[nt][0]); kq_[nt] = up4(nK[nt][1]); }
                    const f32x4 vc_ = up4(nV[0]), vp_ = up4(nV[1]);
                    asm volatile("" : "+v"(accw[0]), "+v"(accw[1]), "+v"(acca[0]), "+v"(acca[1]));
                    if (c + 1 < NCH) R2_PREFETCH(c + 1);
                    float ssp = 0.f, bop = 0.f;
#pragma unroll
                    for (int nt = 0; nt < 2; ++nt) {
                        const int ch0 = 32 * half + 16 * nt + 4 * fq;
                        const f32x4 w0 = *(LAS const f32x4*)(cst + 0 * 64 + ch0), a0 = *(LAS const f32x4*)(cst + 1 * 64 + ch0), kkc = *(LAS const f32x4*)(cst + 2 * 64 + ch0), kac = *(LAS const f32x4*)(cst + 3 * 64 + ch0),
                                    rkc = *(LAS const f32x4*)(cst + 4 * 64 + ch0), mur = *(LAS const f32x4*)(cst + 5 * 64 + ch0), muk = *(LAS const f32x4*)(cst + 6 * 64 + ch0);
                        const f32x4 r4 = rc_[nt] + (rp_[nt] - rc_[nt]) * mur, k4 = kc_[nt] + (kq_[nt] - kc_[nt]) * muk;
                        f32x4 wv, ag;
#pragma unroll
                        for (int i = 0; i < 4; ++i) { const float sg = __builtin_amdgcn_rcpf(1.f + __expf(-(w0[i] + accw[nt][i]))); wv[i] = __expf(-0.60653066f * sg); ag[i] = __builtin_amdgcn_rcpf(1.f + __expf(-(a0[i] + acca[nt][i]))); }
                        const f32x4 kk = k4 * kkc, kp4 = k4 * (1.f + (ag - 1.f) * kac), b4 = kk * ag;
                        ssp += (kk.x * kk.x + kk.y * kk.y) + (kk.z * kk.z + kk.w * kk.w);
                        const f32x4 bo4 = r4 * kp4 * rkc; bop += (bo4.x + bo4.y) + (bo4.z + bo4.w);
                        const int so = tok * 64 + (ch0 ^ ((tok & 7) << 2));
                        *(LAS f32x4*)(r_an + so) = kk; *(LAS f32x4*)(r_ww + so) = wv; *(LAS f32x4*)(r_bb + so) = b4; *(LAS f32x4*)(r_kp + so) = kp4; *(LAS f32x4*)(r_rr + so) = r4;
                        if (nt == vnt) {
                            const f32x4 muv = *(LAS const f32x4*)(cst + 7 * 64 + ch0);
                            const f32x4 vv4 = vc_ + (vp_ - vc_) * muv;
                            r_vv[(4 * fq + 0) * 36 + tok] = vv4.x; r_vv[(4 * fq + 1) * 36 + tok] = vv4.y; r_vv[(4 * fq + 2) * 36 + tok] = vv4.z; r_vv[(4 * fq + 3) * 36 + tok] = vv4.w;
                        }
                    }
                    ssp += __shfl_xor(ssp, 16); ssp += __shfl_xor(ssp, 32); bop += __shfl_xor(bop, 16); bop += __shfl_xor(bop, 32);
                    if (fq == 0) { r_ss[tok * 2 + half] = ssp; if (q == 0) BON[(m * 32 + h) * 2 + half] = bop; }
                }
                if (PROBE_PH == 12 && blockIdx.x == 0 && pw == 0) { asm volatile("s_waitcnt lgkmcnt(0)" ::: "memory"); pacc += __builtin_amdgcn_s_memrealtime() - tq0; }
                if (c <= NCH) LDS_BARRIER();
            }
            if (PROBE_PH == 12 && blockIdx.x == 0 && pw == 0 && lane == 0) *(LAS unsigned long long*)(lds + 163840 - 16) = pacc;
#undef R2_PREFETCH
        } else {
            __builtin_amdgcn_s_setprio(2);
            const int cw = wave, g = lane >> 4, l16 = lane & 15, row = 4 * cw + g;
            float S0 = 0.f, S1 = 0.f, S2 = 0.f, S3 = 0.f;
            float yrot = 0.f;
            unsigned long long pacc = 0;
            LDS_BARRIER();
            for (int c = 0; c < NCH; ++c) {
                LAS const float* rg = (LAS const float*)(lds + (c & 1) * R2_RING);
                LAS const float* r_vv = rg + 10240 + row * 36; LAS const float* r_ss = rg + 10240 + 576;
                LAS float* yo = (LAS float*)(lds + 2 * R2_RING + (c & 1) * 2048) + row + (15 - l16) * 16;
                f32x4 vq[8];
#pragma unroll
                for (int i = 0; i < 8; ++i) vq[i] = *(LAS const f32x4*)(r_vv + 4 * i);
                float cv; { const int tt = lane & 31; cv = -__builtin_amdgcn_rcpf(fmaxf(r_ss[2 * tt] + r_ss[2 * tt + 1], 1e-24f)); }
                constexpr int PF = 4;
                f32x4 qa[PF], qw[PF], qb[PF], qk[PF], qr[PF];
#pragma unroll
                for (int t = 0; t < PF; ++t) { qa[t] = *(LAS const f32x4*)(rg + (4 * (l16 ^ (t & 7))) + t * 64); qw[t] = *(LAS const f32x4*)(rg + (4 * (l16 ^ (t & 7))) + 2048 + t * 64); qb[t] = *(LAS const f32x4*)(rg + (4 * (l16 ^ (t & 7))) + 4096 + t * 64); qk[t] = *(LAS const f32x4*)(rg + (4 * (l16 ^ (t & 7))) + 6144 + t * 64); qr[t] = *(LAS const f32x4*)(rg + (4 * (l16 ^ (t & 7))) + 8192 + t * 64); }
                unsigned long long tq0 = 0; if (PROBE_PH == 11 && blockIdx.x == 0 && wave == 0) tq0 = __builtin_amdgcn_s_memrealtime(); if (PROBE_PH == 13 && blockIdx.x == 0 && wave == 0) tq0 = __builtin_amdgcn_s_memtime();
                float sa = red16(afma(S0, qa[0].x, amul(S1, qa[0].y)) + afma(S2, qa[0].z, amul(S3, qa[0].w))) * __builtin_bit_cast(float, __builtin_amdgcn_readlane(__builtin_bit_cast(int, cv), 0));
#pragma unroll
                for (int t = 0; t < T; ++t) {
                    const int sl = t % PF;
                    const f32x4 w4 = qw[sl], b4 = qb[sl], k4 = qk[sl], r4 = qr[sl]; const float vr = vq[t >> 2][t & 3];
                    const f32x4 an = qa[(t + 1) % PF];
                    if (t + PF < T) { const int u = t + PF; qa[sl] = *(LAS const f32x4*)(rg + (4 * (l16 ^ (u & 7))) + u * 64); qw[sl] = *(LAS const f32x4*)(rg + (4 * (l16 ^ (u & 7))) + 2048 + u * 64); qb[sl] = *(LAS const f32x4*)(rg + (4 * (l16 ^ (u & 7))) + 4096 + u * 64); qk[sl] = *(LAS const f32x4*)(rg + (4 * (l16 ^ (u & 7))) + 6144 + u * 64); qr[sl] = *(LAS const f32x4*)(rg + (4 * (l16 ^ (u & 7))) + 8192 + u * 64); }
                    float y, z, m0, m1, m2, m3;
                    asm("v_mul_f32 %[m0], %[vr], %[k0]\n\tv_mul_f32 %[m1], %[vr], %[k1]\n\tv_mul_f32 %[m2], %[vr], %[k2]\n\tv_mul_f32 %[m3], %[vr], %[k3]\n\t"
                        "v_fma_f32 %[m0], %[sa], %[b0], %[m0]\n\tv_fma_f32 %[m1], %[sa], %[b1], %[m1]\n\tv_fma_f32 %[m2], %[sa], %[b2], %[m2]\n\tv_fma_f32 %[m3], %[sa], %[b3], %[m3]\n\t"
                        "v_fma_f32 %[S0], %[S0], %[w0], %[m0]\n\tv_fma_f32 %[S1], %[S1], %[w1], %[m1]\n\tv_fma_f32 %[S2], %[S2], %[w2], %[m2]\n\tv_fma_f32 %[S3], %[S3], %[w3], %[m3]\n\t"
                        "v_mul_f32 %[m0], %[S1], %[r1]\n\tv_mul_f32 %[m1], %[S3], %[r3]\n\tv_mul_f32 %[m2], %[S1], %[a1]\n\tv_mul_f32 %[m3], %[S3], %[a3]\n\t"
                        "v_fma_f32 %[m0], %[S0], %[r0], %[m0]\n\tv_fma_f32 %[m1], %[S2], %[r2], %[m1]\n\tv_fma_f32 %[m2], %[S0], %[a0], %[m2]\n\tv_fma_f32 %[m3], %[S2], %[a2], %[m3]\n\t"
                        "v_add_f32 %[y], %[m0], %[m1]\n\tv_add_f32 %[z], %[m2], %[m3]"
                        : [S0] "+v"(S0), [S1] "+v"(S1), [S2] "+v"(S2), [S3] "+v"(S3), [y] "=&v"(y), [z] "=&v"(z), [m0] "=&v"(m0), [m1] "=&v"(m1), [m2] "=&v"(m2), [m3] "=&v"(m3)
                        : [sa] "v"(sa), [vr] "v"(vr), [k0] "v"(k4.x), [k1] "v"(k4.y), [k2] "v"(k4.z), [k3] "v"(k4.w), [b0] "v"(b4.x), [b1] "v"(b4.y), [b2] "v"(b4.z), [b3] "v"(b4.w),
                          [w0] "v"(w4.x), [w1] "v"(w4.y), [w2] "v"(w4.z), [w3] "v"(w4.w), [r0] "v"(r4.x), [r1] "v"(r4.y), [r2] "v"(r4.z), [r3] "v"(r4.w), [a0] "v"(an.x), [a1] "v"(an.y), [a2] "v"(an.z), [a3] "v"(an.w));
                    y += dpp_f<0xB1>(y); z += dpp_f<0xB1>(z); y += dpp_f<0x4E>(y); z += dpp_f<0x4E>(z); y += dpp_f<0x124>(y); z += dpp_f<0x124>(z); y += dpp_f<0x128>(y); z += dpp_f<0x128>(z);
                    sa = z * __builtin_bit_cast(float, __builtin_amdgcn_readlane(__builtin_bit_cast(int, cv), (t + 1) % T));
                    yrot = __builtin_bit_cast(float, __builtin_amdgcn_update_dpp(__builtin_bit_cast(int, y), __builtin_bit_cast(int, yrot), 0x111, 0xf, 0xf, false));
                    if ((t & 15) == 15) yo[(t - 15) * 16] = yrot;
                }
                if (PROBE_PH == 11 && blockIdx.x == 0 && wave == 0) { asm volatile("s_waitcnt lgkmcnt(0)" ::: "memory"); pacc += __builtin_amdgcn_s_memrealtime() - tq0; }
                if (PROBE_PH == 13 && blockIdx.x == 0 && wave == 0) { asm volatile("s_waitcnt lgkmcnt(0)" ::: "memory"); pacc += __builtin_amdgcn_s_memtime() - tq0; }
                LDS_BARRIER();
            }
            if (PROBE_PH == 11 && blockIdx.x == 0 && wave == 0 && lane == 0) *(LAS unsigned long long*)(lds + 163840 - 16) = pacc;
            if (PROBE_PH == 13 && blockIdx.x == 0 && wave == 0 && lane == 0) *(LAS unsigned long long*)(lds + 163840 - 16) = pacc / 100;
            __builtin_amdgcn_s_setprio(0);
        }
    }
}

typedef short bf16x4 __attribute__((ext_vector_type(4)));
__device__ __forceinline__ bf16x4 pk4(f32x4 v) { u32x2 w; w.x = pg8::cvt_pk_bf16_c(v.x, v.y); w.y = pg8::cvt_pk_bf16_c(v.z, v.w); return __builtin_bit_cast(bf16x4, w); }
__device__ __forceinline__ bf16x8 pk8(f32x4 a, f32x4 b) { u32x4 w; w.x = pg8::cvt_pk_bf16_c(a.x, a.y); w.y = pg8::cvt_pk_bf16_c(a.z, a.w); w.z = pg8::cvt_pk_bf16_c(b.x, b.y); w.w = pg8::cvt_pk_bf16_c(b.z, b.w); return __builtin_bit_cast(bf16x8, w); }
#define MFMA16(a, b, c) __builtin_amdgcn_mfma_f32_16x16x16bf16_1k(a, b, c, 0, 0, 0)
#define MFMA32(a, b, c) __builtin_amdgcn_mfma_f32_16x16x32_bf16(a, b, c, 0, 0, 0)
constexpr int RC_SL = 11008, RC_AT = 0, RC_RT = 2048, RC_BT = 4096, RC_KT = 6144, RC_MAK = 8192, RC_MRB = 8704, RC_MRK = 9216, RC_TI = 9728, RC_VT = 10240, RC_GL = 10752;
constexpr int RC_BLK = 6, RC_NCHK = SEQ / 16, RC_NB = (RC_NCHK + RC_BLK - 1) / RC_BLK;
constexpr int RC_W2H = 2 * RC_BLK * RC_SL, RC_A2H = RC_W2H + 13312, RC_CST = RC_A2H + 13312;
static_assert(RC_CST + 2048 <= 163840 - 64, "R2c LDS map");
static_assert((RC_NB + 1) * 12 >= 8 * 128, "SSD2 slices cover all 128 chunks of all 8 items per lane (256-workgroup grid)");
__device__ void phase_rwkv_chunked(const Params& p, LAS unsigned char* lds, int wg, int nwg) {
    const int tid = otid(), lane = tid & 63, wave = __builtin_amdgcn_readfirstlane(tid >> 6), r = lane & 15, q = lane >> 4;
    LAS float* cst = (LAS float*)(lds + RC_CST);
    const bf16_t* R = (const bf16_t*)(p.ws + WS_R); const bf16_t* Kb = (const bf16_t*)(p.ws + WS_K); const bf16_t* V = (const bf16_t*)(p.ws + WS_V);
    const bf16_t* AW = (const bf16_t*)(p.ws + WS_AW); const bf16_t* AA = (const bf16_t*)(p.ws + WS_AA);
    float* BON = (float*)(p.ws + WS_BON); bf16_t* YRAW = (bf16_t*)(p.ws + WS_YRAW);
    for (int unit = wg; unit < 256; unit += nwg) {
        const int xcd = unit & 7, idx = unit >> 3, qw = idx & 3, bh = xcd * 8 + (idx >> 2), b = bh >> 5, h = bh & 31;
        __syncthreads();
        { const int arr = tid >> 6, ch = tid & 63; const float* srcs[8] = {p.in[I_W0], p.in[I_A0], p.in[I_KK], p.in[I_KA], p.in[I_RK], p.in[I_MU] + MU_R, p.in[I_MU] + MU_K, p.in[I_MU] + MU_V};
          float v = 0.f;
#pragma unroll
          for (int a = 0; a < 8; ++a) if (arr == a) v = srcs[a][h * 64 + ch];
          cst[arr * 64 + ch] = v; }
        {   LAS bf16_t* w2h = (LAS bf16_t*)(lds + RC_W2H); LAS bf16_t* a2h = (LAS bf16_t*)(lds + RC_A2H);
            for (int i = tid; i < 96 * 64; i += 512) { const int k = i >> 6, ch = i & 63;
                w2h[ch * 104 + k] = (bf16_t)f2bf(p.in[I_W2][(size_t)k * D_RWKV + h * 64 + ch]); a2h[ch * 104 + k] = (bf16_t)f2bf(p.in[I_A2][(size_t)k * D_RWKV + h * 64 + ch]); } }
        __syncthreads();
        if (wave == 0) {
            __builtin_amdgcn_s_setprio(3);
            f32x4 Sacc[4];
#pragma unroll
            for (int ct = 0; ct < 4; ++ct) Sacc[ct] = (f32x4){0.f, 0.f, 0.f, 0.f};
            const f32x4 zero4 = {0.f, 0.f, 0.f, 0.f};
            unsigned long long pacc = 0;
            for (int blk = 0; blk <= RC_NB; ++blk) {
                unsigned long long tq0 = 0; if (PROBE_PH == 21 && blockIdx.x == 0) tq0 = __builtin_amdgcn_s_memrealtime();
                if (blk >= 1) {
                    for (int j = 0; j < RC_BLK; ++j) {
                        const int ci = (blk - 1) * RC_BLK + j; if (ci >= RC_NCHK) break;
                        LAS const unsigned char* sl = lds + (((blk - 1) & 1) * RC_BLK + j) * RC_SL;
                        const bf16x8 at0 = *(LAS const bf16x8*)(sl + RC_AT + lane * 16), at1 = *(LAS const bf16x8*)(sl + RC_AT + 1024 + lane * 16);
                        const bf16x8 rt0 = *(LAS const bf16x8*)(sl + RC_RT + lane * 16), rt1 = *(LAS const bf16x8*)(sl + RC_RT + 1024 + lane * 16);
                        const bf16x4 mak = *(LAS const bf16x4*)(sl + RC_MAK + lane * 8), mrb = *(LAS const bf16x4*)(sl + RC_MRB + lane * 8), mrk = *(LAS const bf16x4*)(sl + RC_MRK + lane * 8),
                                     ti = *(LAS const bf16x4*)(sl + RC_TI + lane * 8), vt = *(LAS const bf16x4*)(sl + RC_VT + lane * 8);
                        bf16x4 bt[4], kt[4]; f32x4 gl[4];
#pragma unroll
                        for (int ct = 0; ct < 4; ++ct) { bt[ct] = *(LAS const bf16x4*)(sl + RC_BT + (ct * 64 + lane) * 8); kt[ct] = *(LAS const bf16x4*)(sl + RC_KT + (ct * 64 + lane) * 8); gl[ct] = *(LAS const f32x4*)(sl + RC_GL + (16 * ct + 4 * q) * 4); }
                        const bf16x8 sop0 = pk8(Sacc[0], Sacc[1]), sop1 = pk8(Sacc[2], Sacc[3]);
                        f32x4 X = MFMA32(at0, sop0, zero4); X = MFMA32(at1, sop1, X); X = MFMA16(mak, vt, X);
                        const f32x4 U = MFMA16(ti, pk4(X), zero4);
                        const bf16x4 up = pk4(U);
                        f32x4 Y = MFMA32(rt0, sop0, zero4); Y = MFMA32(rt1, sop1, Y); Y = MFMA16(mrb, up, Y); Y = MFMA16(mrk, vt, Y);
#pragma unroll
                        for (int ct = 0; ct < 4; ++ct) { Sacc[ct] = MFMA16(bt[ct], up, Sacc[ct]); Sacc[ct] = MFMA16(kt[ct], vt, Sacc[ct]); Sacc[ct] = Sacc[ct] * gl[ct]; }
                        bf16_t* yo = YRAW + ((size_t)b * SEQ + 16 * ci + 4 * q) * D_RWKV + h * 64 + 16 * qw + r;
                        yo[0] = (bf16_t)f2bf(Y.x); yo[D_RWKV] = (bf16_t)f2bf(Y.y); yo[2 * D_RWKV] = (bf16_t)f2bf(Y.z); yo[3 * D_RWKV] = (bf16_t)f2bf(Y.w);
                    }
                }
                if (PROBE_PH == 21 && blockIdx.x == 0) { asm volatile("s_waitcnt lgkmcnt(0)" ::: "memory"); pacc += __builtin_amdgcn_s_memrealtime() - tq0; }
                LDS_BARRIER();
            }
            __builtin_amdgcn_s_setprio(0);
            if (PROBE_PH == 21 && blockIdx.x == 0 && lane == 0) *(LAS unsigned long long*)(lds + 163840 - 16) = pacc;
        } else if (wave != 4) {
            const int pw = wave < 4 ? wave - 1 : wave - 2;
            const auto rsAW = __builtin_amdgcn_make_buffer_rsrc((void*)AW, 0, (int)(M * 128 * 2), 0x00020000), rsAA = __builtin_amdgcn_make_buffer_rsrc((void*)AA, 0, (int)(M * 128 * 2), 0x00020000);
            const auto rsR = __builtin_amdgcn_make_buffer_rsrc((void*)R, 0, (int)(M * 2048 * 2), 0x00020000), rsK = __builtin_amdgcn_make_buffer_rsrc((void*)Kb, 0, (int)(M * 2048 * 2), 0x00020000), rsV = __builtin_amdgcn_make_buffer_rsrc((void*)V, 0, (int)(M * 2048 * 2), 0x00020000);
            const int voA = (r * 128 + 8 * q) * 2, voR = (r * 2048 + h * 64 + 4 * q) * 2;
            bf16x8 nAW[3], nAA[3]; u32x2 nR[4][2], nK[4][2], nV[2];
#define RC_PREFETCH_A(cc) do { const int soA_ = (b * SEQ + 16 * (cc)) * 256; \
                _Pragma("unroll") for (int ks = 0; ks < 3; ++ks) { nAW[ks] = __builtin_bit_cast(bf16x8, __builtin_amdgcn_raw_buffer_load_b128(rsAW, voA + 64 * ks, soA_, 0)); nAA[ks] = __builtin_bit_cast(bf16x8, __builtin_amdgcn_raw_buffer_load_b128(rsAA, voA + 64 * ks, soA_, 0)); } } while (0)
#define RC_PREFETCH_R(cc) do { const int row0_ = b * SEQ + 16 * (cc); const int soR_ = row0_ * 4096, soP_ = row0_ > 0 ? (row0_ - 1) * 4096 : 0, vaP_ = row0_ > 0 ? 0 : -4096; \
                _Pragma("unroll") for (int nt = 0; nt < 4; ++nt) { \
                    nR[nt][0] = __builtin_bit_cast(u32x2, __builtin_amdgcn_raw_buffer_load_b64(rsR, voR + 32 * nt, soR_, 0)); nK[nt][0] = __builtin_bit_cast(u32x2, __builtin_amdgcn_raw_buffer_load_b64(rsK, voR + 32 * nt, soR_, 0)); \
                    nR[nt][1] = __builtin_bit_cast(u32x2, __builtin_amdgcn_raw_buffer_load_b64(rsR, voR + 32 * nt + vaP_, soP_, 0)); nK[nt][1] = __builtin_bit_cast(u32x2, __builtin_amdgcn_raw_buffer_load_b64(rsK, voR + 32 * nt + vaP_, soP_, 0)); } \
                nV[0] = __builtin_bit_cast(u32x2, __builtin_amdgcn_raw_buffer_load_b64(rsV, voR + 32 * qw, soR_, 0)); nV[1] = __builtin_bit_cast(u32x2, __builtin_amdgcn_raw_buffer_load_b64(rsV, voR + 32 * qw + vaP_, soP_, 0)); } while (0)
            RC_PREFETCH_A(pw); RC_PREFETCH_R(pw);
            LAS const unsigned char* wb = lds + RC_W2H + (r * 104 + 8 * q) * 2;
            LAS const float* cq = cst + 4 * q;
            asm volatile("" : "+v"(wb), "+v"(cq));
            bf16x4 ident; { u32x2 w; w.x = ((4 * q + 0 == r) ? 0x3F80u : 0u) | ((4 * q + 1 == r) ? 0x3F800000u : 0u); w.y = ((4 * q + 2 == r) ? 0x3F80u : 0u) | ((4 * q + 3 == r) ? 0x3F800000u : 0u); ident = __builtin_bit_cast(bf16x4, w); }
            const f32x4 zero4 = {0.f, 0.f, 0.f, 0.f};
            unsigned long long pacc = 0;
            for (int blk = 0; blk <= RC_NB; ++blk) {
                unsigned long long tq0 = 0; if (PROBE_PH == 22 && blockIdx.x == 0 && pw == 0) tq0 = __builtin_amdgcn_s_memrealtime();
                const int ci = blk * RC_BLK + pw;
                if (blk < RC_NB && ci < RC_NCHK) {
                    LAS unsigned char* sl = lds + ((blk & 1) * RC_BLK + pw) * RC_SL;
                    LAS unsigned char* sl16 = sl + lane * 16; LAS unsigned char* sl8 = sl + lane * 8; LAS unsigned char* slg = sl + RC_GL + 16 * q;
                    asm volatile("" : "+v"(sl16), "+v"(sl8), "+v"(slg));
                    const size_t m = (size_t)b * SEQ + 16 * ci + r; const bool first = (16 * ci + r) == 0;
                    f32x4 accw[4], acca[4];
#pragma unroll
                    for (int nt = 0; nt < 4; ++nt) { accw[nt] = zero4; acca[nt] = zero4; }
#pragma unroll
                    for (int ks = 0; ks < 3; ++ks)
#pragma unroll
                        for (int nt = 0; nt < 4; ++nt) { const int bo = (16 * nt * 104 + 32 * ks) * 2;
                            accw[nt] = MFMA32(*(LAS const bf16x8*)(wb + bo), nAW[ks], accw[nt]); acca[nt] = MFMA32(*(LAS const bf16x8*)(wb + 13312 + bo), nAA[ks], acca[nt]); }
                    __builtin_amdgcn_sched_barrier(0);
                    if (ci + RC_BLK < RC_NCHK) RC_PREFETCH_A(ci + RC_BLK);
                    float ss = 0.f, bo = 0.f;
#pragma unroll
                    for (int nt = 0; nt < 4; ++nt) { const f32x4 muk = *(LAS const f32x4*)(cq + 6 * 64 + 16 * nt), kkc = *(LAS const f32x4*)(cq + 2 * 64 + 16 * nt);
                        const f32x4 kc = up4(nK[nt][0]); f32x4 kq = up4(nK[nt][1]); if (first) kq = zero4; const f32x4 kkv = (kc + (kq - kc) * muk) * kkc; ss += sumsq4(kkv); }
                    ss += __shfl_xor(ss, 16); ss += __shfl_xor(ss, 32);
                    const float rn = __builtin_amdgcn_rsqf(fmaxf(ss, 1e-24f));
                    bf16x4 qa[4], qb[4], qk[4], qr[4];
#pragma unroll
                    for (int nt = 0; nt < 4; ++nt) {
                        const f32x4 w0 = *(LAS const f32x4*)(cq + 0 * 64 + 16 * nt), a0 = *(LAS const f32x4*)(cq + 1 * 64 + 16 * nt);
                        f32x4 lw, ag;
#pragma unroll
                        for (int i = 0; i < 4; ++i) { lw[i] = -0.60653066f * __builtin_amdgcn_rcpf(1.f + __expf(-(w0[i] + accw[nt][i]))); ag[i] = __builtin_amdgcn_rcpf(1.f + __expf(-(a0[i] + acca[nt][i]))); }
                        const f32x4 mur = *(LAS const f32x4*)(cq + 5 * 64 + 16 * nt), muk = *(LAS const f32x4*)(cq + 6 * 64 + 16 * nt), kkc = *(LAS const f32x4*)(cq + 2 * 64 + 16 * nt), kac = *(LAS const f32x4*)(cq + 3 * 64 + 16 * nt), rkc = *(LAS const f32x4*)(cq + 4 * 64 + 16 * nt);
                        const f32x4 rc = up4(nR[nt][0]), kc = up4(nK[nt][0]); f32x4 rp = up4(nR[nt][1]), kq = up4(nK[nt][1]); if (first) { rp = zero4; kq = zero4; }
                        const f32x4 r4 = rc + (rp - rc) * mur, k4 = kc + (kq - kc) * muk;
                        const f32x4 kn = k4 * kkc * rn, kp = k4 * (1.f + (ag - 1.f) * kac);
                        const f32x4 b4_ = r4 * kp * rkc; bo += (b4_.x + b4_.y) + (b4_.z + b4_.w);
                        f32x4 G = lw;
#pragma unroll
                        for (int i = 0; i < 4; ++i) { float g = G[i]; g += dpp_f<0x111>(g); g += dpp_f<0x112>(g); g += dpp_f<0x114>(g); g += dpp_f<0x118>(g); G[i] = g; }
                        f32x4 eG, eGx, eI;
#pragma unroll
                        for (int i = 0; i < 4; ++i) { eG[i] = __expf(G[i]); eGx[i] = __builtin_bit_cast(float, __builtin_amdgcn_update_dpp(0x3F800000, __builtin_bit_cast(int, eG[i]), 0x111, 0xf, 0xf, false)); eI[i] = __builtin_amdgcn_rcpf(eG[i]); }
                        qa[nt] = pk4((zero4 - kn) * eGx); qb[nt] = pk4(kn * ag * eI); qk[nt] = pk4(kp * eI); qr[nt] = pk4(r4 * eG);
                        if (r == 15) *(LAS f32x4*)(slg + 64 * nt) = eG;
                        const f32x4 d1 = MFMA16(qb[nt], ident, zero4), d2 = MFMA16(qk[nt], ident, zero4);
                        *(LAS bf16x4*)(sl8 + RC_BT + nt * 512) = pk4(d1); *(LAS bf16x4*)(sl8 + RC_KT + nt * 512) = pk4(d2);
                    }
                    bo += __shfl_xor(bo, 16); bo += __shfl_xor(bo, 32);
                    if (qw == 0 && q == 0) { BON[(m * 32 + h) * 2] = bo; BON[(m * 32 + h) * 2 + 1] = 0.f; }
                    f32x4 v4; { const f32x4 muv = *(LAS const f32x4*)(cq + 7 * 64 + 16 * qw); const f32x4 vc = up4(nV[0]); f32x4 vp = up4(nV[1]); if (first) vp = zero4; v4 = vc + (vp - vc) * muv; }
                    __builtin_amdgcn_sched_barrier(0);
                    if (ci + RC_BLK < RC_NCHK) RC_PREFETCH_R(ci + RC_BLK);
                    __builtin_amdgcn_sched_barrier(0);
                    { const f32x4 d3 = MFMA16(pk4(v4), ident, zero4); *(LAS bf16x4*)(sl8 + RC_VT) = pk4(d3); }
#define CAT8(lo, hi) __builtin_shufflevector(lo, hi, 0, 1, 2, 3, 4, 5, 6, 7)
                    const bf16x8 pa0 = CAT8(qa[0], qa[1]), pa1 = CAT8(qa[2], qa[3]), pr0 = CAT8(qr[0], qr[1]), pr1 = CAT8(qr[2], qr[3]), pb0 = CAT8(qb[0], qb[1]), pb1 = CAT8(qb[2], qb[3]), pk0 = CAT8(qk[0], qk[1]), pk1 = CAT8(qk[2], qk[3]);
#undef CAT8
                    *(LAS bf16x8*)(sl16 + RC_AT) = pa0; *(LAS bf16x8*)(sl16 + RC_AT + 1024) = pa1; *(LAS bf16x8*)(sl16 + RC_RT) = pr0; *(LAS bf16x8*)(sl16 + RC_RT + 1024) = pr1;
                    __builtin_amdgcn_sched_barrier(0);
                    f32x4 mab = MFMA32(pb0, pa0, zero4); mab = MFMA32(pb1, pa1, mab);
                    f32x4 mak = MFMA32(pk0, pa0, zero4); mak = MFMA32(pk1, pa1, mak);
                    f32x4 mrb = MFMA32(pb0, pr0, zero4); mrb = MFMA32(pb1, pr1, mrb);
                    f32x4 mrk = MFMA32(pk0, pr0, zero4); mrk = MFMA32(pk1, pr1, mrk);
#pragma unroll
                    for (int t = 0; t < 4; ++t) { const int j = 4 * q + t; if (!(j < r)) { mab[t] = 0.f; mak[t] = 0.f; } if (!(j <= r)) { mrb[t] = 0.f; mrk[t] = 0.f; } }
                    *(LAS bf16x4*)(sl8 + RC_MAK) = pk4(mak); *(LAS bf16x4*)(sl8 + RC_MRB) = pk4(mrb); *(LAS bf16x4*)(sl8 + RC_MRK) = pk4(mrk);
                    __builtin_amdgcn_sched_barrier(0);
                    {
                        const bf16x4 nA = pk4(mab);
                        const bf16x4 nB = pk4(MFMA16(nA, ident, zero4));
                        f32x4 s;
#pragma unroll
                        for (int t = 0; t < 4; ++t) s[t] = mab[t] + ((4 * q + t == r) ? 1.f : 0.f);
                        const bf16x4 z2a = pk4(MFMA16(nA, nB, zero4)), z2b = pk4(MFMA16(nB, nA, zero4));
                        s = MFMA16(z2a, pk4(s), s);
                        const bf16x4 z4a = pk4(MFMA16(z2b, z2a, zero4)), z4b = pk4(MFMA16(z2a, z2b, zero4));
                        s = MFMA16(z4a, pk4(s), s);
                        const bf16x4 z8a = pk4(MFMA16(z4b, z4a, zero4));
                        s = MFMA16(z8a, pk4(s), s);
                        *(LAS bf16x4*)(sl8 + RC_TI) = pk4(s);
                    }
                }
                if (PROBE_PH == 22 && blockIdx.x == 0 && pw == 0) { asm volatile("s_waitcnt lgkmcnt(0)" ::: "memory"); pacc += __builtin_amdgcn_s_memrealtime() - tq0; }
                LDS_BARRIER();
            }
            if (PROBE_PH == 22 && blockIdx.x == 0 && pw == 0 && lane == 0) *(LAS unsigned long long*)(lds + 163840 - 16) = pacc;
#undef RC_PREFETCH_A
#undef RC_PREFETCH_R
        } else {
            bf16_t* SS = (bf16_t*)p.out; const float* CD = (const float*)(p.ws + WS_CTL + WS_CD);
            const int nitem = (BATCH * 32 * 64 * 32 + nwg * 64 - 1) / (nwg * 64), nstep = nitem * 128;
            constexpr int PER = 12;
            int s = (unit == wg) ? 0 : nstep; f32x4 hh = {0.f, 0.f, 0.f, 0.f};
            for (int blk = 0; blk <= RC_NB; ++blk) {
                u32x2 raw[PER]; float dd[PER]; bf16_t* qq[PER]; bool ok[PER];
#pragma unroll
                for (int k = 0; k < PER; ++k) { const int ss = s + k, item = ss >> 7, cc = ss & 127, idx = item * (nwg * 64) + wg * 64 + lane; ok[k] = ss < nstep && idx < BATCH * 32 * 64 * 32;
                    const int n4 = idx & 31, pp = (idx >> 5) & 63, eg = (idx >> 11) & 31, bb = idx >> 16;
                    qq[k] = SS + ((((size_t)bb * 128 + cc) * 32 + eg) * 64 + pp) * 128 + 4 * n4; raw[k] = (u32x2){0u, 0u}; dd[k] = 0.f;
                    if (ok[k]) { raw[k] = *(const u32x2*)qq[k]; dd[k] = CD[(bb * 128 + cc) * 32 + eg]; } }
#pragma unroll
                for (int k = 0; k < PER; ++k) { if (((s + k) & 127) == 0) hh = (f32x4){0.f, 0.f, 0.f, 0.f};
                    if (ok[k]) { u32x2 w; w.x = pg8::cvt_pk_bf16(hh.x, hh.y); w.y = pg8::cvt_pk_bf16(hh.z, hh.w); *(u32x2*)qq[k] = w; hh = hh * dd[k] + up4(raw[k]); } }
                s += PER;
                LDS_BARRIER();
            }
            for (; s < nstep; ++s) {
                const int item = s >> 7, cc = s & 127, idx = item * (nwg * 64) + wg * 64 + lane; if ((s & 127) == 0) hh = (f32x4){0.f, 0.f, 0.f, 0.f};
                if (idx < BATCH * 32 * 64 * 32) { const int n4 = idx & 31, pp = (idx >> 5) & 63, eg = (idx >> 11) & 31, bb = idx >> 16;
                    bf16_t* q1 = SS + ((((size_t)bb * 128 + cc) * 32 + eg) * 64 + pp) * 128 + 4 * n4; const f32x4 sv = ld4bf(q1); const float d1 = CD[(bb * 128 + cc) * 32 + eg];
                    u32x2 w; w.x = pg8::cvt_pk_bf16(hh.x, hh.y); w.y = pg8::cvt_pk_bf16(hh.z, hh.w); *(u32x2*)q1 = w; hh = hh * d1 + sv; } }
        }
    }
}

constexpr int RD_NG = 56;
constexpr int RD_NL = 12;
constexpr int RD_SLOTG = 10496;
constexpr int RD_BK = 4096, RD_MM = 8192;
constexpr size_t WS_RING = 9 * MiB;
constexpr size_t CTL_READY = 256 * 1024, CTL_DONE = 512 * 1024, CTL_ERR = 192 * 1024;
static_assert(WS_RING + (size_t)64 * RD_NG * RD_SLOTG <= 47 * MiB, "ring fits the dead WIN' region");
constexpr int RD_FLAGS = RC_CST + 2048;
static_assert(RD_FLAGS + 64 <= 163840, "R2d LDS map");
#define RD_SPIN_MAX (1u << 19)
__device__ void phase_rwkv_dist(const Params& p, LAS unsigned char* lds, int wg, int nwg) {
    const int tid = otid(), lane = tid & 63, wave = __builtin_amdgcn_readfirstlane(tid >> 6), r = lane & 15, q = lane >> 4;
    LAS float* cst = (LAS float*)(lds + RC_CST);
    volatile LAS unsigned* lflag = (volatile LAS unsigned*)(lds + RD_FLAGS);
    float* BON = (float*)(p.ws + WS_BON); bf16_t* YRAW = (bf16_t*)(p.ws + WS_YRAW);
    unsigned* READY = (unsigned*)(p.ws + WS_CTL + CTL_READY); unsigned* DONE = (unsigned*)(p.ws + WS_CTL + CTL_DONE); unsigned* ERR = (unsigned*)(p.ws + WS_CTL + CTL_ERR);
    const auto rsWS = __builtin_amdgcn_make_buffer_rsrc((void*)p.ws, 0, (int)WS_END, 0x00020000);
    for (int unit = wg; unit < 256; unit += nwg) {
        const int xcd = unit & 7, idx = unit >> 3, qw = idx & 3, bh = xcd * 8 + (idx >> 2), b = bh >> 5, h = bh & 31;
        __syncthreads();
        { const int arr = tid >> 6, ch = tid & 63; const float* srcs[8] = {p.in[I_W0], p.in[I_A0], p.in[I_KK], p.in[I_KA], p.in[I_RK], p.in[I_MU] + MU_R, p.in[I_MU] + MU_K, p.in[I_MU] + MU_V};
          float v = 0.f;
#pragma unroll
          for (int a = 0; a < 8; ++a) if (arr == a) v = srcs[a][h * 64 + ch];
          cst[arr * 64 + ch] = v; }
        {   LAS bf16_t* w2h = (LAS bf16_t*)(lds + RC_W2H); LAS bf16_t* a2h = (LAS bf16_t*)(lds + RC_A2H);
            for (int i = tid; i < 96 * 64; i += 512) { const int k = i >> 6, ch = i & 63;
                w2h[ch * 104 + k] = (bf16_t)f2bf(p.in[I_W2][(size_t)k * D_RWKV + h * 64 + ch]); a2h[ch * 104 + k] = (bf16_t)f2bf(p.in[I_A2][(size_t)k * D_RWKV + h * 64 + ch]); } }
        if (tid < 13) lflag[tid] = 0u;
        __syncthreads();
        const f32x4 zero4 = {0.f, 0.f, 0.f, 0.f};
        bf16x4 ident; { u32x2 w; w.x = ((4 * q + 0 == r) ? 0x3F80u : 0u) | ((4 * q + 1 == r) ? 0x3F800000u : 0u); w.y = ((4 * q + 2 == r) ? 0x3F80u : 0u) | ((4 * q + 3 == r) ? 0x3F800000u : 0u); ident = __builtin_bit_cast(bf16x4, w); }
        const int ringbase = (int)WS_RING + bh * (RD_NG * RD_SLOTG);
        bool dead = false;
        if (wave == 0) {
            __builtin_amdgcn_s_setprio(3);
            f32x4 Sacc[4];
#pragma unroll
            for (int ct = 0; ct < 4; ++ct) Sacc[ct] = zero4;
            for (int ci = 0; ci < RC_NCHK; ++ci) {
                { unsigned sp = 0; while (!dead && lflag[ci % RD_NL] != (unsigned)(ci + 1)) { __builtin_amdgcn_s_sleep(1); if (++sp > RD_SPIN_MAX) { if (lane == 0) atomicAdd(ERR, 1u); dead = true; } } }
                asm volatile("" ::: "memory");
                LAS const unsigned char* sl = lds + (ci % RD_NL) * RC_SL;
                const bf16x8 at0 = *(LAS const bf16x8*)(sl + RC_AT + lane * 16), at1 = *(LAS const bf16x8*)(sl + RC_AT + 1024 + lane * 16);
                const bf16x8 rt0 = *(LAS const bf16x8*)(sl + RC_RT + lane * 16), rt1 = *(LAS const bf16x8*)(sl + RC_RT + 1024 + lane * 16);
                const bf16x8 mm0 = *(LAS const bf16x8*)(sl + RD_MM + lane * 32), mm1 = *(LAS const bf16x8*)(sl + RD_MM + lane * 32 + 16);
                const bf16x4 vt = *(LAS const bf16x4*)(sl + RC_VT + lane * 8);
                bf16x8 bk[4]; f32x4 gl[4];
#pragma unroll
                for (int ct = 0; ct < 4; ++ct) { bk[ct] = *(LAS const bf16x8*)(sl + RD_BK + (ct * 64 + lane) * 16); gl[ct] = *(LAS const f32x4*)(sl + RC_GL + (16 * ct + 4 * q) * 4); }
                asm volatile("s_waitcnt lgkmcnt(0)" ::: "memory");
                lflag[12] = (unsigned)(ci + 1);
                const bf16x4 mak = __builtin_shufflevector(mm0, mm0, 0, 1, 2, 3), mrb = __builtin_shufflevector(mm0, mm0, 4, 5, 6, 7), mrk = __builtin_shufflevector(mm1, mm1, 0, 1, 2, 3), ti = __builtin_shufflevector(mm1, mm1, 4, 5, 6, 7);
                const bf16x8 sop0 = pk8(Sacc[0], Sacc[1]), sop1 = pk8(Sacc[2], Sacc[3]);
                f32x4 X = MFMA32(at0, sop0, zero4); X = MFMA32(at1, sop1, X); X = MFMA16(mak, vt, X);
                const f32x4 U = MFMA16(ti, pk4(X), zero4);
                const bf16x4 up = pk4(U);
                f32x4 Y = MFMA32(rt0, sop0, zero4); Y = MFMA32(rt1, sop1, Y); Y = MFMA16(mrb, up, Y); Y = MFMA16(mrk, vt, Y);
#pragma unroll
                for (int ct = 0; ct < 4; ++ct) { const bf16x4 btc = __builtin_shufflevector(bk[ct], bk[ct], 0, 1, 2, 3), ktc = __builtin_shufflevector(bk[ct], bk[ct], 4, 5, 6, 7);
                    Sacc[ct] = MFMA16(btc, up, Sacc[ct]); Sacc[ct] = MFMA16(ktc, vt, Sacc[ct]); Sacc[ct] = Sacc[ct] * gl[ct]; }
                const f32x4 Yt = MFMA16(pk4(Y), ident, zero4);
                *(u32x2*)(YRAW + ((size_t)bh * SEQ + 16 * ci + r) * 64 + 16 * qw + 4 * q) = __builtin_bit_cast(u32x2, pk4(Yt));
            }
            __builtin_amdgcn_s_setprio(0);
        } else if (wave >= 4) {
            const int fw = wave - 4;
            __builtin_amdgcn_s_setprio(2);
            const int voV = (r * 64 + 16 * qw + 4 * q) * 2;
            const f32x4 muv = *(LAS const f32x4*)(cst + 7 * 64 + 16 * qw + 4 * q);
            u32x4 fa[2][10]; u32x4 fg[2]; u32x2 fv[2][2];
#define RD_PEEK(cc) __hip_atomic_load(READY + bh * 512 + (cc), __ATOMIC_RELAXED, __HIP_MEMORY_SCOPE_AGENT)
#define RD_ISSUE(cc, s_, pre_) do { const int c_ = (cc); unsigned sp_ = 0; \
                    if (__builtin_amdgcn_readfirstlane(pre_) == 0u) while (!dead && __hip_atomic_load(READY + bh * 512 + c_, __ATOMIC_RELAXED, __HIP_MEMORY_SCOPE_AGENT) == 0u) { __builtin_amdgcn_s_sleep(2); if (++sp_ > RD_SPIN_MAX) { if (lane == 0) atomicAdd(ERR, 1u); dead = true; } } \
                    const int so_ = ringbase + (c_ % RD_NG) * RD_SLOTG; \
                    _Pragma("unroll") for (int j_ = 0; j_ < 10; ++j_) fa[s_][j_] = __builtin_bit_cast(u32x4, __builtin_amdgcn_raw_buffer_load_b128(rsWS, lane * 16 + 1024 * (j_ & 3), so_ + 4096 * (j_ >> 2), 16));     \
                    fg[s_] = __builtin_bit_cast(u32x4, __builtin_amdgcn_raw_buffer_load_b128(rsWS, (lane & 15) * 16, so_ + 10240, 16)); \
                    { const int soR_ = (bh * SEQ + 16 * c_) * 128, soP_ = soR_ > 0 ? soR_ - 128 : 0, vaP_ = soR_ > 0 ? 0 : -128; \
                      fv[s_][0] = __builtin_bit_cast(u32x2, __builtin_amdgcn_raw_buffer_load_b64(rsWS, voV, (int)WS_V + soR_, 0)); fv[s_][1] = __builtin_bit_cast(u32x2, __builtin_amdgcn_raw_buffer_load_b64(rsWS, voV + vaP_, (int)WS_V + soP_, 0)); } } while (0)
#define RD_STAGE(cc, s_) do { const int c_ = (cc); { unsigned sp_ = 0; while (!dead && (int)lflag[12] < c_ - RD_NL + 1) { __builtin_amdgcn_s_sleep(1); if (++sp_ > RD_SPIN_MAX) { if (lane == 0) atomicAdd(ERR, 1u); dead = true; } } } \
                    LAS unsigned char* sl_ = lds + (c_ % RD_NL) * RC_SL; \
                    f32x4 vc_ = up4(fv[s_][0]), vp_ = up4(fv[s_][1]); if (16 * c_ + r == 0) vp_ = zero4; const f32x4 v4_ = vc_ + (vp_ - vc_) * muv; \
                    const f32x4 d3_ = MFMA16(pk4(v4_), ident, zero4); \
                    _Pragma("unroll") for (int j_ = 0; j_ < 10; ++j_) *(LAS u32x4*)(sl_ + lane * 16 + 1024 * j_) = fa[s_][j_]; \
                    *(LAS u32x4*)(sl_ + RC_GL + (lane & 15) * 16) = fg[s_]; \
                    *(LAS bf16x4*)(sl_ + RC_VT + lane * 8) = pk4(d3_); \
                    asm volatile("s_waitcnt lgkmcnt(0)" ::: "memory"); \
                    lflag[c_ % RD_NL] = (unsigned)(c_ + 1); __hip_atomic_fetch_add(DONE + bh * 512 + c_, 1u, __ATOMIC_RELAXED, __HIP_MEMORY_SCOPE_AGENT); } while (0)
            bf16_t* SS = (bf16_t*)p.out; const float* CD = (const float*)(p.ws + WS_CTL + WS_CD);
            const int nitem = (BATCH * 32 * 64 * 32 + nwg * 64 - 1) / (nwg * 64), nstep = ((nitem + 3) / 4) * 128;
            const int per = (nitem + 3) / 4;
            int s2 = (unit == wg) ? 0 : nstep; f32x4 hh = zero4;
            RD_ISSUE(fw, 0, 0u);
            for (int c2 = fw; c2 < RC_NCHK; c2 += 8) {
                const unsigned pr1 = RD_PEEK(c2 + 4), pr0 = (c2 + 8 < RC_NCHK) ? RD_PEEK(c2 + 8) : 0u;
                u32x2 raw[4]; float dd[4]; bf16_t* qq[4]; bool ok[4];
#pragma unroll
                for (int k = 0; k < 4; ++k) { const int ss = s2 + k, item = fw * per + (ss >> 7), cc = ss & 127, idx = item * (nwg * 64) + wg * 64 + lane; ok[k] = ss < nstep && (ss >> 7) < per && item < nitem && idx < BATCH * 32 * 64 * 32;
                    const int n4 = idx & 31, pp = (idx >> 5) & 63, eg = (idx >> 11) & 31, bb = idx >> 16;
                    qq[k] = SS + ((((size_t)bb * 128 + cc) * 32 + eg) * 64 + pp) * 128 + 4 * n4; raw[k] = (u32x2){0u, 0u}; dd[k] = 0.f;
                    if (ok[k]) { raw[k] = *(const u32x2*)qq[k]; dd[k] = CD[(bb * 128 + cc) * 32 + eg]; } }
                RD_ISSUE(c2 + 4, 1, pr1);
                RD_STAGE(c2, 0);
                if (c2 + 8 < RC_NCHK) RD_ISSUE(c2 + 8, 0, pr0);
                RD_STAGE(c2 + 4, 1);
#pragma unroll
                for (int k = 0; k < 4; ++k) { if (((s2 + k) & 127) == 0) hh = zero4;
                    if (ok[k]) { u32x2 w; w.x = pg8::cvt_pk_bf16(hh.x, hh.y); w.y = pg8::cvt_pk_bf16(hh.z, hh.w); *(u32x2*)qq[k] = w; hh = hh * dd[k] + up4(raw[k]); } }
                s2 += 4;
            }
            for (; s2 < nstep; ++s2) {
                const int item = fw * per + (s2 >> 7), cc = s2 & 127, idx = item * (nwg * 64) + wg * 64 + lane; if ((s2 & 127) == 0) hh = zero4;
                if (item < nitem && idx < BATCH * 32 * 64 * 32) { const int n4 = idx & 31, pp = (idx >> 5) & 63, eg = (idx >> 11) & 31, bb = idx >> 16;
                    bf16_t* q1 = SS + ((((size_t)bb * 128 + cc) * 32 + eg) * 64 + pp) * 128 + 4 * n4; const f32x4 sv = ld4bf(q1); const float d1 = CD[(bb * 128 + cc) * 32 + eg];
                    u32x2 w; w.x = pg8::cvt_pk_bf16(hh.x, hh.y); w.y = pg8::cvt_pk_bf16(hh.z, hh.w); *(u32x2*)q1 = w; hh = hh * d1 + sv; } }
#undef RD_ISSUE
#undef RD_PEEK
#undef RD_STAGE
            __builtin_amdgcn_s_setprio(0);
        } else {
            const int pw = wave - 1;
            const bf16_t* dummy = nullptr; (void)dummy;
            const int voA = (r * 128 + 8 * q) * 2, voR = (r * 64 + 4 * q) * 2;
            bf16x8 nAW[3], nAA[3]; u32x2 nX[8][2];
#define RD_PREFETCH_A(cc) do { const int soA_ = (b * SEQ + 16 * (cc)) * 256; \
                _Pragma("unroll") for (int ks = 0; ks < 3; ++ks) { nAW[ks] = __builtin_bit_cast(bf16x8, __builtin_amdgcn_raw_buffer_load_b128(rsWS, voA + 64 * ks, (int)WS_AW + soA_, 0)); nAA[ks] = __builtin_bit_cast(bf16x8, __builtin_amdgcn_raw_buffer_load_b128(rsWS, voA + 64 * ks, (int)WS_AA + soA_, 0)); } } while (0)
#define RD_PREFETCH_R(cc) do { const int soR_ = (bh * SEQ + 16 * (cc)) * 128, soP_ = soR_ > 0 ? soR_ - 128 : 0, vaP_ = soR_ > 0 ? 0 : -128; \
                _Pragma("unroll") for (int xi = 0; xi < 8; ++xi) { const int base_ = xi < 4 ? (int)WS_R : (int)WS_K, vo_ = voR + 32 * (xi & 3); \
                    nX[xi][0] = __builtin_bit_cast(u32x2, __builtin_amdgcn_raw_buffer_load_b64(rsWS, vo_, base_ + soR_, 0)); nX[xi][1] = __builtin_bit_cast(u32x2, __builtin_amdgcn_raw_buffer_load_b64(rsWS, vo_ + vaP_, base_ + soP_, 0)); } } while (0)
            LAS const unsigned char* wb = lds + RC_W2H + (r * 104 + 8 * q) * 2;
            LAS const float* cq = cst + 4 * q;
            asm volatile("" : "+v"(wb), "+v"(cq));
            { const int c0 = 6 * qw + pw; if (c0 < RC_NCHK) { RD_PREFETCH_A(c0); } }
            for (int cj = 0; cj < 2 * ((RC_NCHK + 23) / 24); ++cj) {
                const int ci = 24 * (cj >> 1) + 6 * qw + pw + 3 * (cj & 1); if (ci >= RC_NCHK) continue;
                const int cn = 24 * ((cj + 1) >> 1) + 6 * qw + pw + 3 * ((cj + 1) & 1);
                RD_PREFETCH_R(ci);
                const size_t m = (size_t)b * SEQ + 16 * ci + r; const bool first = (16 * ci + r) == 0;
                f32x4 accw[4], acca[4];
#pragma unroll
                for (int nt = 0; nt < 4; ++nt) { accw[nt] = zero4; acca[nt] = zero4; }
#pragma unroll
                for (int ks = 0; ks < 3; ++ks)
#pragma unroll
                    for (int nt = 0; nt < 4; ++nt) { const int bo = (16 * nt * 104 + 32 * ks) * 2;
                        accw[nt] = MFMA32(*(LAS const bf16x8*)(wb + bo), nAW[ks], accw[nt]); acca[nt] = MFMA32(*(LAS const bf16x8*)(wb + 13312 + bo), nAA[ks], acca[nt]); }
                __builtin_amdgcn_sched_barrier(0);
                if (cn < RC_NCHK) RD_PREFETCH_A(cn);
                float ss = 0.f, bo = 0.f;
#pragma unroll
                for (int nt = 0; nt < 4; ++nt) { const f32x4 muk = *(LAS const f32x4*)(cq + 6 * 64 + 16 * nt), kkc = *(LAS const f32x4*)(cq + 2 * 64 + 16 * nt);
                    const f32x4 kc = up4(nX[4 + nt][0]); f32x4 kq = up4(nX[4 + nt][1]); if (first) kq = zero4; const f32x4 kkv = (kc + (kq - kc) * muk) * kkc; ss += sumsq4(kkv); }
                ss += __shfl_xor(ss, 16); ss += __shfl_xor(ss, 32);
                const float rn = __builtin_amdgcn_rsqf(fmaxf(ss, 1e-24f));
                if (ci >= RD_NG) { unsigned sp = 0; while (!dead && __hip_atomic_load(DONE + bh * 512 + (ci - RD_NG), __ATOMIC_RELAXED, __HIP_MEMORY_SCOPE_AGENT) < 256u) { __builtin_amdgcn_s_sleep(2); if (++sp > RD_SPIN_MAX) { if (lane == 0) atomicAdd(ERR, 1u); dead = true; } } }
                const int so = ringbase + (ci % RD_NG) * RD_SLOTG;
                bf16x4 qa[4], qb[4], qk[4], qr[4];
#pragma unroll
                for (int nt = 0; nt < 4; ++nt) {
                    const f32x4 w0 = *(LAS const f32x4*)(cq + 0 * 64 + 16 * nt), a0 = *(LAS const f32x4*)(cq + 1 * 64 + 16 * nt);
                    f32x4 lw, ag;
#pragma unroll
                    for (int i = 0; i < 4; ++i) { lw[i] = -0.60653066f * __builtin_amdgcn_rcpf(1.f + __expf(-(w0[i] + accw[nt][i]))); ag[i] = __builtin_amdgcn_rcpf(1.f + __expf(-(a0[i] + acca[nt][i]))); }
                    const f32x4 mur = *(LAS const f32x4*)(cq + 5 * 64 + 16 * nt), muk = *(LAS const f32x4*)(cq + 6 * 64 + 16 * nt), kkc = *(LAS const f32x4*)(cq + 2 * 64 + 16 * nt), kac = *(LAS const f32x4*)(cq + 3 * 64 + 16 * nt), rkc = *(LAS const f32x4*)(cq + 4 * 64 + 16 * nt);
                    const f32x4 rc = up4(nX[nt][0]), kc = up4(nX[4 + nt][0]); f32x4 rp = up4(nX[nt][1]), kq = up4(nX[4 + nt][1]); if (first) { rp = zero4; kq = zero4; }
                    const f32x4 r4 = rc + (rp - rc) * mur, k4 = kc + (kq - kc) * muk;
                    const f32x4 kn = k4 * kkc * rn, kp = k4 * (1.f + (ag - 1.f) * kac);
                    const f32x4 b4_ = r4 * kp * rkc; bo += (b4_.x + b4_.y) + (b4_.z + b4_.w);
                    f32x4 G = lw;
#pragma unroll
                    for (int i = 0; i < 4; ++i) { float g = G[i]; g += dpp_f<0x111>(g); g += dpp_f<0x112>(g); g += dpp_f<0x114>(g); g += dpp_f<0x118>(g); G[i] = g; }
                    f32x4 eG, eGx, eI;
#pragma unroll
                    for (int i = 0; i < 4; ++i) { eG[i] = __expf(G[i]); eGx[i] = __builtin_bit_cast(float, __builtin_amdgcn_update_dpp(0x3F800000, __builtin_bit_cast(int, eG[i]), 0x111, 0xf, 0xf, false)); eI[i] = __builtin_amdgcn_rcpf(eG[i]); }
                    qa[nt] = pk4((zero4 - kn) * eGx); qb[nt] = pk4(kn * ag * eI); qk[nt] = pk4(kp * eI); qr[nt] = pk4(r4 * eG);
                    __builtin_amdgcn_raw_buffer_store_b128(__builtin_bit_cast(u32x4, eG), rsWS, (r == 15) ? (16 * nt + 4 * q) * 4 : 0x7ffffff0, so + 10240, 16);
                    const f32x4 d1 = MFMA16(qb[nt], ident, zero4), d2 = MFMA16(qk[nt], ident, zero4);
                    { const bf16x4 e1 = pk4(d1), e2 = pk4(d2); __builtin_amdgcn_raw_buffer_store_b128(__builtin_bit_cast(u32x4, __builtin_shufflevector(e1, e2, 0, 1, 2, 3, 4, 5, 6, 7)), rsWS, lane * 16 + 1024 * nt, so + RD_BK, 16); }
                }
                bo += __shfl_xor(bo, 16); bo += __shfl_xor(bo, 32);
                { BON[(m * 32 + h) * 2] = bo; BON[(m * 32 + h) * 2 + 1] = 0.f; }
#define CAT8(lo, hi) __builtin_shufflevector(lo, hi, 0, 1, 2, 3, 4, 5, 6, 7)
                const bf16x8 pa0 = CAT8(qa[0], qa[1]), pa1 = CAT8(qa[2], qa[3]), pr0 = CAT8(qr[0], qr[1]), pr1 = CAT8(qr[2], qr[3]), pb0 = CAT8(qb[0], qb[1]), pb1 = CAT8(qb[2], qb[3]), pk0 = CAT8(qk[0], qk[1]), pk1 = CAT8(qk[2], qk[3]);
#undef CAT8
                __builtin_amdgcn_raw_buffer_store_b128(__builtin_bit_cast(u32x4, pa0), rsWS, lane * 16, so + RC_AT, 16); __builtin_amdgcn_raw_buffer_store_b128(__builtin_bit_cast(u32x4, pa1), rsWS, lane * 16 + 1024, so + RC_AT, 16);
                __builtin_amdgcn_raw_buffer_store_b128(__builtin_bit_cast(u32x4, pr0), rsWS, lane * 16, so + RC_RT, 16); __builtin_amdgcn_raw_buffer_store_b128(__builtin_bit_cast(u32x4, pr1), rsWS, lane * 16 + 1024, so + RC_RT, 16);
                __builtin_amdgcn_sched_barrier(0);
                f32x4 mab = MFMA32(pb0, pa0, zero4); mab = MFMA32(pb1, pa1, mab);
                f32x4 mak = MFMA32(pk0, pa0, zero4); mak = MFMA32(pk1, pa1, mak);
                f32x4 mrb = MFMA32(pb0, pr0, zero4); mrb = MFMA32(pb1, pr1, mrb);
                f32x4 mrk = MFMA32(pk0, pr0, zero4); mrk = MFMA32(pk1, pr1, mrk);
#pragma unroll
                for (int t = 0; t < 4; ++t) { const int j = 4 * q + t; if (!(j < r)) { mab[t] = 0.f; mak[t] = 0.f; } if (!(j <= r)) { mrb[t] = 0.f; mrk[t] = 0.f; } }
                { const bf16x4 e1 = pk4(mak), e2 = pk4(mrb); __builtin_amdgcn_raw_buffer_store_b128(__builtin_bit_cast(u32x4, __builtin_shufflevector(e1, e2, 0, 1, 2, 3, 4, 5, 6, 7)), rsWS, lane * 32, so + RD_MM, 16); }
                const bf16x4 mrkp = pk4(mrk);
                __builtin_amdgcn_sched_barrier(0);
                {   const bf16x4 nA = pk4(mab);
                    const bf16x4 nB = pk4(MFMA16(nA, ident, zero4));
                    f32x4 s;
#pragma unroll
                    for (int t = 0; t < 4; ++t) s[t] = mab[t] + ((4 * q + t == r) ? 1.f : 0.f);
                    const bf16x4 z2a = pk4(MFMA16(nA, nB, zero4)), z2b = pk4(MFMA16(nB, nA, zero4));
                    s = MFMA16(z2a, pk4(s), s);
                    const bf16x4 z4a = pk4(MFMA16(z2b, z2a, zero4)), z4b = pk4(MFMA16(z2a, z2b, zero4));
                    s = MFMA16(z4a, pk4(s), s);
                    const bf16x4 z8a = pk4(MFMA16(z4b, z4a, zero4));
                    s = MFMA16(z8a, pk4(s), s);
                    { const bf16x4 e2 = pk4(s); __builtin_amdgcn_raw_buffer_store_b128(__builtin_bit_cast(u32x4, __builtin_shufflevector(mrkp, e2, 0, 1, 2, 3, 4, 5, 6, 7)), rsWS, lane * 32 + 16, so + RD_MM, 16); }
                }
                asm volatile("s_waitcnt vmcnt(0)" ::: "memory");
                __hip_atomic_store(READY + bh * 512 + ci, 1u, __ATOMIC_RELAXED, __HIP_MEMORY_SCOPE_AGENT);
            }
#undef RD_PREFETCH_A
#undef RD_PREFETCH_R
        }
    }
}

__device__ void phase_rwkv_post(const Params& p, bf16_t* ymix, LAS unsigned char* lds, int wg, int nwg) {
    const int tid = otid(), lane = tid & 63, wave = tid >> 6, fr = lane & 15, fq = lane >> 4;
    const bf16_t* AG = (const bf16_t*)(p.ws + WS_AG); const bf16_t* G2 = (const bf16_t*)(p.ws + WS_G2); const bf16_t* YRAW = (const bf16_t*)(p.ws + WS_YRAW); const bf16_t* V = (const bf16_t*)(p.ws + WS_V);
    const float* BON = (const float*)(p.ws + WS_BON); const float* mu = p.in[I_MU];
    for (int item = wg; item < 8 * 32; item += nwg) {
        const int hg = item >> 5, rng = item & 31;
        __syncthreads();
        for (int i = tid; i < 4 * 64 * 32; i += 512) { const int ch = i >> 5, c16 = i & 31; *(LAS u32x4*)(lds + (ch * 264 + c16 * 8) * 2) = *(const u32x4*)(G2 + (size_t)(hg * 256 + ch) * 256 + c16 * 8); }
        __syncthreads();
        for (int it = 0; it < 4; ++it) {
            const int mt = rng * 32 + it * 8 + wave;
            const size_t m = (size_t)mt * 16 + fr; const bool hp = (m % SEQ) > 0;
            bf16x8 af[8];
#pragma unroll
            for (int ks = 0; ks < 8; ++ks) af[ks] = *(const bf16x8*)(AG + m * 256 + 32 * ks + 8 * fq);
            for (int hh = 0; hh < 4; ++hh) {
                const int h = hg * 4 + hh;
                f32x4 y[4], vc[4], vp[4];
#pragma unroll
                for (int nt = 0; nt < 4; ++nt) { const size_t e = ((size_t)((int)(m / SEQ) * 32 + h) * SEQ + (m % SEQ)) * 64 + 16 * nt + 4 * fq;
                    y[nt] = ld4bf(YRAW + e); vc[nt] = ld4bf(V + e); vp[nt] = (f32x4){0.f, 0.f, 0.f, 0.f}; if (hp) vp[nt] = ld4bf(V + e - 64); }
                const float bon = BON[(m * 32 + h) * 2] + BON[(m * 32 + h) * 2 + 1];
                f32x4 muv4[4], gw4[4], gb4[4];
#pragma unroll
                for (int nt = 0; nt < 4; ++nt) { const int c = h * 64 + 16 * nt + 4 * fq; muv4[nt] = *(const f32x4*)(mu + MU_V + c); gw4[nt] = *(const f32x4*)(p.in[I_GNW] + c); gb4[nt] = *(const f32x4*)(p.in[I_GNB] + c); }
                f32x4 acc[4];
#pragma unroll
                for (int nt = 0; nt < 4; ++nt) acc[nt] = (f32x4){0.f, 0.f, 0.f, 0.f};
#pragma unroll
                for (int ks = 0; ks < 8; ++ks)
#pragma unroll
                    for (int nt = 0; nt < 4; ++nt) acc[nt] = __builtin_amdgcn_mfma_f32_16x16x32_bf16(*(LAS const bf16x8*)(lds + ((64 * hh + 16 * nt + fr) * 264 + 32 * ks + 8 * fq) * 2), af[ks], acc[nt], 0, 0, 0);
                float s1 = 0.f;
#pragma unroll
                for (int nt = 0; nt < 4; ++nt) s1 += (y[nt].x + y[nt].y) + (y[nt].z + y[nt].w);
                s1 += __shfl_xor(s1, 16); s1 += __shfl_xor(s1, 32);
                const float mean = s1 * (1.f / 64.f); float s2 = 0.f;
#pragma unroll
                for (int nt = 0; nt < 4; ++nt) { y[nt] = y[nt] - mean; s2 += sumsq4(y[nt]); }
                s2 += __shfl_xor(s2, 16); s2 += __shfl_xor(s2, 32);
                const float rstd = __builtin_amdgcn_rsqf(s2 * (1.f / 64.f) + GN_EPS);
#pragma unroll
                for (int nt = 0; nt < 4; ++nt) {
                    const int c = h * 64 + 16 * nt + 4 * fq;
                    const f32x4 muv = muv4[nt], gw = gw4[nt], gb = gb4[nt];
                    const f32x4 v4 = vc[nt] + (vp[nt] - vc[nt]) * muv;
                    const f32x4 o = (y[nt] * rstd * gw + gb + v4 * bon) * acc[nt];
                    u32x2 w; w.x = pg8::cvt_pk_bf16_c(o.x, o.y); w.y = pg8::cvt_pk_bf16_c(o.z, o.w);
                    *(u32x2*)(ymix + m * D_MIX + 2048 + c) = w;
                }
            }
        }
    }
}

__device__ void phase_final(const Params& p, int wg, int nwg) {
    const int tid = otid(), lane = tid & 63, wave = tid >> 6;
    const float* rowss2 = (const float*)(p.ws + WS_CTL) + M; const float* gf = p.in[I_NFG]; const bf16_t* H2B = (const bf16_t*)(p.ws + WS_H2B);
    for (int m = wg * 8 + wave; m < M; m += nwg * 8) {
        const float rstd = 1.f / sqrtf(rowss2[m] * (1.f / DM) + RMS_EPS);
        u32x4 hw[4];
#pragma unroll
        for (int j = 0; j < 4; ++j) hw[j] = *(const u32x4*)(H2B + (size_t)m * DM + (64 * j + lane) * 8);
#pragma unroll
        for (int j = 0; j < 4; ++j) { const int c = (64 * j + lane) * 8;
            const f32x4 g0 = *(const f32x4*)(gf + c), g1 = *(const f32x4*)(gf + c + 4);
            *(f32x4*)(p.out + (size_t)m * DM + c) = up4((u32x2){hw[j].x, hw[j].y}) * rstd * g0; *(f32x4*)(p.out + (size_t)m * DM + c + 4) = up4((u32x2){hw[j].z, hw[j].w}) * rstd * g1; }
    }
}

#define XB_TMO      128
#define XB_XCNT(j)  (256  + 64 * (j))
#define XB_XSUB(j)  (1280 + 64 * (j))
#define XB_XGEN(j)  (2304 + 64 * (j))
#define XB_TOP      3328
#define XB_TOPGEN   3392
#define XCD_BAR_WORDS 3456
#define XB_SPIN_CAP (1u << 18)

__device__ __forceinline__ unsigned xb_ld(unsigned* p)              { return __hip_atomic_load(p, __ATOMIC_RELAXED, __HIP_MEMORY_SCOPE_AGENT); }
__device__ __forceinline__ unsigned xb_add(unsigned* p, unsigned v) { return __hip_atomic_fetch_add(p, v, __ATOMIC_RELAXED, __HIP_MEMORY_SCOPE_AGENT); }
__device__ __forceinline__ unsigned xb_xcc_id() { return (unsigned)__builtin_amdgcn_s_getreg((3 << 11) | 20) & 0xFu; }
#define XB_SPIN(cond, bar) do { unsigned _sp = 0; while (cond) { __builtin_amdgcn_s_sleep(1); \
    if ((++_sp & 255u) == 0u) { if (xb_ld(&(bar)[XB_TMO])) break; if (_sp > XB_SPIN_CAP) { atomicAdd(&(bar)[XB_TMO], 1u); break; } } } } while (0)

struct XcdBarrier {
    unsigned* bar; unsigned x;
    volatile LAS unsigned* st;
};

__device__ __forceinline__ XcdBarrier xcd_barrier_post(unsigned* bar, volatile LAS unsigned* st) {
    XcdBarrier b; b.bar = bar; b.x = xb_xcc_id(); b.st = st;
    if (threadIdx.x == 0) (void)xb_add(&bar[XB_XCNT(b.x)], 1u);
    return b;
}
__device__ __forceinline__ void xcd_barrier_complete(unsigned* bar, unsigned x, unsigned& nloc, unsigned& nx) {
    const unsigned G = gridDim.x * gridDim.y * gridDim.z;
    unsigned sum, cnt, mine, sp = 0u;
    for (;;) {
        sum = 0u; cnt = 0u; mine = 0u;
#pragma unroll
        for (unsigned j = 0; j < 16; ++j) { const unsigned c = xb_ld(&bar[XB_XCNT(j)]); sum += c; cnt += (c > 0u) ? 1u : 0u; mine = (j == x) ? c : mine; }
        if (sum == G) break;
        __builtin_amdgcn_s_sleep(1);
        if ((++sp & 255u) == 0u) { if (xb_ld(&bar[XB_TMO])) break; if (sp > XB_SPIN_CAP) { atomicAdd(&bar[XB_TMO], 1u); break; } }
    }
    nloc = mine > 0u ? mine : 1u; nx = cnt > 0u ? cnt : 1u;
}

__device__ __forceinline__ void xcd_barrier(const XcdBarrier& b) {
    asm volatile("s_waitcnt vmcnt(0)" ::: "memory");
    __syncthreads();
    if (threadIdx.x == 0) {
        unsigned* bar = b.bar;
        __builtin_amdgcn_s_waitcnt(0);
        unsigned nloc = b.st[0], nx = b.st[1];
        if (nloc == 0u) { xcd_barrier_complete(bar, b.x, nloc, nx); b.st[0] = nloc; b.st[1] = nx; }
        const unsigned old = xb_add(&bar[XB_XSUB(b.x)], 1u);
        const unsigned gen = old / nloc;
        if (old + 1u == (gen + 1u) * nloc) {
            __builtin_amdgcn_fence(__ATOMIC_RELEASE, "agent");
            asm volatile("s_waitcnt vmcnt(0)" ::: "memory");
            const unsigned og = xb_add(&bar[XB_TOP], 1u);
            const unsigned tg = og / nx;
            if (og + 1u == (tg + 1u) * nx) xb_add(&bar[XB_TOPGEN], 1u);
            else XB_SPIN(xb_ld(&bar[XB_TOPGEN]) == tg, bar);
            __builtin_amdgcn_fence(__ATOMIC_ACQUIRE, "agent");
            xb_add(&bar[XB_XGEN(b.x)], 1u);
            asm volatile("s_waitcnt vmcnt(0)" ::: "memory");
        } else {
            XB_SPIN(xb_ld(&bar[XB_XGEN(b.x)]) == gen, bar);
            __builtin_amdgcn_fence(__ATOMIC_ACQUIRE, "agent");
            asm volatile("s_waitcnt vmcnt(0)" ::: "memory");
        }
    }
    __syncthreads();
}

constexpr size_t CTL_XBAR = 704 * 1024;
static_assert(CTL_XBAR + XCD_BAR_WORDS * 4 <= CTL_BYTES, "barrier words inside the memset");
#define PH_BEGIN(k) do { if (PROBE_PH == (k) && blockIdx.x == 0 && threadIdx.x == 0) pt0 = __builtin_amdgcn_s_memrealtime(); } while (0)
#define PH_END(k) do { if (PROBE_PH == (k) && blockIdx.x == 0 && threadIdx.x == 0) pt1 = __builtin_amdgcn_s_memrealtime(); } while (0)
__global__ void __launch_bounds__(512, 2) k_mega(Params p) {
    extern __shared__ __attribute__((aligned(16))) unsigned char lds_raw[];
    LAS unsigned char* lds = (LAS unsigned char*)lds_raw;
    cg::grid_group grid = cg::this_grid();
    const int wg = blockIdx.x, nwg = gridDim.x;
    bf16_t* ymix = (bf16_t*)(p.ws + WS_R);
    float* rowss1 = (float*)(p.ws + WS_CTL); float* rowss2 = rowss1 + M;
    unsigned long long pt0 = 0, pt1 = 0;
    volatile LAS unsigned* xbst = (volatile LAS unsigned*)(lds + LDS_BYTES_C - 64);
    if (threadIdx.x < 2) xbst[threadIdx.x] = 0u;
    __syncthreads();
    const XcdBarrier xbar = xcd_barrier_post((unsigned*)(p.ws + WS_CTL + CTL_XBAR), xbst);
    grid.sync();
    PH_BEGIN(1);
    phase_p0a(p, lds, wg, nwg);
    xcd_barrier(xbar);
    PH_END(1); PH_BEGIN(2);
    run_gemm(lds, (const bf16_t*)p.out, (const bf16_t*)(p.ws + WS_WIN), M, NP, DM, EpiP{p.ws});
    xcd_barrier(xbar);
    PH_END(2); PH_BEGIN(3);
    phase_rwkv_pre(p, wg, nwg);
    phase_ssd1(p, lds, wg, nwg);
    xcd_barrier(xbar);
    PH_END(3); PH_BEGIN(4); PH_BEGIN(10);
#if RWKV_CHUNKED == 0
    phase_ssd2(p, wg, nwg);
#endif
    PH_END(10);
#if RWKV_CHUNKED == 2
    phase_rwkv_dist(p, lds, wg, nwg);
#elif RWKV_CHUNKED == 1
    phase_rwkv_chunked(p, lds, wg, nwg);
#else
    phase_rwkv_scan(p, lds, wg, nwg);
#endif
    if (PROBE_PH == 12 || PROBE_PH == 22 || PROBE_PH == 21) __syncthreads();
    if ((PROBE_PH == 11 || PROBE_PH == 12 || PROBE_PH == 13 || PROBE_PH == 21 || PROBE_PH == 22) && blockIdx.x == 0 && threadIdx.x == 0) { pt0 = 0; pt1 = *(LAS unsigned long long*)(lds + 163840 - 16); }
    xcd_barrier(xbar);
    PH_END(4); PH_BEGIN(5); PH_BEGIN(14);
    phase_ssd3(p, ymix, lds, wg, nwg);
    if (PROBE_PH == 14) { asm volatile("s_waitcnt vmcnt(0)" ::: "memory"); } PH_END(14);
    phase_rwkv_post(p, ymix, lds, wg, nwg);
    xcd_barrier(xbar);
    PH_END(5); PH_BEGIN(6); PH_BEGIN(15);
    phase_p0b(p, lds, wg, nwg);
    if (PROBE_PH == 15) { asm volatile("s_waitcnt vmcnt(0)" ::: "memory"); } PH_END(15);
    __syncthreads();
    run_gemm(lds, ymix, (const bf16_t*)(p.ws + WS_WOUT), M, DM, D_MIX, EpiOut{p.in[I_X], (bf16_t*)(p.ws + WS_H1B), rowss1, 0.f});
    xcd_barrier(xbar);
    PH_END(6); PH_BEGIN(7);
    run_gemm(lds, (const bf16_t*)(p.ws + WS_H1B), (const bf16_t*)(p.ws + WS_WGU), M, NGU, DM, EpiGU{rowss1, (bf16_t*)(p.ws + WS_ACT)});
    xcd_barrier(xbar);
    PH_END(7); PH_BEGIN(8);
    run_gemm(lds, (const bf16_t*)(p.ws + WS_ACT), (const bf16_t*)(p.ws + WS_WDN), M, DM, D_FF, EpiDown{(const bf16_t*)(p.ws + WS_H1B), (bf16_t*)(p.ws + WS_H2B), rowss2, 0.f});
    xcd_barrier(xbar);
    PH_END(8); PH_BEGIN(9);
    phase_final(p, wg, nwg);
    PH_END(9);
    if (PROBE_PH != 0 && blockIdx.x == 0 && threadIdx.x == 0) { const unsigned long long t0 = __builtin_amdgcn_s_memrealtime(), d = pt1 - pt0; while (__builtin_amdgcn_s_memrealtime() - t0 < d) __builtin_amdgcn_s_sleep(8); }
}

constexpr int LDS_BYTES = 163840;
extern "C" void kernel_launch(void* const* d_in, const int* in_sizes, int n_in, void* d_out, int out_size, void* d_ws, size_t ws_size, hipStream_t stream) {
    static int grid = 0;
    if (grid == 0) {
        if (n_in != 26 || ws_size < WS_END) { fprintf(stderr, "kernel_launch: unexpected n_in %d / ws_size %zu\n", n_in, ws_size); grid = -1; return; }
        int dev = 0, cus = 0, per_cu = 0;
        (void)hipGetDevice(&dev);
        (void)hipDeviceGetAttribute(&cus, hipDeviceAttributeMultiprocessorCount, dev);
        (void)hipFuncSetAttribute((const void*)k_mega, hipFuncAttributeMaxDynamicSharedMemorySize, LDS_BYTES);
        (void)hipOccupancyMaxActiveBlocksPerMultiprocessor(&per_cu, (const void*)k_mega, 512, LDS_BYTES);
        if (per_cu < 1) { fprintf(stderr, "kernel_launch: occupancy query says %d blocks/CU\n", per_cu); grid = -1; return; }
        grid = cus;
        fprintf(stderr, "kernel_launch: cus %d per_cu %d grid %d ws %zu\n", cus, per_cu, grid, ws_size);
    }
    if (grid < 0) return;
    Params p{};
    for (int i = 0; i < 26; ++i) p.in[i] = (const float*)d_in[i];
    p.out = (float*)d_out; p.ws = (unsigned char*)d_ws;
    (void)hipMemsetAsync((char*)d_ws + WS_CTL, 0, CTL_BYTES, stream);
    void* args[] = {&p};
    hipError_t e = hipLaunchCooperativeKernel((const void*)k_mega, dim3(grid), dim3(512), args, LDS_BYTES, stream);
    if (e != hipSuccess) fprintf(stderr, "cooperative launch failed: %s (grid %d)\n", hipGetErrorString(e), grid);
}
```
